# Optimizing an MI355X kernel written in HIP

```python
import math
import jax, jax.numpy as jnp
from jax import lax
import numpy as np

D_MODEL = 1024
BATCH = 8
SEQ = 4096
DEPTH = 1

SSM_GROUPS = 32
SSM_GROUP_CH = 16
SSM_WIDTH = SSM_GROUPS * SSM_GROUP_CH
SSM_STATE = 64
DT_MIN = 1e-3
DT_MAX = 1e-1
N_HEADS = 8
QK_NOPE = 128
QK_ROPE = 64
QK_HEAD = QK_NOPE + QK_ROPE
V_HEAD = 128
Q_LORA = 384
KV_LORA = 256
ROPE_THETA = 10000.0
Q_BLOCK = 128
MAX_POS_OFFSET = 1024
D_FF = 4 * D_MODEL
EPS = 1e-6
IN_SIZES = (SSM_WIDTH, Q_LORA, KV_LORA + QK_ROPE, D_MODEL, D_MODEL)
IN_OFFSETS = tuple(int(v) for v in np.cumsum(IN_SIZES)[:-1])
D_IN = sum(IN_SIZES)

kernel_name = "hybrid_s5_mla_gated_block"


def rms_norm(x, gain):
    xf = x.astype(jnp.float32)
    inv = lax.rsqrt(jnp.mean(xf * xf, axis=-1, keepdims=True) + EPS)
    return (xf * inv * gain.astype(jnp.float32)).astype(x.dtype)


def rope_tables(positions):
    half = QK_ROPE // 2
    inv_freq = ROPE_THETA ** (-jnp.arange(half, dtype=jnp.float32) / half)
    ang = positions.astype(jnp.float32)[..., None] * inv_freq
    return jnp.cos(ang)[:, :, None, :], jnp.sin(ang)[:, :, None, :]


def apply_rope(x, cos, sin):
    xf = x.astype(jnp.float32)
    x1, x2 = jnp.split(xf, 2, axis=-1)
    out = jnp.concatenate([x1 * cos - x2 * sin, x2 * cos + x1 * sin], axis=-1)
    return out.astype(x.dtype)


def causal_block_attention(q, k, v):
    b, l, h, dq = q.shape
    nblk = l // Q_BLOCK
    qb = q.reshape(b, nblk, Q_BLOCK, h, dq).transpose(1, 0, 2, 3, 4)
    key_idx = jnp.arange(l)
    scale = QK_HEAD ** -0.5

    def one_block(args):
        q_blk, blk = args
        s = jnp.einsum('bqhd,bkhd->bhqk', q_blk, k, preferred_element_type=jnp.float32) * scale
        q_idx = blk * Q_BLOCK + jnp.arange(Q_BLOCK)
        s = jnp.where(key_idx[None, :] <= q_idx[:, None], s, -jnp.inf)
        p = jax.nn.softmax(s, axis=-1).astype(v.dtype)
        return jnp.einsum('bhqk,bkhd->bqhd', p, v)

    out = lax.map(one_block, (qb, jnp.arange(nblk)))
    return out.transpose(1, 0, 2, 3, 4).reshape(b, l, h, -1)


def s5_ssm(u, a_re, a_im, log_dt, b_re, b_im, c_re, c_im, d_skip):
    f32 = jnp.float32
    dt = jnp.exp(log_dt.astype(f32))[:, None]
    lam = lax.complex(a_re.astype(f32), a_im.astype(f32))
    lam_bar = jnp.exp(lam * dt)
    b_mat = lax.complex(b_re.astype(f32), b_im.astype(f32))
    b_bar = ((lam_bar - 1.0) / lam)[..., None] * b_mat
    bu = jnp.einsum('gpc,blgc->blgp', b_bar, u.astype(f32).astype(jnp.complex64))
    a = jnp.broadcast_to(lam_bar, (1, u.shape[1]) + lam_bar.shape)

    def combine(left, right):
        a_l, b_l = left
        a_r, b_r = right
        return a_r * a_l, a_r * b_l + b_r

    _, states = lax.associative_scan(combine, (a, bu), axis=1)
    c_mat = lax.complex(c_re.astype(f32), c_im.astype(f32))
    y = jnp.real(jnp.einsum('gcp,blgp->blgc', c_mat, states)) + d_skip.astype(f32) * u.astype(f32)
    return y.astype(u.dtype)


def hybrid_layer(x, positions, norm_mix, w_in, q_a_norm, kv_a_norm, w_q_b, w_kv_b, q_norm, k_norm, w_o_mla,
                 ssm_a_re, ssm_a_im, ssm_log_dt, ssm_b_re, ssm_b_im, ssm_c_re, ssm_c_im, ssm_d,
                 w_glu, b_glu, w_o_ssm, w_out, norm_mlp, w_up, w_down):
    b, l, _ = x.shape
    xn = rms_norm(x, norm_mix)
    proj = xn @ w_in
    u, q_lat, kv_lat, gate_ssm, gate_mla = jnp.split(proj, IN_OFFSETS, axis=-1)

    y = s5_ssm(u.reshape(b, l, SSM_GROUPS, SSM_GROUP_CH), ssm_a_re, ssm_a_im, ssm_log_dt,
               ssm_b_re, ssm_b_im, ssm_c_re, ssm_c_im, ssm_d).reshape(b, l, SSM_WIDTH)
    z = jax.nn.gelu(y)
    z = z * jax.nn.sigmoid(z @ w_glu + b_glu)
    y_ssm = z @ w_o_ssm

    q = (rms_norm(q_lat, q_a_norm) @ w_q_b).reshape(b, l, N_HEADS, QK_HEAD)
    c_kv, k_pe = kv_lat[..., :KV_LORA], kv_lat[..., KV_LORA:]
    kv = (rms_norm(c_kv, kv_a_norm) @ w_kv_b).reshape(b, l, N_HEADS, QK_NOPE + V_HEAD)
    k_nope, v = kv[..., :QK_NOPE], kv[..., QK_NOPE:]
    k = jnp.concatenate([k_nope, jnp.broadcast_to(k_pe[:, :, None, :], (b, l, N_HEADS, QK_ROPE))], axis=-1)
    q = rms_norm(q, q_norm)
    k = rms_norm(k, k_norm)
    cos, sin = rope_tables(positions)
    q = jnp.concatenate([q[..., :QK_NOPE], apply_rope(q[..., QK_NOPE:], cos, sin)], axis=-1)
    k = jnp.concatenate([k[..., :QK_NOPE], apply_rope(k[..., QK_NOPE:], cos, sin)], axis=-1)
    attn = causal_block_attention(q, k, v).reshape(b, l, N_HEADS * V_HEAD)
    y_mla = attn @ w_o_mla

    mixed = jax.nn.sigmoid(gate_ssm) * y_ssm + jax.nn.sigmoid(gate_mla) * y_mla
    h = x + mixed @ w_out

    hidden = jnp.square(jax.nn.relu(rms_norm(h, norm_mlp) @ w_up))
    return h + hidden @ w_down


def setup_inputs(seed: int = 0) -> dict:
    key = jax.random.key(seed)
    ks = jax.random.split(key, 32)
    f32 = jnp.float32

    def dense(k, fan_in, shape):
        return jax.random.normal(k, (DEPTH,) + shape, f32) * (fan_in ** -0.5)

    def gain(k, n):
        return 1.0 + 0.02 * jax.random.normal(k, (DEPTH, n), f32)

    x = jax.random.normal(ks[0], (BATCH, SEQ, D_MODEL), f32)
    offset = jax.random.randint(ks[1], (BATCH, 1), 0, MAX_POS_OFFSET, dtype=jnp.int32)
    positions = (offset + jnp.arange(SEQ, dtype=jnp.int32)[None, :]).astype(jnp.int32)
    n_idx = jnp.arange(SSM_STATE, dtype=f32)
    ssm_a_re = -0.5 + 0.01 * jax.random.normal(ks[2], (DEPTH, SSM_GROUPS, SSM_STATE), f32)
    ssm_a_im = math.pi * n_idx[None, None, :] + 0.01 * jax.random.normal(ks[3], (DEPTH, SSM_GROUPS, SSM_STATE), f32)
    ssm_log_dt = jax.random.uniform(ks[4], (DEPTH, SSM_GROUPS), f32, math.log(DT_MIN), math.log(DT_MAX))
    return {
        "x": x,
        "positions": positions,
        "norm_mix": gain(ks[5], D_MODEL),
        "w_in": dense(ks[6], D_MODEL, (D_MODEL, D_IN)),
        "q_a_norm": gain(ks[7], Q_LORA),
        "kv_a_norm": gain(ks[8], KV_LORA),
        "w_q_b": dense(ks[9], Q_LORA, (Q_LORA, N_HEADS * QK_HEAD)),
        "w_kv_b": dense(ks[10], KV_LORA, (KV_LORA, N_HEADS * (QK_NOPE + V_HEAD))),
        "q_norm": gain(ks[11], QK_HEAD),
        "k_norm": gain(ks[12], QK_HEAD),
        "w_o_mla": dense(ks[13], N_HEADS * V_HEAD, (N_HEADS * V_HEAD, D_MODEL)),
        "ssm_a_re": ssm_a_re,
        "ssm_a_im": ssm_a_im,
        "ssm_log_dt": ssm_log_dt,
        "ssm_b_re": dense(ks[14], 2 * SSM_GROUP_CH, (SSM_GROUPS, SSM_STATE, SSM_GROUP_CH)),
        "ssm_b_im": dense(ks[15], 2 * SSM_GROUP_CH, (SSM_GROUPS, SSM_STATE, SSM_GROUP_CH)),
        "ssm_c_re": dense(ks[16], 2 * SSM_STATE, (SSM_GROUPS, SSM_GROUP_CH, SSM_STATE)),
        "ssm_c_im": dense(ks[17], 2 * SSM_STATE, (SSM_GROUPS, SSM_GROUP_CH, SSM_STATE)),
        "ssm_d": jax.random.normal(ks[18], (DEPTH, SSM_GROUPS, SSM_GROUP_CH), f32),
        "w_glu": dense(ks[19], SSM_WIDTH, (SSM_WIDTH, SSM_WIDTH)),
        "b_glu": 0.01 * jax.random.normal(ks[20], (DEPTH, SSM_WIDTH), f32),
        "w_o_ssm": dense(ks[21], SSM_WIDTH, (SSM_WIDTH, D_MODEL)),
        "w_out": dense(ks[22], D_MODEL, (D_MODEL, D_MODEL)),
        "norm_mlp": gain(ks[23], D_MODEL),
        "w_up": dense(ks[24], D_MODEL, (D_MODEL, D_FF)),
        "w_down": dense(ks[25], D_FF, (D_FF, D_MODEL)),
    }


def reference(x, positions, norm_mix, w_in, q_a_norm, kv_a_norm, w_q_b, w_kv_b, q_norm, k_norm, w_o_mla,
              ssm_a_re, ssm_a_im, ssm_log_dt, ssm_b_re, ssm_b_im, ssm_c_re, ssm_c_im, ssm_d,
              w_glu, b_glu, w_o_ssm, w_out, norm_mlp, w_up, w_down):
    h = x
    for layer in range(DEPTH):
        h = hybrid_layer(h, positions, norm_mix[layer], w_in[layer], q_a_norm[layer], kv_a_norm[layer],
                         w_q_b[layer], w_kv_b[layer], q_norm[layer], k_norm[layer], w_o_mla[layer],
                         ssm_a_re[layer], ssm_a_im[layer], ssm_log_dt[layer], ssm_b_re[layer], ssm_b_im[layer],
                         ssm_c_re[layer], ssm_c_im[layer], ssm_d[layer], w_glu[layer], b_glu[layer],
                         w_o_ssm[layer], w_out[layer], norm_mlp[layer], w_up[layer], w_down[layer])
    return h
```

```cpp
#include <hip/hip_runtime.h>
#include <hip/hip_cooperative_groups.h>
#include <cstdint>
#include <cstdio>
#include <cmath>
#define MK_MODE 0
#define MK_FIRST_CHECK 1
#define LAS __attribute__((address_space(3)))
typedef unsigned short bf16_t;
typedef short bf16x8 __attribute__((ext_vector_type(8)));
typedef short s16x4 __attribute__((ext_vector_type(4)));
typedef float f32x4 __attribute__((ext_vector_type(4)));
typedef float f32x16 __attribute__((ext_vector_type(16)));
typedef unsigned u32x4 __attribute__((ext_vector_type(4)));
typedef unsigned u32x2 __attribute__((ext_vector_type(2)));

constexpr int TOK = 4096;
constexpr float LOG2E = 1.4426950408889634f;
constexpr float QSCALE = 0.07216878364870322f * LOG2E;

struct Params {
    const float* in[26];
    float* out;
    unsigned* ctl;
    float *ssq_q, *ssq_kv, *ssq_kpe, *ssq_h, *inv_x;
    float* sloc;
    float *rcos, *rsin;
    bf16_t* kpe;
    bf16_t *W1t, *Wqt, *Wkvt, *Wglut, *Wost, *Womt, *Woutt, *Wupt, *Wdnt;
    bf16_t *XB, *U, *QL, *CKV, *Q, *K, *V, *ATT, *Z, *Z2, *T1, *HB, *HID, *SGS, *SGM;
    const float* x; const int* pos;
    int NB, ph_lo, ph_hi, pad;
    float inv_freq[32];
};

typedef float f32x2_t __attribute__((ext_vector_type(2))); typedef __bf16 bf16x2_t __attribute__((ext_vector_type(2)));
__device__ __forceinline__ unsigned cvt_pk_bf16(float lo, float hi) { f32x2_t v = {lo, hi}; bf16x2_t b = __builtin_convertvector(v, bf16x2_t); return __builtin_bit_cast(unsigned, b); }
__device__ __forceinline__ u32x4 pack8(const f32x4 a, const f32x4 b) { u32x4 w; w.x = cvt_pk_bf16(a[0], a[1]); w.y = cvt_pk_bf16(a[2], a[3]); w.z = cvt_pk_bf16(b[0], b[1]); w.w = cvt_pk_bf16(b[2], b[3]); return w; }
__device__ __forceinline__ float bf_lo(unsigned w) { return __uint_as_float(w << 16); }
__device__ __forceinline__ float bf_hi(unsigned w) { return __uint_as_float(w & 0xffff0000u); }
__device__ __forceinline__ void unpack8(const u32x4 w, f32x4& a, f32x4& b) { a = (f32x4){bf_lo(w.x), bf_hi(w.x), bf_lo(w.y), bf_hi(w.y)}; b = (f32x4){bf_lo(w.z), bf_hi(w.z), bf_lo(w.w), bf_hi(w.w)}; }
__device__ __forceinline__ float fast_sigmoid(float v) { return __builtin_amdgcn_rcpf(1.f + __builtin_amdgcn_exp2f(-v * LOG2E)); }
__device__ __forceinline__ float fast_tanh(float v) { const float e = __builtin_amdgcn_exp2f(-2.f * LOG2E * fabsf(v)); const float t = (1.f - e) * __builtin_amdgcn_rcpf(1.f + e); return v < 0.f ? -t : t; }
__device__ __forceinline__ float gelu_t(float x) { return 0.5f * x * (1.f + fast_tanh(0.7978845608028654f * (x + 0.044715f * x * x * x))); }
__host__ __device__ __forceinline__ int dperm(int s) { const int wc = s >> 5, fq = (s >> 3) & 3, n = (s >> 2) & 1, j = s & 3; return 32 * n + 16 * wc + 4 * fq + j; }

namespace pg8 {
constexpr int BM = 256, BK = 64, HALF = 128, HTB = HALF * BK * 2, STAGE_BYTES = 8 * HTB, NXCD = 8, WGM = 8;
__host__ __device__ __forceinline__ int lds_byte(int r, int c) { const int st = (r >> 4) * 2 + (c >> 5), rr = r & 15, cc = c & 31, ob = rr * 64 + cc * 2; return st * 1024 + (ob ^ (((ob >> 9) & 1) << 5)); }
__host__ __device__ __forceinline__ void stage_rc(int b, int& R, int& C) { const int st = b / 1024, sb = b % 1024, swz = sb ^ (((sb >> 9) & 1) << 5); R = (st >> 1) * 16 + swz / 64; C = (st & 1) * 32 + (swz % 64) / 2; }
__host__ __device__ __forceinline__ int perm32(int rho) { const int n = rho >> 4, i = rho & 15; return 8 * (i >> 2) + 4 * n + (i & 3); }
struct Unit { int pm, pn; };
struct Gemm { const bf16_t* A; int lda; const bf16_t* Bt; int ldb; int M, N, K; };
struct StaticOrder {
    int nM, nN, nwg, G, c;
    __device__ void init(int M, int N, int G_, int c_) { nM = M / BM; nN = N / BM; nwg = nM * nN; G = G_; c = c_; }
    __device__ bool next(int i, Unit& u) const {
        const long L = (long)i * G + c; if (L >= nwg) return false;
        int wgid = (int)L; { const int q = nwg / NXCD, r = nwg % NXCD, xcd = wgid % NXCD, off = wgid / NXCD; wgid = (xcd < r ? xcd * (q + 1) : r * (q + 1) + (xcd - r) * q) + off; }
        const int nig = WGM * nN, gid = wgid / nig, fm = gid * WGM, gsz = (nM - fm) < WGM ? (nM - fm) : WGM;
        u.pm = fm + ((wgid % nig) % gsz); u.pn = (wgid % nig) / gsz; return true;
    }
};
typedef f32x4 Acc[2][2][4][2];

template <class Epi>
__device__ __forceinline__ void gemm_phase(LAS unsigned char* lds, LAS unsigned char* aux, const Gemm g, const StaticOrder& S, const Epi& E) {
    const int tid = threadIdx.x, wid = __builtin_amdgcn_readfirstlane(tid >> 6), lane = tid & 63, wr = wid >> 2, wc = wid & 3, fr = lane & 15, fq = lane >> 4;
    const int K = g.K, nt = K / BK;
    unsigned voffA[2], voffB[2];
#pragma unroll
    for (int i = 0; i < 2; ++i) { int R, C; stage_rc(tid * 16 + i * 8192, R, C); const int Rb = (R & ~31) + perm32(R & 31);
        voffA[i] = (unsigned)(R * g.lda + C) * 2u; voffB[i] = (unsigned)(Rb * g.ldb + C) * 2u; }
    const size_t kstep = (size_t)(BK * 2);
    const size_t hstepA = (size_t)HALF * g.lda * 2, hstepB = (size_t)HALF * g.ldb * 2;
    const size_t tstepA = 2 * hstepA, tstepB = 2 * hstepB;
    const unsigned ldsw = (unsigned)wid * 1024u;
    const int aoff = lds_byte(wr * 64 + fr, fq * 8), boff = lds_byte(wc * 32 + fr, fq * 8);
#define PG8_SA(b, h) (((b) * 2 + (h)) * HTB)
#define PG8_SB(b, h) ((4 + (b) * 2 + (h)) * HTB)
#define PG8_STAGE(bufoff, gbase, voff) do { _Pragma("unroll") for (int _i = 0; _i < 2; ++_i) \
        __builtin_amdgcn_global_load_lds((const unsigned*)((const char*)(gbase) + (voff)[_i]), (LAS unsigned*)(lds + (bufoff) + ldsw + _i * 8192), 16, 0, 0); } while (0)
#define PG8_LDA(dst, b, h) do { _Pragma("unroll") for (int m = 0; m < 4; ++m) _Pragma("unroll") for (int k = 0; k < 2; ++k) dst[m][k] = *(const LAS bf16x8*)(lds + PG8_SA(b, h) + aoff + m * 2048 + k * 1024); } while (0)
#define PG8_LDB(dst, b, h) do { _Pragma("unroll") for (int n = 0; n < 2; ++n) _Pragma("unroll") for (int k = 0; k < 2; ++k) dst[n][k] = *(const LAS bf16x8*)(lds + PG8_SB(b, h) + boff + n * 2048 + k * 1024); } while (0)
#define PG8_MMA(ai, bj, At, Bt) do { __builtin_amdgcn_s_setprio(1); _Pragma("unroll") for (int m = 0; m < 4; ++m) _Pragma("unroll") for (int n = 0; n < 2; ++n) _Pragma("unroll") for (int k = 0; k < 2; ++k) \
        acc[ai][bj][m][n] = __builtin_amdgcn_mfma_f32_16x16x32_bf16(Bt[n][k], At[m][k], acc[ai][bj][m][n], 0, 0, 0); __builtin_amdgcn_s_setprio(0); } while (0)
#define PG8_WAIT_V(n) asm volatile("s_waitcnt vmcnt(" #n ")" ::: "memory")
#define PG8_WAIT_L(n) asm volatile("s_waitcnt lgkmcnt(" #n ")" ::: "memory")
#define PG8_BAR __builtin_amdgcn_s_barrier()
#define PG8_SCHED __builtin_amdgcn_sched_barrier(0)
    Unit cur, nxt; int ui = 0;
    if (!S.next(0, cur)) return;
    Acc acc;
#pragma unroll
    for (int a = 0; a < 2; ++a)
#pragma unroll
        for (int b = 0; b < 2; ++b)
#pragma unroll
            for (int m = 0; m < 4; ++m)
#pragma unroll
                for (int n = 0; n < 2; ++n) acc[a][b][m][n] = (f32x4){0.f, 0.f, 0.f, 0.f};
    bf16x8 At[4][2], B0[2][2], B1[2][2];
    const char* cA = (const char*)g.A + (size_t)cur.pm * tstepA; const char* cB = (const char*)g.Bt + (size_t)cur.pn * tstepB;
    PG8_STAGE(PG8_SB(0, 0), cB, voffB); PG8_STAGE(PG8_SB(0, 1), cB + hstepB, voffB); PG8_STAGE(PG8_SA(0, 0), cA, voffA); PG8_STAGE(PG8_SA(0, 1), cA + hstepA, voffA);
    if (wr == 1) PG8_BAR;
    PG8_WAIT_V(2); PG8_BAR;
    PG8_STAGE(PG8_SB(1, 0), cB + kstep, voffB); PG8_STAGE(PG8_SA(1, 0), cA + kstep, voffA); PG8_STAGE(PG8_SB(1, 1), cB + hstepB + kstep, voffB);
    PG8_WAIT_V(6); PG8_BAR;
    for (;;) {
        const bool has_next = S.next(ui + 1, nxt);
        const char* nA = has_next ? (const char*)g.A + (size_t)nxt.pm * tstepA : cA; const char* nB = has_next ? (const char*)g.Bt + (size_t)nxt.pn * tstepB : cB;
#pragma unroll 1
        for (int t = 0; t < nt; t += 2) {
            const bool last = (t == nt - 2);
            const char* a1 = cA + (size_t)(t + 1) * kstep;
            const char* a2 = last ? nA : cA + (size_t)(t + 2) * kstep; const char* b2 = last ? nB : cB + (size_t)(t + 2) * kstep;
            const char* a3 = a2 + kstep; const char* b3 = b2 + kstep;
            PG8_LDB(B0, 0, 0); PG8_LDB(B1, 0, 1); PG8_SCHED; PG8_LDA(At, 0, 0); PG8_STAGE(PG8_SA(1, 1), a1 + hstepA, voffA);
            PG8_WAIT_V(8); PG8_WAIT_L(0); PG8_BAR; PG8_MMA(0, 0, At, B0); PG8_MMA(0, 1, At, B1); PG8_BAR; PG8_SCHED;
            PG8_LDA(At, 0, 1); PG8_STAGE(PG8_SB(0, 0), b2, voffB); PG8_STAGE(PG8_SB(0, 1), b2 + hstepB, voffB); PG8_STAGE(PG8_SA(0, 0), a2, voffA);
            PG8_WAIT_V(8); PG8_WAIT_L(0); PG8_BAR; PG8_MMA(1, 0, At, B0); PG8_MMA(1, 1, At, B1); PG8_BAR; PG8_SCHED;
            PG8_LDB(B0, 1, 0); PG8_LDB(B1, 1, 1); PG8_SCHED; PG8_LDA(At, 1, 0); PG8_STAGE(PG8_SA(0, 1), a2 + hstepA, voffA);
            PG8_WAIT_V(8); PG8_WAIT_L(0); PG8_BAR; PG8_MMA(0, 0, At, B0); PG8_MMA(0, 1, At, B1); PG8_BAR; PG8_SCHED;
            PG8_LDA(At, 1, 1); PG8_STAGE(PG8_SB(1, 0), b3, voffB); PG8_STAGE(PG8_SB(1, 1), b3 + hstepB, voffB); PG8_STAGE(PG8_SA(1, 0), a3, voffA);
            PG8_WAIT_V(8); PG8_WAIT_L(0); PG8_BAR; PG8_MMA(1, 0, At, B0); PG8_MMA(1, 1, At, B1); PG8_BAR; PG8_SCHED;
        }
        if (wr == 0) PG8_BAR;
        E(acc, cur, wr, wc, fr, fq, aux, wid, lane);
        if (!has_next) break;
#pragma unroll
        for (int a = 0; a < 2; ++a)
#pragma unroll
            for (int b = 0; b < 2; ++b)
#pragma unroll
                for (int m = 0; m < 4; ++m)
#pragma unroll
                    for (int n = 0; n < 2; ++n) acc[a][b][m][n] = (f32x4){0.f, 0.f, 0.f, 0.f};
        cur = nxt; cA = nA; cB = nB; ++ui;
        if (wr == 1) PG8_BAR;
    }
    PG8_WAIT_V(0);
    PG8_BAR;
#undef PG8_SA
#undef PG8_SB
#undef PG8_STAGE
#undef PG8_LDA
#undef PG8_LDB
#undef PG8_MMA
#undef PG8_SCHED
}
}
using pg8::Acc; using pg8::Unit;

#define EPI_ARGS const Acc& acc, const Unit& u, int wr, int wc, int fr_, int fq_, LAS unsigned char* aux, int wid, int lane
#define EPI_OPAQUE int fr = fr_, fq = fq_; asm volatile("" : "+v"(fr), "+v"(fq));
#define ROWLOOP for (int ai = 0; ai < 2; ++ai) _Pragma("unroll") for (int m = 0; m < 4; ++m)

__device__ __forceinline__ float fq_sum(float s) { s += __shfl_xor(s, 16); s += __shfl_xor(s, 32); return s; }
__device__ __forceinline__ float sq4(const f32x4 v) { return (v[0] * v[0] + v[1] * v[1]) + (v[2] * v[2] + v[3] * v[3]); }

struct EpiG1 {
    const float* inv_x; bf16_t *U, *QL, *CKV, *KPE, *SGS, *SGM; float *ssq_q, *ssq_kv, *ssq_kpe; const float *rcos, *rsin; const float* k_norm; int dry;
    __device__ __forceinline__ void operator()(EPI_ARGS) const {
        EPI_OPAQUE
        const int pn = u.pn, cw = wc * 32 + 8 * fq;
#pragma unroll
        ROWLOOP {
            const int row = u.pm * 256 + ai * 128 + wr * 64 + m * 16 + fr; const float s = inv_x[row];
            f32x4 v[2][2];
#pragma unroll
            for (int bj = 0; bj < 2; ++bj)
#pragma unroll
                for (int n = 0; n < 2; ++n) v[bj][n] = acc[ai][bj][m][n] * s;
            if (pn < 2) {
#pragma unroll
                for (int bj = 0; bj < 2; ++bj) *(u32x4*)(U + (size_t)row * 512 + pn * 256 + bj * 128 + cw) = pack8(v[bj][0], v[bj][1]);
            } else if (pn == 2) {
#pragma unroll
                for (int bj = 0; bj < 2; ++bj) *(u32x4*)(QL + (size_t)row * 384 + bj * 128 + cw) = pack8(v[bj][0], v[bj][1]);
                const float q = fq_sum(sq4(v[0][0]) + sq4(v[0][1]) + sq4(v[1][0]) + sq4(v[1][1]));
                if (fq == 0 && !dry) atomicAdd(ssq_q + row, q);
            } else if (pn == 3) {
                *(u32x4*)(QL + (size_t)row * 384 + 256 + cw) = pack8(v[0][0], v[0][1]);
                *(u32x4*)(CKV + (size_t)row * 256 + cw) = pack8(v[1][0], v[1][1]);
                const float q = fq_sum(sq4(v[0][0]) + sq4(v[0][1])), k = fq_sum(sq4(v[1][0]) + sq4(v[1][1]));
                if (fq == 0 && !dry) { atomicAdd(ssq_q + row, q); atomicAdd(ssq_kv + row, k); }
            } else if (pn == 4) {
                *(u32x4*)(CKV + (size_t)row * 256 + 128 + cw) = pack8(v[0][0], v[0][1]);
                const float k = fq_sum(sq4(v[0][0]) + sq4(v[0][1]));
                if (fq == 0 && !dry) atomicAdd(ssq_kv + row, k);
                if (wc < 2) {
                    const int i0 = 16 * wc + 4 * fq;
                    const f32x4 c = *(const f32x4*)(rcos + (size_t)row * 32 + i0), sn = *(const f32x4*)(rsin + (size_t)row * 32 + i0);
                    const f32x4 g1 = *(const f32x4*)(k_norm + 128 + i0), g2 = *(const f32x4*)(k_norm + 160 + i0);
                    const f32x4 x1 = v[1][0] * g1, x2 = v[1][1] * g2;
                    const f32x4 r1 = x1 * c - x2 * sn, r2 = x2 * c + x1 * sn;
                    *(u32x4*)(KPE + (size_t)row * 64 + cw) = pack8(r1, r2);
                    const float p = fq_sum(sq4(v[1][0]) + sq4(v[1][1]));
                    if (fq == 0 && !dry) atomicAdd(ssq_kpe + row, p);
                }
            } else {
                bf16_t* G = (pn < 9) ? SGS : SGM; const int c0 = ((pn < 9) ? (pn - 5) : (pn - 9)) * 256;
#pragma unroll
                for (int bj = 0; bj < 2; ++bj) { f32x4 a, b;
#pragma unroll
                    for (int j = 0; j < 4; ++j) { a[j] = fast_sigmoid(v[bj][0][j]); b[j] = fast_sigmoid(v[bj][1][j]); }
                    *(u32x4*)(G + (size_t)row * 1024 + c0 + bj * 128 + cw) = pack8(a, b); }
            }
        }
    }
};

__device__ __forceinline__ void row_reduce4(const float (&part)[2][4], float (&tot)[2][4], int wr, int wc, int fr, int fq, LAS unsigned char* aux) {
    LAS float* red = (LAS float*)aux;
#pragma unroll
    ROWLOOP { const float s = fq_sum(part[ai][m]); if (fq == 0) red[(ai * 128 + wr * 64 + m * 16 + fr) * 4 + wc] = s; }
    asm volatile("s_waitcnt lgkmcnt(0)" ::: "memory"); __builtin_amdgcn_s_barrier(); asm volatile("" ::: "memory");
#pragma unroll
    ROWLOOP { const f32x4 t = *(const LAS f32x4*)(red + (ai * 128 + wr * 64 + m * 16 + fr) * 4); tot[ai][m] = (t[0] + t[1]) + (t[2] + t[3]); }
    asm volatile("s_waitcnt lgkmcnt(0)" ::: "memory"); __builtin_amdgcn_s_barrier(); asm volatile("" ::: "memory");
}

struct EpiQ {
    const float* ssq_q; const float *rcos, *rsin; const float* q_norm; bf16_t* Q;
    __device__ __forceinline__ void operator()(EPI_ARGS) const {
        EPI_OPAQUE
        const int h = u.pn, cw = wc * 32 + 8 * fq;
        float part[2][4], tot[2][4], rs[2][4];
#pragma unroll
        ROWLOOP { const int row = u.pm * 256 + ai * 128 + wr * 64 + m * 16 + fr; const float s = __builtin_amdgcn_rsqf(ssq_q[row] * (1.f / 384.f) + 1e-6f); rs[ai][m] = s;
            part[ai][m] = (sq4(acc[ai][0][m][0]) + sq4(acc[ai][0][m][1]) + sq4(acc[ai][1][m][0]) + sq4(acc[ai][1][m][1])) * s * s; }
        row_reduce4(part, tot, wr, wc, fr, fq, aux);
        const f32x4 g0 = *(const f32x4*)(q_norm + cw), g1 = *(const f32x4*)(q_norm + cw + 4);
        const int i0 = 16 * (wc & 1) + 4 * fq;
        const f32x4 gr1 = *(const f32x4*)(q_norm + 128 + i0), gr2 = *(const f32x4*)(q_norm + 160 + i0);
#pragma unroll
        ROWLOOP { const int row = u.pm * 256 + ai * 128 + wr * 64 + m * 16 + fr;
            const float f = rs[ai][m] * __builtin_amdgcn_rsqf(tot[ai][m] * (1.f / 192.f) + 1e-6f) * QSCALE;
            const int b = row / TOK, l = row % TOK; bf16_t* qrow = Q + ((size_t)(b * 8 + h) * TOK + l) * 192;
            *(u32x4*)(qrow + cw) = pack8(acc[ai][0][m][0] * f * g0, acc[ai][0][m][1] * f * g1);
            if (wc < 2) {
                const f32x4 c = *(const f32x4*)(rcos + (size_t)row * 32 + i0), sn = *(const f32x4*)(rsin + (size_t)row * 32 + i0);
                const f32x4 x1 = acc[ai][1][m][0] * f * gr1, x2 = acc[ai][1][m][1] * f * gr2;
                *(u32x4*)(qrow + 128 + cw) = pack8(x1 * c - x2 * sn, x2 * c + x1 * sn);
            }
            asm volatile("" ::: "memory");
        }
    }
};

struct EpiKV {
    const float *ssq_kv, *ssq_kpe; const float* k_norm; const bf16_t* KPE; bf16_t *K, *V;
    __device__ __forceinline__ void operator()(EPI_ARGS) const {
        EPI_OPAQUE
        const int h = u.pn, cw = wc * 32 + 8 * fq;
        float part[2][4], tot[2][4], rs[2][4];
#pragma unroll
        ROWLOOP { const int row = u.pm * 256 + ai * 128 + wr * 64 + m * 16 + fr; const float s = __builtin_amdgcn_rsqf(ssq_kv[row] * (1.f / 256.f) + 1e-6f); rs[ai][m] = s;
            part[ai][m] = (sq4(acc[ai][0][m][0]) + sq4(acc[ai][0][m][1])) * s * s; }
        row_reduce4(part, tot, wr, wc, fr, fq, aux);
        const f32x4 g0 = *(const f32x4*)(k_norm + cw), g1 = *(const f32x4*)(k_norm + cw + 4);
#pragma unroll
        ROWLOOP { const int row = u.pm * 256 + ai * 128 + wr * 64 + m * 16 + fr;
            const float ik = __builtin_amdgcn_rsqf((tot[ai][m] + ssq_kpe[row]) * (1.f / 192.f) + 1e-6f), f = rs[ai][m] * ik;
            const int b = row / TOK, l = row % TOK; const size_t tl = (size_t)(b * 8 + h) * 64 + (l >> 6); const int kv = l & 63;
            bf16_t* kt = K + tl * 12288 + kv * 8;
            *(u32x4*)(kt + (4 * wc + fq) * 512) = pack8(acc[ai][0][m][0] * f * g0, acc[ai][0][m][1] * f * g1);
            if (wc < 2) { const u32x4 w = *(const u32x4*)(KPE + (size_t)row * 64 + cw); f32x4 a, c; unpack8(w, a, c);
                *(u32x4*)(kt + (16 + 4 * wc + fq) * 512) = pack8(a * ik, c * ik); }
            *(u32x4*)(V + tl * 8192 + wc * 2048 + kv * 32 + fq * 8) = pack8(acc[ai][1][m][0] * rs[ai][m], acc[ai][1][m][1] * rs[ai][m]);
            asm volatile("" ::: "memory");
        }
    }
};

struct EpiGlu {
    const bf16_t* Z; const float* bias; bf16_t* Z2;
    __device__ __forceinline__ void operator()(EPI_ARGS) const {
        EPI_OPAQUE
#pragma unroll
        for (int bj = 0; bj < 2; ++bj) { const int col = u.pn * 256 + bj * 128 + wc * 32 + 8 * fq;
            const f32x4 b0 = *(const f32x4*)(bias + col), b1 = *(const f32x4*)(bias + col + 4);
#pragma unroll
            ROWLOOP { const int row = u.pm * 256 + ai * 128 + wr * 64 + m * 16 + fr;
                f32x4 z0, z1; unpack8(*(const u32x4*)(Z + (size_t)row * 512 + col), z0, z1);
                f32x4 o0, o1;
#pragma unroll
                for (int j = 0; j < 4; ++j) { o0[j] = z0[j] * fast_sigmoid(acc[ai][bj][m][0][j] + b0[j]); o1[j] = z1[j] * fast_sigmoid(acc[ai][bj][m][1][j] + b1[j]); }
                *(u32x4*)(Z2 + (size_t)row * 512 + col) = pack8(o0, o1); }
        }
    }
};
template <bool SECOND> struct EpiMix {
    const bf16_t* SG; bf16_t* T1;
    __device__ __forceinline__ void operator()(EPI_ARGS) const {
        EPI_OPAQUE
#pragma unroll
        for (int bj = 0; bj < 2; ++bj) { const int col = u.pn * 256 + bj * 128 + wc * 32 + 8 * fq;
#pragma unroll
            ROWLOOP { const size_t o = (size_t)(u.pm * 256 + ai * 128 + wr * 64 + m * 16 + fr) * 1024 + col;
                f32x4 s0, s1; unpack8(*(const u32x4*)(SG + o), s0, s1);
                f32x4 r0 = s0 * acc[ai][bj][m][0], r1 = s1 * acc[ai][bj][m][1];
                if (SECOND) { f32x4 t0, t1; unpack8(*(const u32x4*)(T1 + o), t0, t1); r0 += t0; r1 += t1; }
                *(u32x4*)(T1 + o) = pack8(r0, r1); }
        }
    }
};
struct EpiOut {
    const float* x; float* out; bf16_t* HB; float* ssq_h; int dry;
    __device__ __forceinline__ void operator()(EPI_ARGS) const {
        EPI_OPAQUE
#pragma unroll
        ROWLOOP { const int row = u.pm * 256 + ai * 128 + wr * 64 + m * 16 + fr; float q = 0.f;
#pragma unroll
            for (int bj = 0; bj < 2; ++bj) { const size_t o = (size_t)row * 1024 + u.pn * 256 + bj * 128 + wc * 32 + 8 * fq;
                const f32x4 h0 = *(const f32x4*)(x + o) + acc[ai][bj][m][0], h1 = *(const f32x4*)(x + o + 4) + acc[ai][bj][m][1];
                *(u32x4*)(HB + o) = pack8(h0, h1); q += sq4(h0) + sq4(h1); }
            q = fq_sum(q); if (fq == 0 && !dry) atomicAdd(ssq_h + row, q); }
    }
};
struct EpiUp {
    const float* ssq_h; bf16_t* HID;
    __device__ __forceinline__ void operator()(EPI_ARGS) const {
        EPI_OPAQUE
#pragma unroll
        ROWLOOP { const int row = u.pm * 256 + ai * 128 + wr * 64 + m * 16 + fr; const float s = __builtin_amdgcn_rsqf(ssq_h[row] * (1.f / 1024.f) + 1e-6f);
#pragma unroll
            for (int bj = 0; bj < 2; ++bj) { f32x4 a, b;
#pragma unroll
                for (int j = 0; j < 4; ++j) { const float p = fmaxf(acc[ai][bj][m][0][j] * s, 0.f), q = fmaxf(acc[ai][bj][m][1][j] * s, 0.f); a[j] = p * p; b[j] = q * q; }
                *(u32x4*)(HID + (size_t)row * 4096 + u.pn * 256 + bj * 128 + wc * 32 + 8 * fq) = pack8(a, b); } }
    }
};
struct EpiDown {
    const bf16_t* HB; float* out; float sc;
    __device__ __forceinline__ void operator()(EPI_ARGS) const {
        EPI_OPAQUE
#pragma unroll
        ROWLOOP { const int row = u.pm * 256 + ai * 128 + wr * 64 + m * 16 + fr;
#pragma unroll
            for (int bj = 0; bj < 2; ++bj) { const size_t o = (size_t)row * 1024 + u.pn * 256 + bj * 128 + wc * 32 + 8 * fq;
                f32x4 h0, h1; unpack8(*(const u32x4*)(HB + o), h0, h1);
                *(f32x4*)(out + o) = h0 + acc[ai][bj][m][0] * sc; *(f32x4*)(out + o + 4) = h1 + acc[ai][bj][m][1] * sc; } }
    }
};
#define XB_TMO      128
#define XB_XCNT(j)  (256  + 64 * (j))
#define XB_XSUB(j)  (1280 + 64 * (j))
#define XB_XGEN(j)  (2304 + 64 * (j))
#define XB_TOP      3328
#define XB_TOPGEN   3392
#define XCD_BAR_WORDS 3456
#define XB_SPIN_CAP (1u << 18)
__device__ __forceinline__ unsigned xb_ld(unsigned* p)              { return __hip_atomic_load(p, __ATOMIC_RELAXED, __HIP_MEMORY_SCOPE_AGENT); }
__device__ __forceinline__ unsigned xb_add(unsigned* p, unsigned v) { return __hip_atomic_fetch_add(p, v, __ATOMIC_RELAXED, __HIP_MEMORY_SCOPE_AGENT); }
__device__ __forceinline__ unsigned xb_xcc_id() { return (unsigned)__builtin_amdgcn_s_getreg((3 << 11) | 20) & 0xFu; }
#define XB_SPIN(cond, bar) do { unsigned _sp = 0; while (cond) { __builtin_amdgcn_s_sleep(1); \
    if ((++_sp & 255u) == 0u) { if (xb_ld(&(bar)[XB_TMO])) break; if (_sp > XB_SPIN_CAP) { atomicAdd(&(bar)[XB_TMO], 1u); break; } } } } while (0)
struct XcdBarrier { unsigned* bar; unsigned x; volatile LAS unsigned* st; };
__device__ __forceinline__ XcdBarrier xcd_barrier_post(unsigned* bar, volatile LAS unsigned* st) {
    XcdBarrier b; b.bar = bar; b.x = xb_xcc_id(); b.st = st;
    if (threadIdx.x == 0) (void)xb_add(&bar[XB_XCNT(b.x)], 1u);
    return b;
}
__device__ __forceinline__ void xcd_barrier_complete(unsigned* bar, unsigned x, unsigned& nloc, unsigned& nx) {
    const unsigned G = gridDim.x * gridDim.y * gridDim.z;
    unsigned sum, cnt, mine, sp = 0u;
    for (;;) {
        sum = 0u; cnt = 0u; mine = 0u;
#pragma unroll
        for (unsigned j = 0; j < 16; ++j) { const unsigned c = xb_ld(&bar[XB_XCNT(j)]); sum += c; cnt += (c > 0u) ? 1u : 0u; mine = (j == x) ? c : mine; }
        if (sum == G) break;
        __builtin_amdgcn_s_sleep(1);
        if ((++sp & 255u) == 0u) { if (xb_ld(&bar[XB_TMO])) break; if (sp > XB_SPIN_CAP) { atomicAdd(&bar[XB_TMO], 1u); break; } }
    }
    nloc = mine > 0u ? mine : 1u; nx = cnt > 0u ? cnt : 1u;
}
__device__ __forceinline__ void xcd_barrier(const XcdBarrier& b) {
    asm volatile("s_waitcnt vmcnt(0)" ::: "memory");
    __syncthreads();
    if (threadIdx.x == 0) {
        unsigned* bar = b.bar;
        __builtin_amdgcn_s_waitcnt(0);
        unsigned nloc = b.st[0], nx = b.st[1];
        if (nloc == 0u) { xcd_barrier_complete(bar, b.x, nloc, nx); b.st[0] = nloc; b.st[1] = nx; }
        const unsigned old = xb_add(&bar[XB_XSUB(b.x)], 1u);
        const unsigned gen = old / nloc;
        if (old + 1u == (gen + 1u) * nloc) {
            __builtin_amdgcn_fence(__ATOMIC_RELEASE, "agent");
            asm volatile("s_waitcnt vmcnt(0)" ::: "memory");
            const unsigned og = xb_add(&bar[XB_TOP], 1u);
            const unsigned tg = og / nx;
            if (og + 1u == (tg + 1u) * nx) xb_add(&bar[XB_TOPGEN], 1u);
            else XB_SPIN(xb_ld(&bar[XB_TOPGEN]) == tg, bar);
            __builtin_amdgcn_fence(__ATOMIC_ACQUIRE, "agent");
            xb_add(&bar[XB_XGEN(b.x)], 1u);
            asm volatile("s_waitcnt vmcnt(0)" ::: "memory");
        } else {
            XB_SPIN(xb_ld(&bar[XB_XGEN(b.x)]) == gen, bar);
            __builtin_amdgcn_fence(__ATOMIC_ACQUIRE, "agent");
            asm volatile("s_waitcnt vmcnt(0)" ::: "memory");
        }
    }
    __syncthreads();
}

__device__ __forceinline__ void ctr_barrier(unsigned* ctr, unsigned* tmo, unsigned& epoch) {
    __threadfence();
    __syncthreads();
    ++epoch;
    if (threadIdx.x == 0) {
        const unsigned target = epoch * gridDim.x;
        xb_add(ctr, 1u);
        unsigned sp = 0;
        while (xb_ld(ctr) < target) { __builtin_amdgcn_s_sleep(1); if ((++sp & 1023u) == 0u) { if (sp > (1u << 22)) { atomicAdd(tmo, 1u); break; } } }
    }
    __syncthreads();
    __threadfence();
}
namespace att {
constexpr int KSLOT = 24576, VSLOT = 16384, NSLOT = 3;
constexpr int LDS_K = 0, LDS_V = NSLOT * KSLOT, LDS_WS = LDS_V + NSLOT * VSLOT, LDS_END = LDS_WS + 8 * 256;
__device__ __forceinline__ int crow(int r, int hi) { return (r & 3) + 8 * (r >> 2) + 4 * hi; }
__device__ __forceinline__ s16x4 vtr(const LAS unsigned char* p) { typedef short v4i16_t __attribute__((ext_vector_type(4))); return __builtin_bit_cast(s16x4, __builtin_amdgcn_ds_read_tr16_b64_v4i16((LAS v4i16_t*)p)); }
#define ATT_WAIT_V(n) asm volatile("s_waitcnt vmcnt(" #n ")" ::: "memory")

__device__ __forceinline__ void attn_unit(int bh, int qb, const bf16_t* Qg, const bf16_t* Kg, const bf16_t* Vg, bf16_t* Og, LAS unsigned char* lds) {
    const int tid = threadIdx.x, lane = tid & 63, r32 = lane & 31, hi = lane >> 5; const int wid = __builtin_amdgcn_readfirstlane(tid >> 6);
    const bool late = wid >= 4;
    const int b = bh >> 3, h = bh & 7;
    const int NT = 4 * (qb + 1);
    const char* kbase = (const char*)Kg + (size_t)bh * 64 * KSLOT + lane * 16;
    const char* vbase = (const char*)Vg + (size_t)bh * 64 * VSLOT + lane * 16;
    LAS float* wsf = (LAS float*)(lds + LDS_WS) + wid * 64;
#define ATT_ISSUE_K(t, slot) do { _Pragma("unroll") for (int _p = 0; _p < 3; ++_p) __builtin_amdgcn_global_load_lds((const unsigned*)(kbase + (size_t)(t) * KSLOT + (wid + 8 * _p) * 1024), (LAS unsigned*)(lds + LDS_K + (slot) * KSLOT + (wid + 8 * _p) * 1024), 16, 0, 0); } while (0)
#define ATT_ISSUE_V(t, slot) do { _Pragma("unroll") for (int _p = 0; _p < 2; ++_p) __builtin_amdgcn_global_load_lds((const unsigned*)(vbase + (size_t)(t) * VSLOT + (wid + 8 * _p) * 1024), (LAS unsigned*)(lds + LDS_V + (slot) * VSLOT + (wid + 8 * _p) * 1024), 16, 0, 0); } while (0)
    const bf16_t* qrow = Qg + ((size_t)bh * TOK + qb * 256 + wid * 32 + r32) * 192 + hi * 8;
    bf16x8 qf[12];
#pragma unroll
    for (int d0 = 0; d0 < 12; ++d0) qf[d0] = *(const bf16x8*)(qrow + d0 * 16);
    ATT_ISSUE_K(0, 0); ATT_ISSUE_V(0, 0); ATT_ISSUE_K(1, 1);
    float mrow = -1e30f, lsum = 0.f;
    f32x16 o[4];
#pragma unroll
    for (int d = 0; d < 4; ++d) o[d] = (f32x16){0.f, 0.f, 0.f, 0.f, 0.f, 0.f, 0.f, 0.f, 0.f, 0.f, 0.f, 0.f, 0.f, 0.f, 0.f, 0.f};
    const int qrel = wid * 32 + r32;
    u32x4 pw[4] = {(u32x4){0u, 0u, 0u, 0u}, (u32x4){0u, 0u, 0u, 0u}, (u32x4){0u, 0u, 0u, 0u}, (u32x4){0u, 0u, 0u, 0u}};
    bool pvalid = false;
    const LAS unsigned char* vp0 = lds + LDS_V + ((lane >> 4) & 1) * 32 + (lane & 3) * 8 + (4 * hi + ((lane & 15) >> 2)) * 64;
#define ATT_PV(vslot) do { const LAS unsigned char* vp = vp0 + (vslot) * VSLOT; \
        _Pragma("unroll") for (int d = 0; d < 4; ++d) _Pragma("unroll") for (int ks = 0; ks < 4; ++ks) { \
            const s16x4 lo = vtr(vp + d * 4096 + ks * 1024), hv = vtr(vp + d * 4096 + ks * 1024 + 512); \
            const bf16x8 vf = (bf16x8){lo[0], lo[1], lo[2], lo[3], hv[0], hv[1], hv[2], hv[3]}; \
            o[d] = __builtin_amdgcn_mfma_f32_32x32x16_bf16(__builtin_bit_cast(bf16x8, pw[ks]), vf, o[d], 0, 0, 0); } } while (0)
    int s0 = 0, sm1 = 2;
    for (int t = 0; t <= NT; ++t) {
        if (t + 1 < NT) ATT_WAIT_V(3); else ATT_WAIT_V(0);
        __builtin_amdgcn_s_barrier(); asm volatile("" ::: "memory");
        const int s1 = (s0 == 2) ? 0 : s0 + 1;
        if (t + 1 < NT) ATT_ISSUE_V(t + 1, s1);
        if (t + 2 < NT) ATT_ISSUE_K(t + 2, sm1);
        if (late && pvalid) { ATT_PV(sm1); pvalid = false; }
        const int jb = t - (NT - 4);
        if (t < NT && (jb <= 0 || 64 * jb <= wid * 32 + 31)) {
            f32x16 p0 = (f32x16){0.f, 0.f, 0.f, 0.f, 0.f, 0.f, 0.f, 0.f, 0.f, 0.f, 0.f, 0.f, 0.f, 0.f, 0.f, 0.f}, p1 = p0;
            const LAS unsigned char* kp = lds + LDS_K + s0 * KSLOT + hi * 1024 + r32 * 16;
#pragma unroll
            for (int d0 = 0; d0 < 12; ++d0) {
                const bf16x8 k0 = *(const LAS bf16x8*)(kp + d0 * 2048), k1 = *(const LAS bf16x8*)(kp + d0 * 2048 + 512);
                p0 = __builtin_amdgcn_mfma_f32_32x32x16_bf16(k0, qf[d0], p0, 0, 0, 0);
                p1 = __builtin_amdgcn_mfma_f32_32x32x16_bf16(k1, qf[d0], p1, 0, 0, 0);
            }
            if (jb >= 0) {
                const int kb = 64 * jb + 4 * hi;
#pragma unroll
                for (int r = 0; r < 16; ++r) { const int kv = kb + (r & 3) + 8 * (r >> 2); if (kv > qrel) p0[r] = -INFINITY; if (kv + 32 > qrel) p1[r] = -INFINITY; }
            }
            float rm = fmaxf(p0[0], p1[0]);
#pragma unroll
            for (int r = 1; r < 16; ++r) rm = fmaxf(rm, fmaxf(p0[r], p1[r]));
            { auto rr = __builtin_amdgcn_permlane32_swap(__float_as_uint(rm), __float_as_uint(rm), false, false); rm = fmaxf(__uint_as_float(rr[0]), __uint_as_float(rr[1])); }
            const float mnew = fmaxf(mrow, rm);
            if (__any(mnew > mrow)) {
                const float alpha = __builtin_amdgcn_exp2f(mrow - mnew); lsum *= alpha; mrow = mnew;
                if (hi == 0) wsf[r32] = alpha;
                asm volatile("s_waitcnt lgkmcnt(0)" ::: "memory");
#pragma unroll
                for (int r = 0; r < 16; ++r) { const float a = wsf[crow(r, hi)];
#pragma unroll
                    for (int d = 0; d < 4; ++d) o[d][r] *= a; }
            }
            float ps = 0.f;
#pragma unroll
            for (int r = 0; r < 16; ++r) { p0[r] = __builtin_amdgcn_exp2f(p0[r] - mrow); p1[r] = __builtin_amdgcn_exp2f(p1[r] - mrow); ps += p0[r] + p1[r]; }
            lsum += ps;
#pragma unroll
            for (int k = 0; k < 2; ++k) {
                pw[k] = (u32x4){cvt_pk_bf16(p0[8 * k], p0[8 * k + 1]), cvt_pk_bf16(p0[8 * k + 2], p0[8 * k + 3]), cvt_pk_bf16(p0[8 * k + 4], p0[8 * k + 5]), cvt_pk_bf16(p0[8 * k + 6], p0[8 * k + 7])};
                pw[2 + k] = (u32x4){cvt_pk_bf16(p1[8 * k], p1[8 * k + 1]), cvt_pk_bf16(p1[8 * k + 2], p1[8 * k + 3]), cvt_pk_bf16(p1[8 * k + 4], p1[8 * k + 5]), cvt_pk_bf16(p1[8 * k + 6], p1[8 * k + 7])};
            }
            if (late) pvalid = true; else ATT_PV(s0);
        }
        sm1 = s0; s0 = s1;
    }
    { auto rr = __builtin_amdgcn_permlane32_swap(__float_as_uint(lsum), __float_as_uint(lsum), false, false); lsum = __uint_as_float(rr[0]) + __uint_as_float(rr[1]); }
    if (hi == 0) wsf[32 + r32] = lsum;
    asm volatile("s_waitcnt lgkmcnt(0)" ::: "memory");
    bf16_t* orow = Og + ((size_t)b * TOK + qb * 256 + wid * 32) * 1024 + h * 128 + r32;
#pragma unroll
    for (int r = 0; r < 16; ++r) { const int q = crow(r, hi); const float il = __builtin_amdgcn_rcpf(wsf[32 + q]);
#pragma unroll
        for (int d = 0; d < 4; ++d) { const unsigned w = cvt_pk_bf16(o[d][r] * il, 0.f); orow[(size_t)q * 1024 + d * 32] = (bf16_t)(w & 0xffffu); } }
    asm volatile("s_waitcnt lgkmcnt(0)" ::: "memory"); __builtin_amdgcn_s_barrier(); asm volatile("" ::: "memory");
#undef ATT_ISSUE_K
#undef ATT_ISSUE_V
#undef ATT_PV
}

__device__ __forceinline__ void attn_phase(const Params& p, LAS unsigned char* lds, int vcu, int G) {
    const int nitems = p.NB * 8 * 8;
    for (int it = vcu; it < nitems; it += G) {
        const int bh = it >> 3, s = it & 7;
        attn_unit(bh, s, p.Q, p.K, p.V, p.ATT, lds);
        attn_unit(bh, 15 - s, p.Q, p.K, p.V, p.ATT, lds);
    }
}
}
namespace ssm {
constexpr int CH = 256, NCH = TOK / CH, XROW = 272;
struct Cplx { float r, i; };
__device__ __forceinline__ Cplx cmul(Cplx a, Cplx b) { return {a.r * b.r - a.i * b.i, a.r * b.i + a.i * b.r}; }

template <bool OUT>
__device__ __forceinline__ void ssm_item(const Params& p, int item, LAS unsigned char* xt  ) {
    const int lane = threadIdx.x & 63, j = lane & 31, hi = lane >> 5;
    const int cp = item & 7, g = (item >> 3) & 31, b = item >> 8;
    const int chunk = 2 * cp + hi;
    const float* a_re = p.in[11]; const float* a_im = p.in[12]; const float* log_dt = p.in[13];
    const float* b_re = p.in[14]; const float* b_im = p.in[15]; const float* c_re = p.in[16]; const float* c_im = p.in[17]; const float* dsk = p.in[18];
    const float dt = expf(log_dt[g]);
    Cplx lam[2], fac[2];
#pragma unroll
    for (int k = 0; k < 2; ++k) { const int pp = g * 64 + 32 * k + j; const float ar = a_re[pp], ai = a_im[pp];
        const float mag = expf(ar * dt); lam[k] = {mag * cosf(ai * dt), mag * sinf(ai * dt)};
        const float nr = lam[k].r - 1.f, ni = lam[k].i, den = ar * ar + ai * ai; fac[k] = {(nr * ar + ni * ai) / den, (ni * ar - nr * ai) / den}; }
    bf16x8 bfr[4];
#pragma unroll
    for (int k = 0; k < 2; ++k) { const int pp = g * 64 + 32 * k + j; float br[8], bi[8];
        const f32x4 r0 = *(const f32x4*)(b_re + pp * 16 + 8 * hi), r1 = *(const f32x4*)(b_re + pp * 16 + 8 * hi + 4);
        const f32x4 i0 = *(const f32x4*)(b_im + pp * 16 + 8 * hi), i1 = *(const f32x4*)(b_im + pp * 16 + 8 * hi + 4);
#pragma unroll
        for (int q = 0; q < 4; ++q) { br[q] = r0[q]; br[4 + q] = r1[q]; bi[q] = i0[q]; bi[4 + q] = i1[q]; }
        u32x4 wr_, wi_;
#pragma unroll
        for (int q = 0; q < 4; ++q) { const float ar0 = fac[k].r * br[2 * q] - fac[k].i * bi[2 * q], ar1 = fac[k].r * br[2 * q + 1] - fac[k].i * bi[2 * q + 1];
            const float ai0 = fac[k].r * bi[2 * q] + fac[k].i * br[2 * q], ai1 = fac[k].r * bi[2 * q + 1] + fac[k].i * br[2 * q + 1];
            wr_[q] = cvt_pk_bf16(ar0, ar1); wi_[q] = cvt_pk_bf16(ai0, ai1); }
        bfr[2 * k] = __builtin_bit_cast(bf16x8, wr_); bfr[2 * k + 1] = __builtin_bit_cast(bf16x8, wi_); }
    const int hA = (j >> 2) & 1, rA = (j & 3) + 4 * (j >> 3);
    const size_t rowA0 = (size_t)b * TOK + (size_t)(2 * cp + hA) * CH + rA;
    const bf16_t* ua = p.U + rowA0 * 512 + g * 16 + 8 * hi;
    Cplx x[2] = {{0.f, 0.f}, {0.f, 0.f}};
    bf16x8 cfr[8]; float dv[8];
    if (OUT) {
        Cplx l256[2];
#pragma unroll
        for (int k = 0; k < 2; ++k) { Cplx t = lam[k];
#pragma unroll
            for (int s = 0; s < 8; ++s) t = cmul(t, t);
            l256[k] = t; }
        const float* sl = p.sloc + ((size_t)(b * 32 + g) * NCH) * 128;
        for (int c = 0; c < 2 * cp + 1; ++c) { if (c < chunk) {
#pragma unroll
            for (int k = 0; k < 2; ++k) { const float2 s = *(const float2*)(sl + (size_t)c * 128 + (32 * k + j) * 2); const Cplx t = cmul(l256[k], x[k]); x[k] = {t.r + s.x, t.i + s.y}; } } }
#pragma unroll
        for (int ks = 0; ks < 8; ++ks) { u32x4 w = (u32x4){0u, 0u, 0u, 0u};
            if (j < 16) { const f32x4 cr = *(const f32x4*)(c_re + (g * 16 + j) * 64 + 8 * ks + 4 * hi), ci = *(const f32x4*)(c_im + (g * 16 + j) * 64 + 8 * ks + 4 * hi);
#pragma unroll
                for (int q = 0; q < 4; ++q) w[q] = cvt_pk_bf16(cr[q], -ci[q]); }
            cfr[ks] = __builtin_bit_cast(bf16x8, w); }
#pragma unroll
        for (int q = 0; q < 8; ++q) dv[q] = dsk[g * 16 + 4 * hi + (q & 3) + 8 * (q >> 2)];
    }
    for (int tile = 0; tile < CH / 16; ++tile) {
        const bf16x8 af = *(const bf16x8*)(ua + (size_t)tile * 16 * 512);
        f32x16 bu[4];
#pragma unroll
        for (int q = 0; q < 4; ++q) bu[q] = __builtin_amdgcn_mfma_f32_32x32x16_bf16(af, bfr[q], (f32x16){0.f, 0.f, 0.f, 0.f, 0.f, 0.f, 0.f, 0.f, 0.f, 0.f, 0.f, 0.f, 0.f, 0.f, 0.f, 0.f}, 0, 0, 0);
#pragma unroll
        for (int r = 0; r < 16; ++r) {
#pragma unroll
            for (int k = 0; k < 2; ++k) { const float nr = fmaf(lam[k].r, x[k].r, fmaf(-lam[k].i, x[k].i, bu[2 * k][r])), ni = fmaf(lam[k].r, x[k].i, fmaf(lam[k].i, x[k].r, bu[2 * k + 1][r]));
                x[k] = {nr, ni}; if (OUT) { bu[2 * k][r] = nr; bu[2 * k + 1][r] = ni; } }
        }
        if (OUT) {
#pragma unroll
            for (int r = 0; r < 16; ++r) { LAS unsigned* rowp = (LAS unsigned*)(xt + (16 * hi + r) * XROW);
                rowp[j] = cvt_pk_bf16(bu[0][r], bu[1][r]); rowp[32 + j] = cvt_pk_bf16(bu[2][r], bu[3][r]); }
            asm volatile("s_waitcnt lgkmcnt(0)" ::: "memory");
            f32x16 y = (f32x16){0.f, 0.f, 0.f, 0.f, 0.f, 0.f, 0.f, 0.f, 0.f, 0.f, 0.f, 0.f, 0.f, 0.f, 0.f, 0.f};
#pragma unroll
            for (int ks = 0; ks < 8; ++ks) { const bf16x8 xf = *(const LAS bf16x8*)(xt + j * XROW + (16 * ks + 8 * hi) * 2);
                y = __builtin_amdgcn_mfma_f32_32x32x16_bf16(cfr[ks], xf, y, 0, 0, 0); }
            const int hn = j >> 4, rn = j & 15;
            const size_t row = (size_t)b * TOK + (size_t)(2 * cp + hn) * CH + tile * 16 + rn;
#pragma unroll
            for (int q2 = 0; q2 < 2; ++q2) { const int c0 = 4 * hi + 8 * q2;
                const u32x2 uw = *(const u32x2*)(p.U + row * 512 + g * 16 + c0);
                const float u0 = bf_lo(uw.x), u1 = bf_hi(uw.x), u2 = bf_lo(uw.y), u3 = bf_hi(uw.y);
                const float z0 = gelu_t(y[4 * q2 + 0] + dv[4 * q2 + 0] * u0), z1 = gelu_t(y[4 * q2 + 1] + dv[4 * q2 + 1] * u1);
                const float z2 = gelu_t(y[4 * q2 + 2] + dv[4 * q2 + 2] * u2), z3 = gelu_t(y[4 * q2 + 3] + dv[4 * q2 + 3] * u3);
                *(u32x2*)(p.Z + row * 512 + g * 16 + c0) = (u32x2){cvt_pk_bf16(z0, z1), cvt_pk_bf16(z2, z3)}; }
            asm volatile("s_waitcnt lgkmcnt(0)" ::: "memory");
        }
    }
    if (!OUT) {
        float* sl = p.sloc + (((size_t)(b * 32 + g) * NCH + chunk) * 64) * 2;
#pragma unroll
        for (int k = 0; k < 2; ++k) *(float2*)(sl + (32 * k + j) * 2) = make_float2(x[k].r, x[k].i);
    }
}
template <bool OUT>
__device__ __forceinline__ void ssm_phase(const Params& p, LAS unsigned char* lds, int vcu, int G) {
    const int wid = __builtin_amdgcn_readfirstlane(threadIdx.x >> 6);
    const int nitems = p.NB * 32 * 8;
    for (int it = vcu * 8 + wid; it < nitems; it += G * 8) ssm_item<OUT>(p, it, lds + wid * (32 * XROW));
}
}
__device__ __forceinline__ int src_col(int mode, int n) {
    if (mode == 0) return n;
    if (mode == 1) { if (n < 1152) return n; if (n < 1216) return 1152 + dperm(n - 1152); if (n < 1280) return -1; if (n < 2304) return 1216 + (n - 1280); return 2240 + (n - 2304); }
    const int h = n >> 8, c = n & 255; if (c < 128) return 192 * h + c; if (c < 192) return 192 * h + 128 + dperm(c - 128); return -1;
}
__device__ __forceinline__ unsigned f2bf(float f) { unsigned u = __builtin_bit_cast(unsigned, f); return (u + 0x7fffu + ((u >> 16) & 1u)) >> 16; }
__device__ __forceinline__ unsigned pk2(float lo, float hi) { return f2bf(lo) | (f2bf(hi) << 16); }
__device__ __forceinline__ void p0_item(const float* W, int K, int Nsrc, const float* gain, bf16_t* WT, int nblk, int mode, LAS float* scr, int item, int lane) {
    const int kb = item / nblk, nb = item % nblk, k0 = 64 * kb, n0 = 32 * nb;
    const int sc = src_col(mode, n0 + (lane & 31));
#pragma unroll 8
    for (int i = 0; i < 32; ++i) { const int kk = 2 * i + (lane >> 5); float v = 0.f; if (sc >= 0) { v = W[(size_t)(k0 + kk) * Nsrc + sc]; if (gain) v *= gain[k0 + kk]; } scr[kk * 33 + (lane & 31)] = v; }
    asm volatile("s_waitcnt lgkmcnt(0)" ::: "memory");
    const int c = lane & 7;
#pragma unroll
    for (int jj = 0; jj < 4; ++jj) { const int n = (lane >> 3) + 8 * jj; const LAS float* s = scr + (8 * c) * 33 + n;
        u32x4 o; o.x = pk2(s[0 * 33], s[1 * 33]); o.y = pk2(s[2 * 33], s[3 * 33]); o.z = pk2(s[4 * 33], s[5 * 33]); o.w = pk2(s[6 * 33], s[7 * 33]);
        *(u32x4*)(WT + (size_t)(n0 + n) * K + k0 + 8 * c) = o; }
    asm volatile("s_waitcnt lgkmcnt(0)" ::: "memory");
}
__device__ __forceinline__ float wave_sum(float v) {
#pragma unroll
    for (int o = 1; o < 64; o <<= 1) v += __shfl_xor(v, o);
    return v;
}
__device__ __forceinline__ void p0_prologue(const Params& p, LAS unsigned char* lds, int vcu, int G) {
    const int lane = threadIdx.x & 63, wid = __builtin_amdgcn_readfirstlane(threadIdx.x >> 6);
    LAS float* scr = (LAS float*)(lds + wid * 16384);
    const int gw = vcu * 8 + wid, NGW = G * 8;
    constexpr int I1 = 16 * 104, IQ = 6 * 64, IKV = 4 * 64, IGL = 8 * 16, IOS = 8 * 32, IOM = 16 * 32, IOU = 16 * 32, IUP = 16 * 128, IDN = 64 * 32;
    constexpr int NITEMS = I1 + IQ + IKV + IGL + IOS + IOM + IOU + IUP + IDN;
    for (int it = gw; it < NITEMS; it += NGW) {
        int r = it;
        if (r < I1) { p0_item(p.in[3], 1024, 3264, p.in[2], p.W1t, 104, 1, scr, r, lane); continue; } r -= I1;
        if (r < IQ) { p0_item(p.in[6], 384, 1536, p.in[4], p.Wqt, 64, 2, scr, r, lane); continue; } r -= IQ;
        if (r < IKV) { p0_item(p.in[7], 256, 2048, p.in[5], p.Wkvt, 64, 0, scr, r, lane); continue; } r -= IKV;
        if (r < IGL) { p0_item(p.in[19], 512, 512, nullptr, p.Wglut, 16, 0, scr, r, lane); continue; } r -= IGL;
        if (r < IOS) { p0_item(p.in[21], 512, 1024, nullptr, p.Wost, 32, 0, scr, r, lane); continue; } r -= IOS;
        if (r < IOM) { p0_item(p.in[10], 1024, 1024, nullptr, p.Womt, 32, 0, scr, r, lane); continue; } r -= IOM;
        if (r < IOU) { p0_item(p.in[22], 1024, 1024, nullptr, p.Woutt, 32, 0, scr, r, lane); continue; } r -= IOU;
        if (r < IUP) { p0_item(p.in[24], 1024, 4096, p.in[23], p.Wupt, 128, 0, scr, r, lane); continue; } r -= IUP;
        p0_item(p.in[25], 4096, 1024, nullptr, p.Wdnt, 32, 0, scr, r, lane);
    }
    const int M = p.NB * TOK;
    for (int m0 = gw * 4; m0 < M; m0 += NGW * 4) {
        f32x4 v[4][4]; float s[4];
#pragma unroll
        for (int r = 0; r < 4; ++r) { const f32x4* xr = (const f32x4*)(p.x + (size_t)(m0 + r) * 1024) + lane;
#pragma unroll
            for (int jj = 0; jj < 4; ++jj) v[r][jj] = xr[64 * jj]; }
#pragma unroll
        for (int r = 0; r < 4; ++r) { s[r] = 0.f;
#pragma unroll
            for (int jj = 0; jj < 4; ++jj) s[r] += sq4(v[r][jj]);
            s[r] = wave_sum(s[r]);
            u32x2* o8 = (u32x2*)(p.XB + (size_t)(m0 + r) * 1024) + lane;
#pragma unroll
            for (int jj = 0; jj < 4; ++jj) o8[64 * jj] = (u32x2){cvt_pk_bf16(v[r][jj][0], v[r][jj][1]), cvt_pk_bf16(v[r][jj][2], v[r][jj][3])}; }
        if (lane < 4) { const int mm = m0 + lane; const float sv = lane == 0 ? s[0] : lane == 1 ? s[1] : lane == 2 ? s[2] : s[3];
            p.inv_x[mm] = rsqrtf(sv * (1.f / 1024.f) + 1e-6f); p.ssq_q[mm] = 0.f; p.ssq_kv[mm] = 0.f; p.ssq_kpe[mm] = 0.f; p.ssq_h[mm] = 0.f; }
        { const int mm = m0 + (lane >> 5) * 2, i = lane & 31;
#pragma unroll
          for (int r = 0; r < 2; ++r) { const float ang = (float)p.pos[mm + r] * p.inv_freq[i]; p.rcos[(size_t)(mm + r) * 32 + i] = cosf(ang); p.rsin[(size_t)(mm + r) * 32 + i] = sinf(ang); } }
    }
}

constexpr int LDS_RING = 131072, LDS_AUX = LDS_RING, LDS_BYTES = LDS_RING + 4096 + 256;
#ifndef MK_MODE
#define MK_MODE 0
#endif
namespace cg = cooperative_groups;
template <int K>
__device__ __forceinline__ void run_phase(const Params& p, LAS unsigned char* lds, LAS unsigned char* aux, int vcu, int G, int bx, int dry) {
    const int M = p.NB * TOK;
    if (K == 0) { p0_prologue(p, lds, vcu, G); __syncthreads(); }
    if (K == 1) {
        pg8::Gemm g{p.XB, 1024, p.W1t, 1024, M, 3328, 1024}; pg8::StaticOrder S; S.init(M, 3328, G, bx);
        EpiG1 E{p.inv_x, p.U, p.QL, p.CKV, p.kpe, p.SGS, p.SGM, p.ssq_q, p.ssq_kv, p.ssq_kpe, p.rcos, p.rsin, p.in[9], dry};
        pg8::gemm_phase(lds, aux, g, S, E);
    }
#ifndef MK_DUPSUB
#define MK_DUPSUB 7
#endif
#define SUBON(b) (!dry || (MK_DUPSUB & (b)))
    if (K == 2) {
        if (SUBON(4) && (vcu & 1)) { ssm::ssm_phase<false>(p, lds, vcu, G); __syncthreads(); }
        if (SUBON(1)) { pg8::Gemm g{p.QL, 384, p.Wqt, 384, M, 2048, 384}; pg8::StaticOrder S; S.init(M, 2048, G, bx);
          EpiQ E{p.ssq_q, p.rcos, p.rsin, p.in[8], p.Q}; pg8::gemm_phase(lds, aux, g, S, E); }
        if (SUBON(2)) { pg8::Gemm g{p.CKV, 256, p.Wkvt, 256, M, 2048, 256}; pg8::StaticOrder S; S.init(M, 2048, G, bx);
          EpiKV E{p.ssq_kv, p.ssq_kpe, p.in[9], p.kpe, p.K, p.V}; pg8::gemm_phase(lds, aux, g, S, E); }
        if (SUBON(4) && !(vcu & 1)) ssm::ssm_phase<false>(p, lds, vcu, G);
        __syncthreads();
    }
    if (K == 3) {
        if (SUBON(1)) att::attn_phase(p, lds, vcu, G);
        if (SUBON(2)) ssm::ssm_phase<true>(p, lds, vcu, G);
        __syncthreads();
    }
    if (K == 4) {
        pg8::Gemm g{p.Z, 512, p.Wglut, 512, M, 512, 512}; pg8::StaticOrder S; S.init(M, 512, G, bx);
        EpiGlu E{p.Z, p.in[20], p.Z2}; pg8::gemm_phase(lds, aux, g, S, E);
    }
    if (K == 5) {
        { pg8::Gemm g{p.Z2, 512, p.Wost, 512, M, 1024, 512}; pg8::StaticOrder S; S.init(M, 1024, G, bx);
          EpiMix<false> E{p.SGS, p.T1}; pg8::gemm_phase(lds, aux, g, S, E); }
        { pg8::Gemm g{p.ATT, 1024, p.Womt, 1024, M, 1024, 1024}; pg8::StaticOrder S; S.init(M, 1024, G, bx);
          EpiMix<true> E{p.SGM, p.T1}; pg8::gemm_phase(lds, aux, g, S, E); }
    }
    if (K == 6) {
        pg8::Gemm g{p.T1, 1024, p.Woutt, 1024, M, 1024, 1024}; pg8::StaticOrder S; S.init(M, 1024, G, bx);
        EpiOut E{p.x, p.out, p.HB, p.ssq_h, dry}; pg8::gemm_phase(lds, aux, g, S, E);
    }
    if (K == 7) {
        pg8::Gemm g{p.HB, 1024, p.Wupt, 1024, M, 4096, 1024}; pg8::StaticOrder S; S.init(M, 4096, G, bx);
        EpiUp E{p.ssq_h, p.HID}; pg8::gemm_phase(lds, aux, g, S, E);
    }
    if (K == 8) {
        pg8::Gemm g{p.HID, 4096, p.Wdnt, 4096, M, 1024, 4096}; pg8::StaticOrder S; S.init(M, 1024, G, bx);
        EpiDown E{p.HB, p.out, 1.f}; pg8::gemm_phase(lds, aux, g, S, E);
    }
}
__global__ void __launch_bounds__(512, 2) mk_kernel(Params p) {
    extern __shared__ __attribute__((aligned(16))) unsigned char lds_raw[];
    LAS unsigned char* lds = (LAS unsigned char*)lds_raw;
    LAS unsigned char* aux = lds + LDS_AUX;
    const int G = gridDim.x, bx = blockIdx.x;
    const int vcu = (G % 8 == 0) ? (bx % 8) * (G / 8) + bx / 8 : bx;
#ifndef MK_PHMASK
#define MK_PHMASK 0x1ff
#endif
#define IN(k) (((MK_PHMASK >> (k)) & 1) && p.ph_lo <= (k) && (k) < p.ph_hi)
#if MK_MODE == 0
#ifndef MK_CGSYNC
#define MK_CGSYNC 0
#endif
    volatile LAS unsigned* bst = (volatile LAS unsigned*)(lds + LDS_AUX + 4096);
    if (threadIdx.x < 2) bst[threadIdx.x] = 0u;
    __syncthreads();
    XcdBarrier xbar = xcd_barrier_post(p.ctl + 4096, bst);
    if (p.NB < 0) cg::this_grid().sync();
#ifndef MK_BAR
#define MK_BAR 2
#endif
    unsigned bar_epoch = 0;
#define SEAMX() do { if (MK_CGSYNC) cg::this_grid().sync(); else if (MK_BAR == 1) ctr_barrier(p.ctl + 1024, p.ctl + 1088, bar_epoch); else xcd_barrier(xbar); } while (0)
#define SEAM(k) do { if (IN(k) && IN((k) + 1)) SEAMX(); } while (0)
#else
#define SEAMX() do { } while (0)
#define SEAM(k) do { } while (0)
#endif
#ifndef MK_DUP
#define MK_DUP -1
#endif
#define PHASE(k) do { if (IN(k)) { run_phase<k>(p, lds, aux, vcu, G, bx, 0); if (MK_DUP == (k)) { SEAMX(); run_phase<k>(p, lds, aux, vcu, G, bx, 1); } } SEAM(k); } while (0)
    PHASE(0); PHASE(1); PHASE(2); PHASE(3); PHASE(4); PHASE(5); PHASE(6); PHASE(7); PHASE(8);
#undef IN
#undef SEAM
}
constexpr int N_PHASES = 9;

static size_t al(size_t v) { return (v + 255) & ~(size_t)255; }
static Params make_params(void* const* d_in, float* out, unsigned char* ws, int NB, int b0, bool alias, unsigned char* gates) {
    Params p{};
    for (int i = 0; i < 26; ++i) p.in[i] = (const float*)d_in[i];
    p.out = out; p.NB = NB; p.ph_lo = 0; p.ph_hi = N_PHASES; p.pad = 0;
    p.x = (const float*)d_in[0] + (size_t)b0 * TOK * 1024; p.pos = (const int*)d_in[1] + (size_t)b0 * TOK;
    for (int i = 0; i < 32; ++i) p.inv_freq[i] = powf(10000.0f, -(float)i / 32.0f);
    const size_t M = (size_t)NB * TOK; size_t off = 0;
    auto take = [&](size_t bytes) { unsigned char* q = ws + off; off += al(bytes); return q; };
    p.ctl = (unsigned*)take(1 << 20);
    p.ssq_q = (float*)take(M * 4); p.ssq_kv = (float*)take(M * 4); p.ssq_kpe = (float*)take(M * 4); p.ssq_h = (float*)take(M * 4); p.inv_x = (float*)take(M * 4);
    p.sloc = (float*)take((size_t)NB * 32 * 16 * 128 * 4);
    p.rcos = (float*)take(M * 32 * 4); p.rsin = (float*)take(M * 32 * 4);
    p.kpe = (bf16_t*)take(M * 64 * 2);
    p.W1t = (bf16_t*)take((size_t)3328 * 1024 * 2); p.Wqt = (bf16_t*)take((size_t)2048 * 384 * 2); p.Wkvt = (bf16_t*)take((size_t)2048 * 256 * 2);
    p.Wglut = (bf16_t*)take((size_t)512 * 512 * 2); p.Wost = (bf16_t*)take((size_t)1024 * 512 * 2); p.Womt = (bf16_t*)take((size_t)1024 * 1024 * 2);
    p.Woutt = (bf16_t*)take((size_t)1024 * 1024 * 2); p.Wupt = (bf16_t*)take((size_t)4096 * 1024 * 2); p.Wdnt = (bf16_t*)take((size_t)1024 * 4096 * 2);
    if (alias) {
        unsigned char* rXB = take(M * 2048); unsigned char* rU = take(M * 1024); unsigned char* rQL = take(M * 1280); unsigned char* rQKV = take(M * 8192); unsigned char* rT1 = take(M * 2048);
        p.XB = (bf16_t*)rXB; p.ATT = (bf16_t*)rXB; p.HB = (bf16_t*)rXB;
        p.U = (bf16_t*)rU; p.Z2 = (bf16_t*)rU;
        p.QL = (bf16_t*)rQL; p.CKV = (bf16_t*)(rQL + M * 768); p.Z = (bf16_t*)rQL;
        p.Q = (bf16_t*)rQKV; p.K = (bf16_t*)(rQKV + M * 3072); p.V = (bf16_t*)(rQKV + M * 6144); p.HID = (bf16_t*)rQKV;
        p.T1 = (bf16_t*)rT1;
        p.SGS = (bf16_t*)out; p.SGM = (bf16_t*)((unsigned char*)out + M * 2048);
    } else {
        p.XB = (bf16_t*)take(M * 2048); p.ATT = (bf16_t*)take(M * 2048); p.HB = (bf16_t*)take(M * 2048);
        p.U = (bf16_t*)take(M * 1024); p.Z2 = (bf16_t*)take(M * 1024); p.Z = (bf16_t*)take(M * 1024);
        p.QL = (bf16_t*)take(M * 768); p.CKV = (bf16_t*)take(M * 512);
        p.Q = (bf16_t*)take(M * 3072); p.K = (bf16_t*)take(M * 3072); p.V = (bf16_t*)take(M * 2048); p.HID = (bf16_t*)take(M * 8192);
        p.T1 = (bf16_t*)take(M * 2048);
        p.SGS = (bf16_t*)gates; p.SGM = (bf16_t*)(gates + M * 2048);
    }
    return p;
}
static int g_grid = 0;
static int mk_grid() {
    if (g_grid == 0) {
        int dev = 0, cus = 0, per_cu = 0;
        hipGetDevice(&dev); hipDeviceGetAttribute(&cus, hipDeviceAttributeMultiprocessorCount, dev);
        hipFuncSetAttribute((const void*)mk_kernel, hipFuncAttributeMaxDynamicSharedMemorySize, LDS_BYTES);
        hipOccupancyMaxActiveBlocksPerMultiprocessor(&per_cu, (const void*)mk_kernel, 512, LDS_BYTES);
        (void)hipGetLastError();
        g_grid = (per_cu >= 1) ? cus : -1;
        if (g_grid < 0) fprintf(stderr, "mk: occupancy query reports %d blocks per CU\n", per_cu);
    }
    return g_grid;
}
static void mk_launch_phases(Params p, int lo, int hi, bool coop, hipStream_t stream) {
    const int grid = mk_grid(); if (grid <= 0) return;
    p.ph_lo = lo; p.ph_hi = hi;
    if (coop) { void* args[] = {&p}; hipError_t e = hipLaunchCooperativeKernel((const void*)mk_kernel, dim3(grid), dim3(512), args, LDS_BYTES, stream);
        if (e != hipSuccess) fprintf(stderr, "mk: cooperative launch failed: %s\n", hipGetErrorString(e)); }
    else hipLaunchKernelGGL(mk_kernel, dim3(grid), dim3(512), LDS_BYTES, stream, p);
}
#if MK_MODE == 2
struct NaiveBufs { float *XN, *PROJ, *QLN, *CKN, *QR, *KVR, *Qh, *Kh, *Vh, *S, *ATT, *Y, *Z, *G, *Z2, *YS, *YM, *MIX, *T, *H, *HN, *DN; };
static void naive_batch(void* const* d_in, int b, float* ob, const NaiveBufs& n, hipStream_t stream) {
    const float* x = (const float*)d_in[0]; const int* pos = (const int*)d_in[1];
    const float* norm_mix = (const float*)d_in[2]; const float* w_in = (const float*)d_in[3];
    const float* q_a_norm = (const float*)d_in[4]; const float* kv_a_norm = (const float*)d_in[5];
    const float* w_q_b = (const float*)d_in[6]; const float* w_kv_b = (const float*)d_in[7];
    const float* q_norm = (const float*)d_in[8]; const float* k_norm = (const float*)d_in[9];
    const float* w_o_mla = (const float*)d_in[10];
    const float* a_re = (const float*)d_in[11]; const float* a_im = (const float*)d_in[12]; const float* log_dt = (const float*)d_in[13];
    const float* b_re = (const float*)d_in[14]; const float* b_im = (const float*)d_in[15];
    const float* c_re = (const float*)d_in[16]; const float* c_im = (const float*)d_in[17]; const float* dsk = (const float*)d_in[18];
    const float* w_glu = (const float*)d_in[19]; const float* b_glu = (const float*)d_in[20]; const float* w_o_ssm = (const float*)d_in[21];
    const float* w_out = (const float*)d_in[22]; const float* norm_mlp = (const float*)d_in[23];
    const float* w_up = (const float*)d_in[24]; const float* w_down = (const float*)d_in[25];
    const int Mb = SEQ; const float scale = 1.0f / sqrtf(192.f);
    const float* xb = x + (size_t)b * Mb * 1024; const int* pb = pos + (size_t)b * Mb;
    k_rmsnorm<<<Mb, 256, 0, stream>>>(xb, 1024, norm_mix, n.XN, 1024, 1024);
    gemm(stream, n.XN, 1024, w_in, D_IN, n.PROJ, D_IN, Mb, D_IN, 1024, false, 0);
    k_rmsnorm<<<Mb, 256, 0, stream>>>(n.PROJ + OFF_QL, D_IN, q_a_norm, n.QLN, 384, 384);
    k_rmsnorm<<<Mb, 256, 0, stream>>>(n.PROJ + OFF_KV, D_IN, kv_a_norm, n.CKN, 256, 256);
    gemm(stream, n.QLN, 384, w_q_b, 1536, n.QR, 1536, Mb, 1536, 384, false, 0);
    gemm(stream, n.CKN, 256, w_kv_b, 2048, n.KVR, 2048, Mb, 2048, 256, false, 0);
    k_qkprep<<<dim3(Mb, NH), 192, 0, stream>>>(n.QR, n.KVR, n.PROJ, pb, q_norm, k_norm, n.Qh, n.Kh, n.Vh, Mb);
    for (int h = 0; h < NH; ++h) {
        gemm(stream, n.Qh + (size_t)h * Mb * 192, 192, n.Kh + (size_t)h * Mb * 192, 192, n.S, Mb, Mb, Mb, 192, true, 1);
        k_softmax<<<Mb, 256, 0, stream>>>(n.S, Mb, scale);
        gemm(stream, n.S, Mb, n.Vh + (size_t)h * Mb * 128, 128, n.ATT + h * 128, 1024, Mb, 128, Mb, false, 2);
    }
    k_ssm<<<SSM_G, 64, 0, stream>>>(n.PROJ, a_re, a_im, log_dt, b_re, b_im, c_re, c_im, dsk, n.Y, Mb);
    const size_t n512 = (size_t)Mb * 512, n1024 = (size_t)Mb * 1024, n4096 = (size_t)Mb * 4096;
    k_gelu<<<(unsigned)(n512 / 256), 256, 0, stream>>>(n.Y, n.Z, n512);
    gemm(stream, n.Z, 512, w_glu, 512, n.G, 512, Mb, 512, 512, false, 0);
    k_glu<<<(unsigned)(n512 / 256), 256, 0, stream>>>(n.Z, n.G, b_glu, n.Z2, n512);
    gemm(stream, n.Z2, 512, w_o_ssm, 1024, n.YS, 1024, Mb, 1024, 512, false, 0);
    gemm(stream, n.ATT, 1024, w_o_mla, 1024, n.YM, 1024, Mb, 1024, 1024, false, 0);
    k_mix<<<(unsigned)(n1024 / 256), 256, 0, stream>>>(n.PROJ, n.YS, n.YM, n.MIX, n1024);
    gemm(stream, n.MIX, 1024, w_out, 1024, n.T, 1024, Mb, 1024, 1024, false, 0);
    k_add<<<(unsigned)(n1024 / 256), 256, 0, stream>>>(xb, n.T, n.H, n1024);
    k_rmsnorm<<<Mb, 256, 0, stream>>>(n.H, 1024, norm_mlp, n.HN, 1024, 1024);
    gemm(stream, n.HN, 1024, w_up, 4096, n.S, 4096, Mb, 4096, 1024, false, 0);
    k_relu2<<<(unsigned)(n4096 / 256), 256, 0, stream>>>(n.S, n4096);
    gemm(stream, n.S, 4096, w_down, 1024, n.DN, 1024, Mb, 1024, 4096, false, 0);
    k_add<<<(unsigned)(n1024 / 256), 256, 0, stream>>>(n.H, n.DN, ob, n1024);
}
__device__ __forceinline__ float bfv(const bf16_t* p, size_t i) { return __uint_as_float((unsigned)p[i] << 16); }
__global__ void __launch_bounds__(256) k_check(int id, size_t n, Params p, NaiveBufs nb, const float* nout, const float* oout, float* res) {
    __shared__ float red[4];
    const int Mb = TOK; float sd = 0.f, sr = 0.f;
    for (size_t i = (size_t)blockIdx.x * 256 + threadIdx.x; i < n; i += (size_t)gridDim.x * 256) {
        float a = 0.f, r = 0.f;
        switch (id) {
            case 1: { const size_t rr = i / 512, c = i % 512; a = bfv(p.U, i); r = nb.PROJ[rr * D_IN + c]; } break;
            case 2: { const size_t rr = i / 384, c = i % 384; a = bfv(p.QL, i); r = nb.PROJ[rr * D_IN + 512 + c]; } break;
            case 3: { const size_t rr = i / 256, c = i % 256; a = bfv(p.CKV, i); r = nb.PROJ[rr * D_IN + 896 + c]; } break;
            case 4: { const size_t rr = i / 1024, c = i % 1024; a = bfv(p.SGS, i); r = sigmoidf_(nb.PROJ[rr * D_IN + OFF_GS + c]); } break;
            case 5: { const size_t rr = i / 1024, c = i % 1024; a = bfv(p.SGM, i); r = sigmoidf_(nb.PROJ[rr * D_IN + OFF_GM + c]); } break;
            case 6: case 7: { const size_t h = i / ((size_t)Mb * 192), l = (i / 192) % Mb, s = i % 192; const size_t d = s < 128 ? s : 128 + dperm((int)s - 128);
                if (id == 6) { a = bfv(p.Q, i); r = nb.Qh[(h * Mb + l) * 192 + d] * QSCALE; }
                else { a = bfv(p.K, ((h * 64 + l / 64) * 24 + s / 8) * 512 + (l % 64) * 8 + s % 8); r = nb.Kh[(h * Mb + l) * 192 + d]; } } break;
            case 8: { const size_t h = i / ((size_t)Mb * 128), l = (i / 128) % Mb, d = i % 128; a = bfv(p.V, ((h * 64 + l / 64) * 4 + d / 32) * 2048 + (l % 64) * 32 + d % 32); r = nb.Vh[(h * Mb + l) * 128 + d]; } break;
            case 9: a = bfv(p.ATT, i); r = nb.ATT[i]; break;
            case 10: a = bfv(p.Z, i); r = nb.Z[i]; break;
            case 11: a = bfv(p.Z2, i); r = nb.Z2[i]; break;
            case 12: a = bfv(p.T1, i); r = nb.MIX[i]; break;
            case 13: a = bfv(p.HB, i); r = nb.H[i]; break;
            case 14: a = bfv(p.HID, i); r = nb.S[i]; break;
            case 15: a = oout[i]; r = nout[i]; break;
        }
        const float d = a - r; sd += d * d; sr += r * r;
    }
    sd = block_sum256(sd, red); sr = block_sum256(sr, red);
    if (threadIdx.x == 0) { atomicAdd(res + 2 * id, sd); atomicAdd(res + 2 * id + 1, sr); }
}
__global__ void k_final(const float* res, float* out, int nchk, int first) {
    float code = 9900.f;
    for (int id = first; id <= nchk; ++id) { const float rvr = res[2 * id] / res[2 * id + 1];
        if (!(rvr < 2e-4f)) { const int sev = !(rvr < 0.1f) ? 0 : (rvr >= 1e-2f) ? 1 : (rvr >= 1e-3f) ? 2 : 3; code = 100.f * id + 10.f * sev; break; } }
    out[0] = code;
}
#ifndef MK_FIRST_CHECK
#define MK_FIRST_CHECK 1
#endif
extern "C" void kernel_launch(void* const* d_in, const int* in_sizes, int n_in, void* d_out, int out_size, void* d_ws, size_t ws_size, hipStream_t stream) {
    unsigned char* ws = (unsigned char*)d_ws; float* out = (float*)d_out;
    const size_t MiB = 1u << 20; const int Mb = TOK;
    float* w = (float*)(ws + 150 * MiB); size_t off = 0;
    auto take = [&](size_t n) { float* q = w + off; off += n; return q; };
    const size_t slot = (size_t)Mb * 1024;
    NaiveBufs n;
    n.PROJ = take((size_t)Mb * D_IN); n.Qh = take((size_t)Mb * 1536); n.Kh = take((size_t)Mb * 1536); n.Vh = take((size_t)Mb * 1024);
    n.S = take((size_t)Mb * 4096); n.Y = take((size_t)Mb * 512); n.Z = take((size_t)Mb * 512);
    n.G = take((size_t)Mb * 512); n.Z2 = take((size_t)Mb * 512);
    float* scratch = take((size_t)Mb * 5248);
    n.XN = scratch; n.QLN = scratch + (size_t)Mb * 1024; n.CKN = n.QLN + (size_t)Mb * 384; n.QR = n.CKN + (size_t)Mb * 256; n.KVR = n.QR + (size_t)Mb * 1536;
    n.YS = scratch; n.YM = scratch + (size_t)Mb * 1024; n.T = scratch + (size_t)Mb * 2048; n.HN = scratch + (size_t)Mb * 3072; n.DN = scratch + (size_t)Mb * 4096;
    float* res = take(64);
    float* out2 = out + slot; unsigned char* gates = (unsigned char*)(out + 2 * slot); n.ATT = out + 3 * slot; n.MIX = out + 4 * slot; n.H = out + 5 * slot;
    hipMemsetAsync(ws, 0, 1 << 20, stream); hipMemsetAsync(res, 0, 64 * 4, stream);
    hipMemsetAsync(out, 0, (size_t)out_size * 4, stream);
    naive_batch(d_in, 0, out, n, stream);
    Params p = make_params(d_in, out2, ws, 1, 0, false, gates);
    for (int ph = 0; ph < N_PHASES; ++ph) mk_launch_phases(p, ph, ph + 1, false, stream);
    const size_t cnt[16] = {0, (size_t)Mb * 512, (size_t)Mb * 384, (size_t)Mb * 256, (size_t)Mb * 1024, (size_t)Mb * 1024, (size_t)Mb * 1536, (size_t)Mb * 1536, (size_t)Mb * 1024,
                            (size_t)Mb * 1024, (size_t)Mb * 512, (size_t)Mb * 512, (size_t)Mb * 1024, (size_t)Mb * 1024, (size_t)Mb * 4096, (size_t)Mb * 1024};
    for (int id = 1; id <= 15; ++id) k_check<<<1024, 256, 0, stream>>>(id, cnt[id], p, n, out, out2, res);
    k_final<<<1, 1, 0, stream>>>(res, out, 15, MK_FIRST_CHECK);
}
#else
extern "C" void kernel_launch(void* const* d_in, const int* in_sizes, int n_in, void* d_out, int out_size, void* d_ws, size_t ws_size, hipStream_t stream) {
    Params p = make_params(d_in, (float*)d_out, (unsigned char*)d_ws, 8, 0, true, nullptr);
    hipMemsetAsync(d_ws, 0, 65536, stream);
#if MK_MODE == 0
    mk_launch_phases(p, 0, N_PHASES, true, stream);
#else
    for (int ph = 0; ph < N_PHASES; ++ph) mk_launch_phases(p, ph, ph + 1, false, stream);
#endif
}
#endif
```

```cpp
#include <hip/hip_runtime.h>
#include <hip/hip_cooperative_groups.h>
#include <cstdint>
#include <cstdio>
#include <cmath>
#define MK_MODE 0
#define MK_FIRST_CHECK 1
#define LAS __attribute__((address_space(3)))
typedef unsigned short bf16_t;
typedef short bf16x8 __attribute__((ext_vector_type(8)));
typedef short s16x4 __attribute__((ext_vector_type(4)));
typedef float f32x4 __attribute__((ext_vector_type(4)));
typedef float f32x16 __attribute__((ext_vector_type(16)));
typedef unsigned u32x4 __attribute__((ext_vector_type(4)));
typedef unsigned u32x2 __attribute__((ext_vector_type(2)));

constexpr int TOK = 4096;
constexpr float LOG2E = 1.4426950408889634f;
constexpr float QSCALE = 0.07216878364870322f * LOG2E;

struct Params {
    const float* in[26];
    float* out;
    unsigned* ctl;
    float *ssq_q, *ssq_kv, *ssq_kpe, *ssq_h, *inv_x;
    float* sloc;
    float *rcos, *rsin;
    bf16_t* kpe;
    bf16_t *W1t, *Wqt, *Wkvt, *Wglut, *Wost, *Womt, *Woutt, *Wupt, *Wdnt;
    bf16_t *XB, *U, *QL, *CKV, *Q, *K, *V, *ATT, *Z, *Z2, *T1, *HB, *HID, *SGS, *SGM;
    const float* x; const int* pos;
    int NB, ph_lo, ph_hi, pad;
    float inv_freq[32];
};

typedef float f32x2_t __attribute__((ext_vector_type(2))); typedef __bf16 bf16x2_t __attribute__((ext_vector_type(2)));
__device__ __forceinline__ unsigned cvt_pk_bf16(float lo, float hi) { f32x2_t v = {lo, hi}; bf16x2_t b = __builtin_convertvector(v, bf16x2_t); return __builtin_bit_cast(unsigned, b); }
__device__ __forceinline__ u32x4 pack8(const f32x4 a, const f32x4 b) { u32x4 w; w.x = cvt_pk_bf16(a[0], a[1]); w.y = cvt_pk_bf16(a[2], a[3]); w.z = cvt_pk_bf16(b[0], b[1]); w.w = cvt_pk_bf16(b[2], b[3]); return w; }
__device__ __forceinline__ float bf_lo(unsigned w) { return __uint_as_float(w << 16); }
__device__ __forceinline__ float bf_hi(unsigned w) { return __uint_as_float(w & 0xffff0000u); }
__device__ __forceinline__ void unpack8(const u32x4 w, f32x4& a, f32x4& b) { a = (f32x4){bf_lo(w.x), bf_hi(w.x), bf_lo(w.y), bf_hi(w.y)}; b = (f32x4){bf_lo(w.z), bf_hi(w.z), bf_lo(w.w), bf_hi(w.w)}; }
__device__ __forceinline__ float fast_sigmoid(float v) { return __builtin_amdgcn_rcpf(1.f + __builtin_amdgcn_exp2f(-v * LOG2E)); }
__device__ __forceinline__ float fast_tanh(float v) { const float e = __builtin_amdgcn_exp2f(-2.f * LOG2E * fabsf(v)); const float t = (1.f - e) * __builtin_amdgcn_rcpf(1.f + e); return v < 0.f ? -t : t; }
__device__ __forceinline__ float gelu_t(float x) { return 0.5f * x * (1.f + fast_tanh(0.7978845608028654f * (x + 0.044715f * x * x * x))); }
__host__ __device__ __forceinline__ int dperm(int s) { const int wc = s >> 5, fq = (s >> 3) & 3, n = (s >> 2) & 1, j = s & 3; return 32 * n + 16 * wc + 4 * fq + j; }

namespace pg8 {
constexpr int BM = 256, BK = 64, HALF = 128, HTB = HALF * BK * 2, STAGE_BYTES = 8 * HTB, NXCD = 8, WGM = 8;
__host__ __device__ __forceinline__ int lds_byte(int r, int c) { const int st = (r >> 4) * 2 + (c >> 5), rr = r & 15, cc = c & 31, ob = rr * 64 + cc * 2; return st * 1024 + (ob ^ (((ob >> 9) & 1) << 5)); }
__host__ __device__ __forceinline__ void stage_rc(int b, int& R, int& C) { const int st = b / 1024, sb = b % 1024, swz = sb ^ (((sb >> 9) & 1) << 5); R = (st >> 1) * 16 + swz / 64; C = (st & 1) * 32 + (swz % 64) / 2; }
__host__ __device__ __forceinline__ int perm32(int rho) { const int n = rho >> 4, i = rho & 15; return 8 * (i >> 2) + 4 * n + (i & 3); }
struct Unit { int pm, pn; };
struct Gemm { const bf16_t* A; int lda; const bf16_t* Bt; int ldb; int M, N, K; };
struct StaticOrder {
    int nM, nN, nwg, G, c;
    __device__ void init(int M, int N, int G_, int c_) { nM = M / BM; nN = N / BM; nwg = nM * nN; G = G_; c = c_; }
    __device__ bool next(int i, Unit& u) const {
        const long L = (long)i * G + c; if (L >= nwg) return false;
        int wgid = (int)L; { const int q = nwg / NXCD, r = nwg % NXCD, xcd = wgid % NXCD, off = wgid / NXCD; wgid = (xcd < r ? xcd * (q + 1) : r * (q + 1) + (xcd - r) * q) + off; }
        const int nig = WGM * nN, gid = wgid / nig, fm = gid * WGM, gsz = (nM - fm) < WGM ? (nM - fm) : WGM;
        u.pm = fm + ((wgid % nig) % gsz); u.pn = (wgid % nig) / gsz; return true;
    }
};
typedef f32x4 Acc[2][2][4][2];

template <class Epi>
__device__ __forceinline__ void gemm_phase(LAS unsigned char* lds, LAS unsigned char* aux, const Gemm g, const StaticOrder& S, const Epi& E) {
    int tid = threadIdx.x; asm volatile("" : "+v"(tid));
    const int wid = __builtin_amdgcn_readfirstlane(tid >> 6), lane = tid & 63, wr = wid >> 2, wc = wid & 3, fr = lane & 15, fq = lane >> 4;
    const int K = g.K, nt = K / BK;
    unsigned voffA[2], voffB[2];
#pragma unroll
    for (int i = 0; i < 2; ++i) { int R, C; stage_rc(tid * 16 + i * 8192, R, C); const int Rb = (R & ~31) + perm32(R & 31);
        voffA[i] = (unsigned)(R * g.lda + C) * 2u; voffB[i] = (unsigned)(Rb * g.ldb + C) * 2u; }
    const size_t kstep = (size_t)(BK * 2);
    const size_t hstepA = (size_t)HALF * g.lda * 2, hstepB = (size_t)HALF * g.ldb * 2;
    const size_t tstepA = 2 * hstepA, tstepB = 2 * hstepB;
    const unsigned ldsw = (unsigned)wid * 1024u;
    const int aoff = lds_byte(wr * 64 + fr, fq * 8), boff = lds_byte(wc * 32 + fr, fq * 8);
#define PG8_SA(b, h) (((b) * 2 + (h)) * HTB)
#define PG8_SB(b, h) ((4 + (b) * 2 + (h)) * HTB)
#define PG8_STAGE(bufoff, gbase, voff) do { _Pragma("unroll") for (int _i = 0; _i < 2; ++_i) \
        __builtin_amdgcn_global_load_lds((const unsigned*)((const char*)(gbase) + (voff)[_i]), (LAS unsigned*)(lds + (bufoff) + ldsw + _i * 8192), 16, 0, 0); } while (0)
#define PG8_LDA(dst, b, h) do { _Pragma("unroll") for (int m = 0; m < 4; ++m) _Pragma("unroll") for (int k = 0; k < 2; ++k) dst[m][k] = *(const LAS bf16x8*)(lds + PG8_SA(b, h) + aoff + m * 2048 + k * 1024); } while (0)
#define PG8_LDB(dst, b, h) do { _Pragma("unroll") for (int n = 0; n < 2; ++n) _Pragma("unroll") for (int k = 0; k < 2; ++k) dst[n][k] = *(const LAS bf16x8*)(lds + PG8_SB(b, h) + boff + n * 2048 + k * 1024); } while (0)
#define PG8_MMA(ai, bj, At, Bt) do { __builtin_amdgcn_s_setprio(1); _Pragma("unroll") for (int m = 0; m < 4; ++m) _Pragma("unroll") for (int n = 0; n < 2; ++n) _Pragma("unroll") for (int k = 0; k < 2; ++k) \
        acc[ai][bj][m][n] = __builtin_amdgcn_mfma_f32_16x16x32_bf16(Bt[n][k], At[m][k], acc[ai][bj][m][n], 0, 0, 0); __builtin_amdgcn_s_setprio(0); } while (0)
#define PG8_WAIT_V(n) asm volatile("s_waitcnt vmcnt(" #n ")" ::: "memory")
#define PG8_WAIT_L(n) asm volatile("s_waitcnt lgkmcnt(" #n ")" ::: "memory")
#define PG8_BAR __builtin_amdgcn_s_barrier()
#define PG8_SCHED __builtin_amdgcn_sched_barrier(0)
    Unit cur, nxt; int ui = 0;
    if (!S.next(0, cur)) return;
    Acc acc;
#pragma unroll
    for (int a = 0; a < 2; ++a)
#pragma unroll
        for (int b = 0; b < 2; ++b)
#pragma unroll
            for (int m = 0; m < 4; ++m)
#pragma unroll
                for (int n = 0; n < 2; ++n) acc[a][b][m][n] = (f32x4){0.f, 0.f, 0.f, 0.f};
    bf16x8 At[4][2], B0[2][2], B1[2][2];
    const char* cA = (const char*)g.A + (size_t)cur.pm * tstepA; const char* cB = (const char*)g.Bt + (size_t)cur.pn * tstepB;
    PG8_STAGE(PG8_SB(0, 0), cB, voffB); PG8_STAGE(PG8_SB(0, 1), cB + hstepB, voffB); PG8_STAGE(PG8_SA(0, 0), cA, voffA); PG8_STAGE(PG8_SA(0, 1), cA + hstepA, voffA);
    if (wr == 1) PG8_BAR;
    PG8_WAIT_V(2); PG8_BAR;
    PG8_STAGE(PG8_SB(1, 0), cB + kstep, voffB); PG8_STAGE(PG8_SA(1, 0), cA + kstep, voffA); PG8_STAGE(PG8_SB(1, 1), cB + hstepB + kstep, voffB);
    PG8_WAIT_V(6); PG8_BAR;
    for (;;) {
        const bool has_next = S.next(ui + 1, nxt);
        const char* nA = has_next ? (const char*)g.A + (size_t)nxt.pm * tstepA : cA; const char* nB = has_next ? (const char*)g.Bt + (size_t)nxt.pn * tstepB : cB;
#pragma unroll 1
        for (int t = 0; t < nt; t += 2) {
            const bool last = (t == nt - 2);
            const char* a1 = cA + (size_t)(t + 1) * kstep;
            const char* a2 = last ? nA : cA + (size_t)(t + 2) * kstep; const char* b2 = last ? nB : cB + (size_t)(t + 2) * kstep;
            const char* a3 = a2 + kstep; const char* b3 = b2 + kstep;
            PG8_LDB(B0, 0, 0); PG8_LDB(B1, 0, 1); PG8_SCHED; PG8_LDA(At, 0, 0); PG8_STAGE(PG8_SA(1, 1), a1 + hstepA, voffA);
            PG8_WAIT_V(8); PG8_WAIT_L(0); PG8_BAR; PG8_MMA(0, 0, At, B0); PG8_MMA(0, 1, At, B1); PG8_BAR; PG8_SCHED;
            PG8_LDA(At, 0, 1); PG8_STAGE(PG8_SB(0, 0), b2, voffB); PG8_STAGE(PG8_SB(0, 1), b2 + hstepB, voffB); PG8_STAGE(PG8_SA(0, 0), a2, voffA);
            PG8_WAIT_V(8); PG8_WAIT_L(0); PG8_BAR; PG8_MMA(1, 0, At, B0); PG8_MMA(1, 1, At, B1); PG8_BAR; PG8_SCHED;
            PG8_LDB(B0, 1, 0); PG8_LDB(B1, 1, 1); PG8_SCHED; PG8_LDA(At, 1, 0); PG8_STAGE(PG8_SA(0, 1), a2 + hstepA, voffA);
            PG8_WAIT_V(8); PG8_WAIT_L(0); PG8_BAR; PG8_MMA(0, 0, At, B0); PG8_MMA(0, 1, At, B1); PG8_BAR; PG8_SCHED;
            PG8_LDA(At, 1, 1); PG8_STAGE(PG8_SB(1, 0), b3, voffB); PG8_STAGE(PG8_SB(1, 1), b3 + hstepB, voffB); PG8_STAGE(PG8_SA(1, 0), a3, voffA);
            PG8_WAIT_V(8); PG8_WAIT_L(0); PG8_BAR; PG8_MMA(1, 0, At, B0); PG8_MMA(1, 1, At, B1); PG8_BAR; PG8_SCHED;
        }
        if (wr == 0) PG8_BAR;
        E(acc, cur, wr, wc, fr, fq, aux, wid, lane);
        if (!has_next) break;
#pragma unroll
        for (int a = 0; a < 2; ++a)
#pragma unroll
            for (int b = 0; b < 2; ++b)
#pragma unroll
                for (int m = 0; m < 4; ++m)
#pragma unroll
                    for (int n = 0; n < 2; ++n) acc[a][b][m][n] = (f32x4){0.f, 0.f, 0.f, 0.f};
        cur = nxt; cA = nA; cB = nB; ++ui;
        if (wr == 1) PG8_BAR;
    }
    PG8_WAIT_V(0);
    PG8_BAR;
#undef PG8_SA
#undef PG8_SB
#undef PG8_STAGE
#undef PG8_LDA
#undef PG8_LDB
#undef PG8_MMA
#undef PG8_SCHED
}
}
using pg8::Acc; using pg8::Unit;

#define EPI_ARGS const Acc& acc, const Unit& u, int wr, int wc, int fr_, int fq_, LAS unsigned char* aux, int wid, int lane
#define EPI_OPAQUE int fr = fr_, fq = fq_; asm volatile("" : "+v"(fr), "+v"(fq));
#define ROWLOOP for (int ai = 0; ai < 2; ++ai) _Pragma("unroll") for (int m = 0; m < 4; ++m)

__device__ __forceinline__ float fq_sum(float s) { s += __shfl_xor(s, 16); s += __shfl_xor(s, 32); return s; }
__device__ __forceinline__ float sq4(const f32x4 v) { return (v[0] * v[0] + v[1] * v[1]) + (v[2] * v[2] + v[3] * v[3]); }

struct EpiG1 {
    const float* inv_x; bf16_t *U, *QL, *CKV, *KPE, *SGS, *SGM; float *ssq_q, *ssq_kv, *ssq_kpe; const float *rcos, *rsin; const float* k_norm; int dry;
    __device__ __forceinline__ void operator()(EPI_ARGS) const {
        EPI_OPAQUE
        const int pn = u.pn, cw = wc * 32 + 8 * fq;
#pragma unroll
        ROWLOOP {
            const int row = u.pm * 256 + ai * 128 + wr * 64 + m * 16 + fr; const float s = inv_x[row];
            f32x4 v[2][2];
#pragma unroll
            for (int bj = 0; bj < 2; ++bj)
#pragma unroll
                for (int n = 0; n < 2; ++n) v[bj][n] = acc[ai][bj][m][n] * s;
            if (pn < 2) {
#pragma unroll
                for (int bj = 0; bj < 2; ++bj) *(u32x4*)(U + (size_t)row * 512 + pn * 256 + bj * 128 + cw) = pack8(v[bj][0], v[bj][1]);
            } else if (pn == 2) {
#pragma unroll
                for (int bj = 0; bj < 2; ++bj) *(u32x4*)(QL + (size_t)row * 384 + bj * 128 + cw) = pack8(v[bj][0], v[bj][1]);
                const float q = fq_sum(sq4(v[0][0]) + sq4(v[0][1]) + sq4(v[1][0]) + sq4(v[1][1]));
                if (fq == 0 && !dry) atomicAdd(ssq_q + row, q);
            } else if (pn == 3) {
                *(u32x4*)(QL + (size_t)row * 384 + 256 + cw) = pack8(v[0][0], v[0][1]);
                *(u32x4*)(CKV + (size_t)row * 256 + cw) = pack8(v[1][0], v[1][1]);
                const float q = fq_sum(sq4(v[0][0]) + sq4(v[0][1])), k = fq_sum(sq4(v[1][0]) + sq4(v[1][1]));
                if (fq == 0 && !dry) { atomicAdd(ssq_q + row, q); atomicAdd(ssq_kv + row, k); }
            } else if (pn == 4) {
                *(u32x4*)(CKV + (size_t)row * 256 + 128 + cw) = pack8(v[0][0], v[0][1]);
                const float k = fq_sum(sq4(v[0][0]) + sq4(v[0][1]));
                if (fq == 0 && !dry) atomicAdd(ssq_kv + row, k);
                if (wc < 2) {
                    const int i0 = 16 * wc + 4 * fq;
                    const f32x4 c = *(const f32x4*)(rcos + (size_t)row * 32 + i0), sn = *(const f32x4*)(rsin + (size_t)row * 32 + i0);
                    const f32x4 g1 = *(const f32x4*)(k_norm + 128 + i0), g2 = *(const f32x4*)(k_norm + 160 + i0);
                    const f32x4 x1 = v[1][0] * g1, x2 = v[1][1] * g2;
                    const f32x4 r1 = x1 * c - x2 * sn, r2 = x2 * c + x1 * sn;
                    *(u32x4*)(KPE + (size_t)row * 64 + cw) = pack8(r1, r2);
                    const float p = fq_sum(sq4(v[1][0]) + sq4(v[1][1]));
                    if (fq == 0 && !dry) atomicAdd(ssq_kpe + row, p);
                }
            } else {
                bf16_t* G = (pn < 9) ? SGS : SGM; const int c0 = ((pn < 9) ? (pn - 5) : (pn - 9)) * 256;
#pragma unroll
                for (int bj = 0; bj < 2; ++bj) { f32x4 a, b;
#pragma unroll
                    for (int j = 0; j < 4; ++j) { a[j] = fast_sigmoid(v[bj][0][j]); b[j] = fast_sigmoid(v[bj][1][j]); }
                    *(u32x4*)(G + (size_t)row * 1024 + c0 + bj * 128 + cw) = pack8(a, b); }
            }
        }
    }
};

__device__ __forceinline__ void row_reduce4(const float (&part)[2][4], float (&tot)[2][4], int wr, int wc, int fr, int fq, LAS unsigned char* aux) {
    LAS float* red = (LAS float*)aux;
#pragma unroll
    ROWLOOP { const float s = fq_sum(part[ai][m]); if (fq == 0) red[(ai * 128 + wr * 64 + m * 16 + fr) * 4 + wc] = s; }
    asm volatile("s_waitcnt lgkmcnt(0)" ::: "memory"); __builtin_amdgcn_s_barrier(); asm volatile("" ::: "memory");
#pragma unroll
    ROWLOOP { const f32x4 t = *(const LAS f32x4*)(red + (ai * 128 + wr * 64 + m * 16 + fr) * 4); tot[ai][m] = (t[0] + t[1]) + (t[2] + t[3]); }
    asm volatile("s_waitcnt lgkmcnt(0)" ::: "memory"); __builtin_amdgcn_s_barrier(); asm volatile("" ::: "memory");
}

struct EpiQ {
    const float* ssq_q; const float *rcos, *rsin; const float* q_norm; bf16_t* Q;
    __device__ __forceinline__ void operator()(EPI_ARGS) const {
        EPI_OPAQUE
        const int h = u.pn, cw = wc * 32 + 8 * fq;
        float part[2][4], tot[2][4], rs[2][4];
#pragma unroll
        ROWLOOP { const int row = u.pm * 256 + ai * 128 + wr * 64 + m * 16 + fr; const float s = __builtin_amdgcn_rsqf(ssq_q[row] * (1.f / 384.f) + 1e-6f); rs[ai][m] = s;
            part[ai][m] = (sq4(acc[ai][0][m][0]) + sq4(acc[ai][0][m][1]) + sq4(acc[ai][1][m][0]) + sq4(acc[ai][1][m][1])) * s * s; }
        row_reduce4(part, tot, wr, wc, fr, fq, aux);
        const f32x4 g0 = *(const f32x4*)(q_norm + cw), g1 = *(const f32x4*)(q_norm + cw + 4);
        const int i0 = 16 * (wc & 1) + 4 * fq;
        const f32x4 gr1 = *(const f32x4*)(q_norm + 128 + i0), gr2 = *(const f32x4*)(q_norm + 160 + i0);
#pragma unroll
        ROWLOOP { const int row = u.pm * 256 + ai * 128 + wr * 64 + m * 16 + fr;
            const float f = rs[ai][m] * __builtin_amdgcn_rsqf(tot[ai][m] * (1.f / 192.f) + 1e-6f) * QSCALE;
            const int b = row / TOK, l = row % TOK; bf16_t* qrow = Q + ((size_t)(b * 8 + h) * TOK + l) * 192;
            *(u32x4*)(qrow + cw) = pack8(acc[ai][0][m][0] * f * g0, acc[ai][0][m][1] * f * g1);
            if (wc < 2) {
                const f32x4 c = *(const f32x4*)(rcos + (size_t)row * 32 + i0), sn = *(const f32x4*)(rsin + (size_t)row * 32 + i0);
                const f32x4 x1 = acc[ai][1][m][0] * f * gr1, x2 = acc[ai][1][m][1] * f * gr2;
                *(u32x4*)(qrow + 128 + cw) = pack8(x1 * c - x2 * sn, x2 * c + x1 * sn);
            }
            asm volatile("" ::: "memory");
        }
    }
};

struct EpiKV {
    const float *ssq_kv, *ssq_kpe; const float* k_norm; const bf16_t* KPE; bf16_t *K, *V;
    __device__ __forceinline__ void operator()(EPI_ARGS) const {
        EPI_OPAQUE
        const int h = u.pn, cw = wc * 32 + 8 * fq;
        float part[2][4], tot[2][4], rs[2][4];
#pragma unroll
        ROWLOOP { const int row = u.pm * 256 + ai * 128 + wr * 64 + m * 16 + fr; const float s = __builtin_amdgcn_rsqf(ssq_kv[row] * (1.f / 256.f) + 1e-6f); rs[ai][m] = s;
            part[ai][m] = (sq4(acc[ai][0][m][0]) + sq4(acc[ai][0][m][1])) * s * s; }
        row_reduce4(part, tot, wr, wc, fr, fq, aux);
        const f32x4 g0 = *(const f32x4*)(k_norm + cw), g1 = *(const f32x4*)(k_norm + cw + 4);
#pragma unroll
        ROWLOOP { const int row = u.pm * 256 + ai * 128 + wr * 64 + m * 16 + fr;
            const float ik = __builtin_amdgcn_rsqf((tot[ai][m] + ssq_kpe[row]) * (1.f / 192.f) + 1e-6f), f = rs[ai][m] * ik;
            const int b = row / TOK, l = row % TOK; const size_t tl = (size_t)(b * 8 + h) * 64 + (l >> 6); const int kv = l & 63;
            bf16_t* kt = K + tl * 12288 + kv * 8;
            *(u32x4*)(kt + (4 * wc + fq) * 512) = pack8(acc[ai][0][m][0] * f * g0, acc[ai][0][m][1] * f * g1);
            if (wc < 2) { const u32x4 w = *(const u32x4*)(KPE + (size_t)row * 64 + cw); f32x4 a, c; unpack8(w, a, c);
                *(u32x4*)(kt + (16 + 4 * wc + fq) * 512) = pack8(a * ik, c * ik); }
            *(u32x4*)(V + tl * 8192 + wc * 2048 + kv * 32 + fq * 8) = pack8(acc[ai][1][m][0] * rs[ai][m], acc[ai][1][m][1] * rs[ai][m]);
            asm volatile("" ::: "memory");
        }
    }
};

struct EpiGlu {
    const bf16_t* Z; const float* bias; bf16_t* Z2;
    __device__ __forceinline__ void operator()(EPI_ARGS) const {
        EPI_OPAQUE
#pragma unroll
        for (int bj = 0; bj < 2; ++bj) { const int col = u.pn * 256 + bj * 128 + wc * 32 + 8 * fq;
            const f32x4 b0 = *(const f32x4*)(bias + col), b1 = *(const f32x4*)(bias + col + 4);
#pragma unroll
            ROWLOOP { const int row = u.pm * 256 + ai * 128 + wr * 64 + m * 16 + fr;
                f32x4 z0, z1; unpack8(*(const u32x4*)(Z + (size_t)row * 512 + col), z0, z1);
                f32x4 o0, o1;
#pragma unroll
                for (int j = 0; j < 4; ++j) { o0[j] = z0[j] * fast_sigmoid(acc[ai][bj][m][0][j] + b0[j]); o1[j] = z1[j] * fast_sigmoid(acc[ai][bj][m][1][j] + b1[j]); }
                *(u32x4*)(Z2 + (size_t)row * 512 + col) = pack8(o0, o1); }
        }
    }
};
template <bool SECOND> struct EpiMix {
    const bf16_t* SG; bf16_t* T1;
    __device__ __forceinline__ void operator()(EPI_ARGS) const {
        EPI_OPAQUE
#pragma unroll
        for (int bj = 0; bj < 2; ++bj) { const int col = u.pn * 256 + bj * 128 + wc * 32 + 8 * fq;
#pragma unroll
            ROWLOOP { const size_t o = (size_t)(u.pm * 256 + ai * 128 + wr * 64 + m * 16 + fr) * 1024 + col;
                f32x4 s0, s1; unpack8(*(const u32x4*)(SG + o), s0, s1);
                f32x4 r0 = s0 * acc[ai][bj][m][0], r1 = s1 * acc[ai][bj][m][1];
                if (SECOND) { f32x4 t0, t1; unpack8(*(const u32x4*)(T1 + o), t0, t1); r0 += t0; r1 += t1; }
                *(u32x4*)(T1 + o) = pack8(r0, r1); }
        }
    }
};
struct EpiOut {
    const float* x; float* out; bf16_t* HB; float* ssq_h; int dry;
    __device__ __forceinline__ void operator()(EPI_ARGS) const {
        EPI_OPAQUE
#pragma unroll
        ROWLOOP { const int row = u.pm * 256 + ai * 128 + wr * 64 + m * 16 + fr; float q = 0.f;
#pragma unroll
            for (int bj = 0; bj < 2; ++bj) { const size_t o = (size_t)row * 1024 + u.pn * 256 + bj * 128 + wc * 32 + 8 * fq;
                const f32x4 h0 = *(const f32x4*)(x + o) + acc[ai][bj][m][0], h1 = *(const f32x4*)(x + o + 4) + acc[ai][bj][m][1];
                *(u32x4*)(HB + o) = pack8(h0, h1); q += sq4(h0) + sq4(h1); }
            q = fq_sum(q); if (fq == 0 && !dry) atomicAdd(ssq_h + row, q); }
    }
};
struct EpiUp {
    const float* ssq_h; bf16_t* HID;
    __device__ __forceinline__ void operator()(EPI_ARGS) const {
        EPI_OPAQUE
#pragma unroll
        ROWLOOP { const int row = u.pm * 256 + ai * 128 + wr * 64 + m * 16 + fr; const float s = __builtin_amdgcn_rsqf(ssq_h[row] * (1.f / 1024.f) + 1e-6f);
#pragma unroll
            for (int bj = 0; bj < 2; ++bj) { f32x4 a, b;
#pragma unroll
                for (int j = 0; j < 4; ++j) { const float p = fmaxf(acc[ai][bj][m][0][j] * s, 0.f), q = fmaxf(acc[ai][bj][m][1][j] * s, 0.f); a[j] = p * p; b[j] = q * q; }
                *(u32x4*)(HID + (size_t)row * 4096 + u.pn * 256 + bj * 128 + wc * 32 + 8 * fq) = pack8(a, b); } }
    }
};
struct EpiDown {
    const bf16_t* HB; float* out; float sc;
    __device__ __forceinline__ void operator()(EPI_ARGS) const {
        EPI_OPAQUE
#pragma unroll
        ROWLOOP { const int row = u.pm * 256 + ai * 128 + wr * 64 + m * 16 + fr;
#pragma unroll
            for (int bj = 0; bj < 2; ++bj) { const size_t o = (size_t)row * 1024 + u.pn * 256 + bj * 128 + wc * 32 + 8 * fq;
                f32x4 h0, h1; unpack8(*(const u32x4*)(HB + o), h0, h1);
                *(f32x4*)(out + o) = h0 + acc[ai][bj][m][0] * sc; *(f32x4*)(out + o + 4) = h1 + acc[ai][bj][m][1] * sc; } }
    }
};
#define XB_TMO      128
#define XB_XCNT(j)  (256  + 64 * (j))
#define XB_XSUB(j)  (1280 + 64 * (j))
#define XB_XGEN(j)  (2304 + 64 * (j))
#define XB_TOP      3328
#define XB_TOPGEN   3392
#define XCD_BAR_WORDS 3456
#define XB_SPIN_CAP (1u << 18)
__device__ __forceinline__ unsigned xb_ld(unsigned* p)              { return __hip_atomic_load(p, __ATOMIC_RELAXED, __HIP_MEMORY_SCOPE_AGENT); }
__device__ __forceinline__ unsigned xb_add(unsigned* p, unsigned v) { return __hip_atomic_fetch_add(p, v, __ATOMIC_RELAXED, __HIP_MEMORY_SCOPE_AGENT); }
__device__ __forceinline__ unsigned xb_xcc_id() { return (unsigned)__builtin_amdgcn_s_getreg((3 << 11) | 20) & 0xFu; }
#define XB_SPIN(cond, bar) do { unsigned _sp = 0; while (cond) { __builtin_amdgcn_s_sleep(1); \
    if ((++_sp & 255u) == 0u) { if (xb_ld(&(bar)[XB_TMO])) break; if (_sp > XB_SPIN_CAP) { atomicAdd(&(bar)[XB_TMO], 1u); break; } } } } while (0)
struct XcdBarrier { unsigned* bar; unsigned x; volatile LAS unsigned* st; };
__device__ __forceinline__ XcdBarrier xcd_barrier_post(unsigned* bar, volatile LAS unsigned* st) {
    XcdBarrier b; b.bar = bar; b.x = xb_xcc_id(); b.st = st;
    if (threadIdx.x == 0) (void)xb_add(&bar[XB_XCNT(b.x)], 1u);
    return b;
}
__device__ __forceinline__ void xcd_barrier_complete(unsigned* bar, unsigned x, unsigned& nloc, unsigned& nx) {
    const unsigned G = gridDim.x * gridDim.y * gridDim.z;
    unsigned sum, cnt, mine, sp = 0u;
    for (;;) {
        sum = 0u; cnt = 0u; mine = 0u;
#pragma unroll
        for (unsigned j = 0; j < 16; ++j) { const unsigned c = xb_ld(&bar[XB_XCNT(j)]); sum += c; cnt += (c > 0u) ? 1u : 0u; mine = (j == x) ? c : mine; }
        if (sum == G) break;
        __builtin_amdgcn_s_sleep(1);
        if ((++sp & 255u) == 0u) { if (xb_ld(&bar[XB_TMO])) break; if (sp > XB_SPIN_CAP) { atomicAdd(&bar[XB_TMO], 1u); break; } }
    }
    nloc = mine > 0u ? mine : 1u; nx = cnt > 0u ? cnt : 1u;
}
__device__ __forceinline__ void xcd_barrier(const XcdBarrier& b) {
    asm volatile("s_waitcnt vmcnt(0)" ::: "memory");
    __syncthreads();
    if (threadIdx.x == 0) {
        unsigned* bar = b.bar;
        __builtin_amdgcn_s_waitcnt(0);
        unsigned nloc = b.st[0], nx = b.st[1];
        if (nloc == 0u) { xcd_barrier_complete(bar, b.x, nloc, nx); b.st[0] = nloc; b.st[1] = nx; }
        const unsigned old = xb_add(&bar[XB_XSUB(b.x)], 1u);
        const unsigned gen = old / nloc;
        if (old + 1u == (gen + 1u) * nloc) {
            __builtin_amdgcn_fence(__ATOMIC_RELEASE, "agent");
            asm volatile("s_waitcnt vmcnt(0)" ::: "memory");
            const unsigned og = xb_add(&bar[XB_TOP], 1u);
            const unsigned tg = og / nx;
            if (og + 1u == (tg + 1u) * nx) xb_add(&bar[XB_TOPGEN], 1u);
            else XB_SPIN(xb_ld(&bar[XB_TOPGEN]) == tg, bar);
            __builtin_amdgcn_fence(__ATOMIC_ACQUIRE, "agent");
            xb_add(&bar[XB_XGEN(b.x)], 1u);
            asm volatile("s_waitcnt vmcnt(0)" ::: "memory");
        } else {
            XB_SPIN(xb_ld(&bar[XB_XGEN(b.x)]) == gen, bar);
            __builtin_amdgcn_fence(__ATOMIC_ACQUIRE, "agent");
            asm volatile("s_waitcnt vmcnt(0)" ::: "memory");
        }
    }
    __syncthreads();
}

__device__ __forceinline__ void ctr_barrier(unsigned* ctr, unsigned* tmo, unsigned& epoch) {
    __threadfence();
    __syncthreads();
    ++epoch;
    if (threadIdx.x == 0) {
        const unsigned target = epoch * gridDim.x;
        xb_add(ctr, 1u);
        unsigned sp = 0;
        while (xb_ld(ctr) < target) { __builtin_amdgcn_s_sleep(1); if ((++sp & 1023u) == 0u) { if (sp > (1u << 22)) { atomicAdd(tmo, 1u); break; } } }
    }
    __syncthreads();
    __threadfence();
}
namespace att {
constexpr int KSLOT = 24576, VSLOT = 16384, NSLOT = 3;
constexpr int LDS_K = 0, LDS_V = NSLOT * KSLOT, LDS_WS = LDS_V + NSLOT * VSLOT, LDS_END = LDS_WS + 8 * 256;
__device__ __forceinline__ int crow(int r, int hi) { return (r & 3) + 8 * (r >> 2) + 4 * hi; }
__device__ __forceinline__ s16x4 vtr(const LAS unsigned char* p) { typedef short v4i16_t __attribute__((ext_vector_type(4))); return __builtin_bit_cast(s16x4, __builtin_amdgcn_ds_read_tr16_b64_v4i16((LAS v4i16_t*)p)); }
#define ATT_WAIT_V(n) asm volatile("s_waitcnt vmcnt(" #n ")" ::: "memory")

__device__ __forceinline__ void attn_unit(int bh, int qb, const bf16_t* Qg, const bf16_t* Kg, const bf16_t* Vg, bf16_t* Og, LAS unsigned char* lds) {
    int tid = threadIdx.x; asm volatile("" : "+v"(tid));
    const int lane = tid & 63, r32 = lane & 31, hi = lane >> 5; const int wid = __builtin_amdgcn_readfirstlane(tid >> 6);
    const bool late = wid >= 4;
    const int b = bh >> 3, h = bh & 7;
    const int NT = 4 * (qb + 1);
    const char* kbase = (const char*)Kg + (size_t)bh * 64 * KSLOT + lane * 16;
    const char* vbase = (const char*)Vg + (size_t)bh * 64 * VSLOT + lane * 16;
    LAS float* wsf = (LAS float*)(lds + LDS_WS) + wid * 64;
#define ATT_ISSUE_K(t, slot) do { _Pragma("unroll") for (int _p = 0; _p < 3; ++_p) __builtin_amdgcn_global_load_lds((const unsigned*)(kbase + (size_t)(t) * KSLOT + (wid + 8 * _p) * 1024), (LAS unsigned*)(lds + LDS_K + (slot) * KSLOT + (wid + 8 * _p) * 1024), 16, 0, 0); } while (0)
#define ATT_ISSUE_V(t, slot) do { _Pragma("unroll") for (int _p = 0; _p < 2; ++_p) __builtin_amdgcn_global_load_lds((const unsigned*)(vbase + (size_t)(t) * VSLOT + (wid + 8 * _p) * 1024), (LAS unsigned*)(lds + LDS_V + (slot) * VSLOT + (wid + 8 * _p) * 1024), 16, 0, 0); } while (0)
    const bf16_t* qrow = Qg + ((size_t)bh * TOK + qb * 256 + wid * 32 + r32) * 192 + hi * 8;
    bf16x8 qf[12];
#pragma unroll
    for (int d0 = 0; d0 < 12; ++d0) qf[d0] = *(const bf16x8*)(qrow + d0 * 16);
    ATT_ISSUE_K(0, 0); ATT_ISSUE_V(0, 0); ATT_ISSUE_K(1, 1);
    float mrow = -1e30f, lsum = 0.f;
    f32x16 o[4];
#pragma unroll
    for (int d = 0; d < 4; ++d) o[d] = (f32x16){0.f, 0.f, 0.f, 0.f, 0.f, 0.f, 0.f, 0.f, 0.f, 0.f, 0.f, 0.f, 0.f, 0.f, 0.f, 0.f};
    const int qrel = wid * 32 + r32;
    u32x4 pw[4] = {(u32x4){0u, 0u, 0u, 0u}, (u32x4){0u, 0u, 0u, 0u}, (u32x4){0u, 0u, 0u, 0u}, (u32x4){0u, 0u, 0u, 0u}};
    bool pvalid = false;
    const LAS unsigned char* vp0 = lds + LDS_V + ((lane >> 4) & 1) * 32 + (lane & 3) * 8 + (4 * hi + ((lane & 15) >> 2)) * 64;
#define ATT_LDV(buf, d) do { _Pragma("unroll") for (int ks = 0; ks < 4; ++ks) { vlo[buf][ks] = vtr(vp + (d) * 4096 + ks * 1024); vhi[buf][ks] = vtr(vp + (d) * 4096 + ks * 1024 + 512); } } while (0)
#define ATT_PV(vslot) do { const LAS unsigned char* vp = vp0 + (vslot) * VSLOT; s16x4 vlo[2][4], vhi[2][4]; \
        ATT_LDV(0, 0); \
        _Pragma("unroll") for (int d = 0; d < 4; ++d) { \
            if (d < 3) ATT_LDV((d + 1) & 1, d + 1); \
            __builtin_amdgcn_sched_barrier(0); \
            _Pragma("unroll") for (int ks = 0; ks < 4; ++ks) { const s16x4 lo = vlo[d & 1][ks], hv = vhi[d & 1][ks]; \
                const bf16x8 vf = (bf16x8){lo[0], lo[1], lo[2], lo[3], hv[0], hv[1], hv[2], hv[3]}; \
                o[d] = __builtin_amdgcn_mfma_f32_32x32x16_bf16(__builtin_bit_cast(bf16x8, pw[ks]), vf, o[d], 0, 0, 0); } \
            __builtin_amdgcn_sched_barrier(0); } } while (0)
    int s0 = 0, sm1 = 2;
    for (int t = 0; t <= NT; ++t) {
        if (t + 1 < NT) ATT_WAIT_V(3); else ATT_WAIT_V(0);
        __builtin_amdgcn_s_barrier(); asm volatile("" ::: "memory");
        const int s1 = (s0 == 2) ? 0 : s0 + 1;
        if (t + 1 < NT) ATT_ISSUE_V(t + 1, s1);
        if (t + 2 < NT) ATT_ISSUE_K(t + 2, sm1);
        if (late && pvalid) { ATT_PV(sm1); pvalid = false; }
        const int jb = t - (NT - 4);
        if (t < NT && (jb <= 0 || 64 * jb <= wid * 32 + 31)) {
            f32x16 p0 = (f32x16){0.f, 0.f, 0.f, 0.f, 0.f, 0.f, 0.f, 0.f, 0.f, 0.f, 0.f, 0.f, 0.f, 0.f, 0.f, 0.f}, p1 = p0;
            const LAS unsigned char* kp = lds + LDS_K + s0 * KSLOT + hi * 1024 + r32 * 16;
            bf16x8 kf[2][4];
#define ATT_LDK(buf, g) do { kf[buf][0] = *(const LAS bf16x8*)(kp + (2 * (g)) * 2048); kf[buf][1] = *(const LAS bf16x8*)(kp + (2 * (g)) * 2048 + 512); \
                             kf[buf][2] = *(const LAS bf16x8*)(kp + (2 * (g) + 1) * 2048); kf[buf][3] = *(const LAS bf16x8*)(kp + (2 * (g) + 1) * 2048 + 512); } while (0)
            ATT_LDK(0, 0);
#pragma unroll
            for (int g = 0; g < 6; ++g) {
                if (g < 5) ATT_LDK((g + 1) & 1, g + 1);
                __builtin_amdgcn_sched_barrier(0);
                p0 = __builtin_amdgcn_mfma_f32_32x32x16_bf16(kf[g & 1][0], qf[2 * g], p0, 0, 0, 0);
                p1 = __builtin_amdgcn_mfma_f32_32x32x16_bf16(kf[g & 1][1], qf[2 * g], p1, 0, 0, 0);
                p0 = __builtin_amdgcn_mfma_f32_32x32x16_bf16(kf[g & 1][2], qf[2 * g + 1], p0, 0, 0, 0);
                p1 = __builtin_amdgcn_mfma_f32_32x32x16_bf16(kf[g & 1][3], qf[2 * g + 1], p1, 0, 0, 0);
                __builtin_amdgcn_sched_barrier(0);
            }
#undef ATT_LDK
            if (jb >= 0) {
                const int kb = 64 * jb + 4 * hi;
#pragma unroll
                for (int r = 0; r < 16; ++r) { const int kv = kb + (r & 3) + 8 * (r >> 2); if (kv > qrel) p0[r] = -INFINITY; if (kv + 32 > qrel) p1[r] = -INFINITY; }
            }
            float rm = fmaxf(p0[0], p1[0]);
#pragma unroll
            for (int r = 1; r < 16; ++r) rm = fmaxf(rm, fmaxf(p0[r], p1[r]));
            { auto rr = __builtin_amdgcn_permlane32_swap(__float_as_uint(rm), __float_as_uint(rm), false, false); rm = fmaxf(__uint_as_float(rr[0]), __uint_as_float(rr[1])); }
            const float mnew = fmaxf(mrow, rm);
            if (__any(mnew > mrow)) {
                const float alpha = __builtin_amdgcn_exp2f(mrow - mnew); lsum *= alpha; mrow = mnew;
                if (hi == 0) wsf[r32] = alpha;
                asm volatile("s_waitcnt lgkmcnt(0)" ::: "memory");
#pragma unroll
                for (int r = 0; r < 16; ++r) { const float a = wsf[crow(r, hi)];
#pragma unroll
                    for (int d = 0; d < 4; ++d) o[d][r] *= a; }
            }
            float ps = 0.f;
#pragma unroll
            for (int r = 0; r < 16; ++r) { p0[r] = __builtin_amdgcn_exp2f(p0[r] - mrow); p1[r] = __builtin_amdgcn_exp2f(p1[r] - mrow); ps += p0[r] + p1[r]; }
            lsum += ps;
#pragma unroll
            for (int k = 0; k < 2; ++k) {
                pw[k] = (u32x4){cvt_pk_bf16(p0[8 * k], p0[8 * k + 1]), cvt_pk_bf16(p0[8 * k + 2], p0[8 * k + 3]), cvt_pk_bf16(p0[8 * k + 4], p0[8 * k + 5]), cvt_pk_bf16(p0[8 * k + 6], p0[8 * k + 7])};
                pw[2 + k] = (u32x4){cvt_pk_bf16(p1[8 * k], p1[8 * k + 1]), cvt_pk_bf16(p1[8 * k + 2], p1[8 * k + 3]), cvt_pk_bf16(p1[8 * k + 4], p1[8 * k + 5]), cvt_pk_bf16(p1[8 * k + 6], p1[8 * k + 7])};
            }
            if (late) pvalid = true; else ATT_PV(s0);
        }
        sm1 = s0; s0 = s1;
    }
    { auto rr = __builtin_amdgcn_permlane32_swap(__float_as_uint(lsum), __float_as_uint(lsum), false, false); lsum = __uint_as_float(rr[0]) + __uint_as_float(rr[1]); }
    if (hi == 0) wsf[32 + r32] = lsum;
    asm volatile("s_waitcnt lgkmcnt(0)" ::: "memory");
    bf16_t* orow = Og + ((size_t)b * TOK + qb * 256 + wid * 32) * 1024 + h * 128 + r32;
#pragma unroll
    for (int r = 0; r < 16; ++r) { const int q = crow(r, hi); const float il = __builtin_amdgcn_rcpf(wsf[32 + q]);
#pragma unroll
        for (int d = 0; d < 4; ++d) { const unsigned w = cvt_pk_bf16(o[d][r] * il, 0.f); orow[(size_t)q * 1024 + d * 32] = (bf16_t)(w & 0xffffu); } }
    asm volatile("s_waitcnt lgkmcnt(0)" ::: "memory"); __builtin_amdgcn_s_barrier(); asm volatile("" ::: "memory");
#undef ATT_ISSUE_K
#undef ATT_ISSUE_V
#undef ATT_PV
#undef ATT_LDV
}

__device__ __forceinline__ void attn_phase(const Params& p, LAS unsigned char* lds, int vcu, int G) {
    const int nitems = p.NB * 8 * 8;
    for (int it = vcu; it < nitems; it += G) {
        const int bh = it >> 3, s = it & 7;
        attn_unit(bh, s, p.Q, p.K, p.V, p.ATT, lds);
        attn_unit(bh, 15 - s, p.Q, p.K, p.V, p.ATT, lds);
    }
}
}
namespace ssm {
constexpr int CH = 256, NCH = TOK / CH, XROW = 272;
struct Cplx { float r, i; };
__device__ __forceinline__ Cplx cmul(Cplx a, Cplx b) { return {a.r * b.r - a.i * b.i, a.r * b.i + a.i * b.r}; }

template <bool OUT>
__device__ __forceinline__ void ssm_item(const Params& p, int item, LAS unsigned char* xt  ) {
    int lane = threadIdx.x & 63; asm volatile("" : "+v"(lane));
    const int j = lane & 31, hi = lane >> 5;
    const int cp = item & 7, g = (item >> 3) & 31, b = item >> 8;
    const int chunk = 2 * cp + hi;
    const float* a_re = p.in[11]; const float* a_im = p.in[12]; const float* log_dt = p.in[13];
    const float* b_re = p.in[14]; const float* b_im = p.in[15]; const float* c_re = p.in[16]; const float* c_im = p.in[17]; const float* dsk = p.in[18];
    const float dt = expf(log_dt[g]);
    Cplx lam[2], fac[2];
#pragma unroll
    for (int k = 0; k < 2; ++k) { const int pp = g * 64 + 32 * k + j; const float ar = a_re[pp], ai = a_im[pp];
        const float mag = expf(ar * dt); lam[k] = {mag * cosf(ai * dt), mag * sinf(ai * dt)};
        const float nr = lam[k].r - 1.f, ni = lam[k].i, den = ar * ar + ai * ai; fac[k] = {(nr * ar + ni * ai) / den, (ni * ar - nr * ai) / den}; }
    bf16x8 bfr[4];
#pragma unroll
    for (int k = 0; k < 2; ++k) { const int pp = g * 64 + 32 * k + j; float br[8], bi[8];
        const f32x4 r0 = *(const f32x4*)(b_re + pp * 16 + 8 * hi), r1 = *(const f32x4*)(b_re + pp * 16 + 8 * hi + 4);
        const f32x4 i0 = *(const f32x4*)(b_im + pp * 16 + 8 * hi), i1 = *(const f32x4*)(b_im + pp * 16 + 8 * hi + 4);
#pragma unroll
        for (int q = 0; q < 4; ++q) { br[q] = r0[q]; br[4 + q] = r1[q]; bi[q] = i0[q]; bi[4 + q] = i1[q]; }
        u32x4 wr_, wi_;
#pragma unroll
        for (int q = 0; q < 4; ++q) { const float ar0 = fac[k].r * br[2 * q] - fac[k].i * bi[2 * q], ar1 = fac[k].r * br[2 * q + 1] - fac[k].i * bi[2 * q + 1];
            const float ai0 = fac[k].r * bi[2 * q] + fac[k].i * br[2 * q], ai1 = fac[k].r * bi[2 * q + 1] + fac[k].i * br[2 * q + 1];
            wr_[q] = cvt_pk_bf16(ar0, ar1); wi_[q] = cvt_pk_bf16(ai0, ai1); }
        bfr[2 * k] = __builtin_bit_cast(bf16x8, wr_); bfr[2 * k + 1] = __builtin_bit_cast(bf16x8, wi_); }
    const int hA = (j >> 2) & 1, rA = (j & 3) + 4 * (j >> 3);
    const size_t rowA0 = (size_t)b * TOK + (size_t)(2 * cp + hA) * CH + rA;
    const bf16_t* ua = p.U + rowA0 * 512 + g * 16 + 8 * hi;
    Cplx x[2] = {{0.f, 0.f}, {0.f, 0.f}};
    bf16x8 cfr[8]; float dv[8];
    if (OUT) {
        Cplx l256[2];
#pragma unroll
        for (int k = 0; k < 2; ++k) { Cplx t = lam[k];
#pragma unroll
            for (int s = 0; s < 8; ++s) t = cmul(t, t);
            l256[k] = t; }
        const float* sl = p.sloc + ((size_t)(b * 32 + g) * NCH) * 128;
        for (int c = 0; c < 2 * cp + 1; ++c) { if (c < chunk) {
#pragma unroll
            for (int k = 0; k < 2; ++k) { const float2 s = *(const float2*)(sl + (size_t)c * 128 + (32 * k + j) * 2); const Cplx t = cmul(l256[k], x[k]); x[k] = {t.r + s.x, t.i + s.y}; } } }
#pragma unroll
        for (int ks = 0; ks < 8; ++ks) { u32x4 w = (u32x4){0u, 0u, 0u, 0u};
            if (j < 16) { const f32x4 cr = *(const f32x4*)(c_re + (g * 16 + j) * 64 + 8 * ks + 4 * hi), ci = *(const f32x4*)(c_im + (g * 16 + j) * 64 + 8 * ks + 4 * hi);
#pragma unroll
                for (int q = 0; q < 4; ++q) w[q] = cvt_pk_bf16(cr[q], -ci[q]); }
            cfr[ks] = __builtin_bit_cast(bf16x8, w); }
#pragma unroll
        for (int q = 0; q < 8; ++q) dv[q] = dsk[g * 16 + 4 * hi + (q & 3) + 8 * (q >> 2)];
    }
    for (int tile = 0; tile < CH / 16; ++tile) {
        const bf16x8 af = *(const bf16x8*)(ua + (size_t)tile * 16 * 512);
        f32x16 bu[4];
#pragma unroll
        for (int q = 0; q < 4; ++q) bu[q] = __builtin_amdgcn_mfma_f32_32x32x16_bf16(af, bfr[q], (f32x16){0.f, 0.f, 0.f, 0.f, 0.f, 0.f, 0.f, 0.f, 0.f, 0.f, 0.f, 0.f, 0.f, 0.f, 0.f, 0.f}, 0, 0, 0);
#pragma unroll
        for (int r = 0; r < 16; ++r) {
#pragma unroll
            for (int k = 0; k < 2; ++k) { const float nr = fmaf(lam[k].r, x[k].r, fmaf(-lam[k].i, x[k].i, bu[2 * k][r])), ni = fmaf(lam[k].r, x[k].i, fmaf(lam[k].i, x[k].r, bu[2 * k + 1][r]));
                x[k] = {nr, ni}; if (OUT) { bu[2 * k][r] = nr; bu[2 * k + 1][r] = ni; } }
        }
        if (OUT) {
#pragma unroll
            for (int r = 0; r < 16; ++r) { LAS unsigned* rowp = (LAS unsigned*)(xt + (16 * hi + r) * XROW);
                rowp[j] = cvt_pk_bf16(bu[0][r], bu[1][r]); rowp[32 + j] = cvt_pk_bf16(bu[2][r], bu[3][r]); }
            asm volatile("s_waitcnt lgkmcnt(0)" ::: "memory");
            f32x16 y = (f32x16){0.f, 0.f, 0.f, 0.f, 0.f, 0.f, 0.f, 0.f, 0.f, 0.f, 0.f, 0.f, 0.f, 0.f, 0.f, 0.f};
#pragma unroll
            for (int ks = 0; ks < 8; ++ks) { const bf16x8 xf = *(const LAS bf16x8*)(xt + j * XROW + (16 * ks + 8 * hi) * 2);
                y = __builtin_amdgcn_mfma_f32_32x32x16_bf16(cfr[ks], xf, y, 0, 0, 0); }
            const int hn = j >> 4, rn = j & 15;
            const size_t row = (size_t)b * TOK + (size_t)(2 * cp + hn) * CH + tile * 16 + rn;
#pragma unroll
            for (int q2 = 0; q2 < 2; ++q2) { const int c0 = 4 * hi + 8 * q2;
                const u32x2 uw = *(const u32x2*)(p.U + row * 512 + g * 16 + c0);
                const float u0 = bf_lo(uw.x), u1 = bf_hi(uw.x), u2 = bf_lo(uw.y), u3 = bf_hi(uw.y);
                const float z0 = gelu_t(y[4 * q2 + 0] + dv[4 * q2 + 0] * u0), z1 = gelu_t(y[4 * q2 + 1] + dv[4 * q2 + 1] * u1);
                const float z2 = gelu_t(y[4 * q2 + 2] + dv[4 * q2 + 2] * u2), z3 = gelu_t(y[4 * q2 + 3] + dv[4 * q2 + 3] * u3);
                *(u32x2*)(p.Z + row * 512 + g * 16 + c0) = (u32x2){cvt_pk_bf16(z0, z1), cvt_pk_bf16(z2, z3)}; }
            asm volatile("s_waitcnt lgkmcnt(0)" ::: "memory");
        }
    }
    if (!OUT) {
        float* sl = p.sloc + (((size_t)(b * 32 + g) * NCH + chunk) * 64) * 2;
#pragma unroll
        for (int k = 0; k < 2; ++k) *(float2*)(sl + (32 * k + j) * 2) = make_float2(x[k].r, x[k].i);
    }
}
template <bool OUT>
__device__ __forceinline__ void ssm_phase(const Params& p, LAS unsigned char* lds, int vcu, int G) {
    const int wid = __builtin_amdgcn_readfirstlane(threadIdx.x >> 6);
    const int nitems = p.NB * 32 * 8;
    for (int it = vcu * 8 + wid; it < nitems; it += G * 8) ssm_item<OUT>(p, it, lds + wid * (32 * XROW));
}
}
__device__ __forceinline__ int src_col(int mode, int n) {
    if (mode == 0) return n;
    if (mode == 1) { if (n < 1152) return n; if (n < 1216) return 1152 + dperm(n - 1152); if (n < 1280) return -1; if (n < 2304) return 1216 + (n - 1280); return 2240 + (n - 2304); }
    const int h = n >> 8, c = n & 255; if (c < 128) return 192 * h + c; if (c < 192) return 192 * h + 128 + dperm(c - 128); return -1;
}
__device__ __forceinline__ unsigned f2bf(float f) { unsigned u = __builtin_bit_cast(unsigned, f); return (u + 0x7fffu + ((u >> 16) & 1u)) >> 16; }
__device__ __forceinline__ unsigned pk2(float lo, float hi) { return f2bf(lo) | (f2bf(hi) << 16); }
__device__ __forceinline__ void p0_item(const float* W, int K, int Nsrc, const float* gain, bf16_t* WT, int nblk, int mode, LAS float* scr, int item, int lane) {
    const int kb = item / nblk, nb = item % nblk, k0 = 64 * kb, n0 = 32 * nb;
    const int sc = src_col(mode, n0 + (lane & 31));
#pragma unroll 8
    for (int i = 0; i < 32; ++i) { const int kk = 2 * i + (lane >> 5); float v = 0.f; if (sc >= 0) { v = W[(size_t)(k0 + kk) * Nsrc + sc]; if (gain) v *= gain[k0 + kk]; } scr[kk * 33 + (lane & 31)] = v; }
    asm volatile("s_waitcnt lgkmcnt(0)" ::: "memory");
    const int c = lane & 7;
#pragma unroll
    for (int jj = 0; jj < 4; ++jj) { const int n = (lane >> 3) + 8 * jj; const LAS float* s = scr + (8 * c) * 33 + n;
        u32x4 o; o.x = pk2(s[0 * 33], s[1 * 33]); o.y = pk2(s[2 * 33], s[3 * 33]); o.z = pk2(s[4 * 33], s[5 * 33]); o.w = pk2(s[6 * 33], s[7 * 33]);
        *(u32x4*)(WT + (size_t)(n0 + n) * K + k0 + 8 * c) = o; }
    asm volatile("s_waitcnt lgkmcnt(0)" ::: "memory");
}
__device__ __forceinline__ float wave_sum(float v) {
#pragma unroll
    for (int o = 1; o < 64; o <<= 1) v += __shfl_xor(v, o);
    return v;
}
__device__ __forceinline__ void p0_prologue(const Params& p, LAS unsigned char* lds, int vcu, int G) {
    const int lane = threadIdx.x & 63, wid = __builtin_amdgcn_readfirstlane(threadIdx.x >> 6);
    LAS float* scr = (LAS float*)(lds + wid * 16384);
    const int gw = vcu * 8 + wid, NGW = G * 8;
    constexpr int I1 = 16 * 104, IQ = 6 * 64, IKV = 4 * 64, IGL = 8 * 16, IOS = 8 * 32, IOM = 16 * 32, IOU = 16 * 32, IUP = 16 * 128, IDN = 64 * 32;
    constexpr int NITEMS = I1 + IQ + IKV + IGL + IOS + IOM + IOU + IUP + IDN;
    for (int it = gw; it < NITEMS; it += NGW) {
        int r = it;
        if (r < I1) { p0_item(p.in[3], 1024, 3264, p.in[2], p.W1t, 104, 1, scr, r, lane); continue; } r -= I1;
        if (r < IQ) { p0_item(p.in[6], 384, 1536, p.in[4], p.Wqt, 64, 2, scr, r, lane); continue; } r -= IQ;
        if (r < IKV) { p0_item(p.in[7], 256, 2048, p.in[5], p.Wkvt, 64, 0, scr, r, lane); continue; } r -= IKV;
        if (r < IGL) { p0_item(p.in[19], 512, 512, nullptr, p.Wglut, 16, 0, scr, r, lane); continue; } r -= IGL;
        if (r < IOS) { p0_item(p.in[21], 512, 1024, nullptr, p.Wost, 32, 0, scr, r, lane); continue; } r -= IOS;
        if (r < IOM) { p0_item(p.in[10], 1024, 1024, nullptr, p.Womt, 32, 0, scr, r, lane); continue; } r -= IOM;
        if (r < IOU) { p0_item(p.in[22], 1024, 1024, nullptr, p.Woutt, 32, 0, scr, r, lane); continue; } r -= IOU;
        if (r < IUP) { p0_item(p.in[24], 1024, 4096, p.in[23], p.Wupt, 128, 0, scr, r, lane); continue; } r -= IUP;
        p0_item(p.in[25], 4096, 1024, nullptr, p.Wdnt, 32, 0, scr, r, lane);
    }
    const int M = p.NB * TOK;
    for (int m0 = gw * 4; m0 < M; m0 += NGW * 4) {
        f32x4 v[4][4]; float s[4];
#pragma unroll
        for (int r = 0; r < 4; ++r) { const f32x4* xr = (const f32x4*)(p.x + (size_t)(m0 + r) * 1024) + lane;
#pragma unroll
            for (int jj = 0; jj < 4; ++jj) v[r][jj] = xr[64 * jj]; }
#pragma unroll
        for (int r = 0; r < 4; ++r) { s[r] = 0.f;
#pragma unroll
            for (int jj = 0; jj < 4; ++jj) s[r] += sq4(v[r][jj]);
            s[r] = wave_sum(s[r]);
            u32x2* o8 = (u32x2*)(p.XB + (size_t)(m0 + r) * 1024) + lane;
#pragma unroll
            for (int jj = 0; jj < 4; ++jj) o8[64 * jj] = (u32x2){cvt_pk_bf16(v[r][jj][0], v[r][jj][1]), cvt_pk_bf16(v[r][jj][2], v[r][jj][3])}; }
        if (lane < 4) { const int mm = m0 + lane; const float sv = lane == 0 ? s[0] : lane == 1 ? s[1] : lane == 2 ? s[2] : s[3];
            p.inv_x[mm] = rsqrtf(sv * (1.f / 1024.f) + 1e-6f); p.ssq_q[mm] = 0.f; p.ssq_kv[mm] = 0.f; p.ssq_kpe[mm] = 0.f; p.ssq_h[mm] = 0.f; }
        { const int mm = m0 + (lane >> 5) * 2, i = lane & 31;
#pragma unroll
          for (int r = 0; r < 2; ++r) { const float ang = (float)p.pos[mm + r] * p.inv_freq[i]; p.rcos[(size_t)(mm + r) * 32 + i] = cosf(ang); p.rsin[(size_t)(mm + r) * 32 + i] = sinf(ang); } }
    }
}

constexpr int LDS_RING = 131072, LDS_AUX = LDS_RING, LDS_BYTES = LDS_RING + 4096 + 256;
#ifndef MK_MODE
#define MK_MODE 0
#endif
namespace cg = cooperative_groups;
template <int K>
__device__ __forceinline__ void run_phase(const Params& p, LAS unsigned char* lds, LAS unsigned char* aux, int vcu, int G, int bx, int dry) {
    const int M = p.NB * TOK;
    if (K == 0) { p0_prologue(p, lds, vcu, G); __syncthreads(); }
    if (K == 1) {
        pg8::Gemm g{p.XB, 1024, p.W1t, 1024, M, 3328, 1024}; pg8::StaticOrder S; S.init(M, 3328, G, bx);
        EpiG1 E{p.inv_x, p.U, p.QL, p.CKV, p.kpe, p.SGS, p.SGM, p.ssq_q, p.ssq_kv, p.ssq_kpe, p.rcos, p.rsin, p.in[9], dry};
        pg8::gemm_phase(lds, aux, g, S, E);
    }
#ifndef MK_DUPSUB
#define MK_DUPSUB 7
#endif
#define SUBON(b) (!dry || (MK_DUPSUB & (b)))
    if (K == 2) {
        if (SUBON(4) && (vcu & 1)) { ssm::ssm_phase<false>(p, lds, vcu, G); __syncthreads(); }
        if (SUBON(1)) { pg8::Gemm g{p.QL, 384, p.Wqt, 384, M, 2048, 384}; pg8::StaticOrder S; S.init(M, 2048, G, bx);
          EpiQ E{p.ssq_q, p.rcos, p.rsin, p.in[8], p.Q}; pg8::gemm_phase(lds, aux, g, S, E); }
        if (SUBON(2)) { pg8::Gemm g{p.CKV, 256, p.Wkvt, 256, M, 2048, 256}; pg8::StaticOrder S; S.init(M, 2048, G, bx);
          EpiKV E{p.ssq_kv, p.ssq_kpe, p.in[9], p.kpe, p.K, p.V}; pg8::gemm_phase(lds, aux, g, S, E); }
        if (SUBON(4) && !(vcu & 1)) ssm::ssm_phase<false>(p, lds, vcu, G);
        __syncthreads();
    }
    if (K == 3) {
        if (SUBON(1)) att::attn_phase(p, lds, vcu, G);
        if (SUBON(2)) ssm::ssm_phase<true>(p, lds, vcu, G);
        __syncthreads();
    }
    if (K == 4) {
        pg8::Gemm g{p.Z, 512, p.Wglut, 512, M, 512, 512}; pg8::StaticOrder S; S.init(M, 512, G, bx);
        EpiGlu E{p.Z, p.in[20], p.Z2}; pg8::gemm_phase(lds, aux, g, S, E);
    }
    if (K == 5) {
        { pg8::Gemm g{p.Z2, 512, p.Wost, 512, M, 1024, 512}; pg8::StaticOrder S; S.init(M, 1024, G, bx);
          EpiMix<false> E{p.SGS, p.T1}; pg8::gemm_phase(lds, aux, g, S, E); }
        { pg8::Gemm g{p.ATT, 1024, p.Womt, 1024, M, 1024, 1024}; pg8::StaticOrder S; S.init(M, 1024, G, bx);
          EpiMix<true> E{p.SGM, p.T1}; pg8::gemm_phase(lds, aux, g, S, E); }
    }
    if (K == 6) {
        pg8::Gemm g{p.T1, 1024, p.Woutt, 1024, M, 1024, 1024}; pg8::StaticOrder S; S.init(M, 1024, G, bx);
        EpiOut E{p.x, p.out, p.HB, p.ssq_h, dry}; pg8::gemm_phase(lds, aux, g, S, E);
    }
    if (K == 7) {
        pg8::Gemm g{p.HB, 1024, p.Wupt, 1024, M, 4096, 1024}; pg8::StaticOrder S; S.init(M, 4096, G, bx);
        EpiUp E{p.ssq_h, p.HID}; pg8::gemm_phase(lds, aux, g, S, E);
    }
    if (K == 8) {
        pg8::Gemm g{p.HID, 4096, p.Wdnt, 4096, M, 1024, 4096}; pg8::StaticOrder S; S.init(M, 1024, G, bx);
        EpiDown E{p.HB, p.out, 1.f}; pg8::gemm_phase(lds, aux, g, S, E);
    }
}
__global__ void __launch_bounds__(512, 2) mk_kernel(Params p) {
    extern __shared__ __attribute__((aligned(16))) unsigned char lds_raw[];
    LAS unsigned char* lds = (LAS unsigned char*)lds_raw;
    LAS unsigned char* aux = lds + LDS_AUX;
    const int G = gridDim.x, bx = blockIdx.x;
    const int vcu = (G % 8 == 0) ? (bx % 8) * (G / 8) + bx / 8 : bx;
#ifndef MK_PHMASK
#define MK_PHMASK 0x1ff
#endif
#define IN(k) (((MK_PHMASK >> (k)) & 1) && p.ph_lo <= (k) && (k) < p.ph_hi)
#if MK_MODE == 0
#ifndef MK_CGSYNC
#define MK_CGSYNC 0
#endif
    volatile LAS unsigned* bst = (volatile LAS unsigned*)(lds + LDS_AUX + 4096);
    if (threadIdx.x < 2) bst[threadIdx.x] = 0u;
    __syncthreads();
    XcdBarrier xbar = xcd_barrier_post(p.ctl + 4096, bst);
    if (p.NB < 0) cg::this_grid().sync();
#ifndef MK_BAR
#define MK_BAR 2
#endif
    unsigned bar_epoch = 0;
#define SEAMX() do { if (MK_CGSYNC) cg::this_grid().sync(); else if (MK_BAR == 1) ctr_barrier(p.ctl + 1024, p.ctl + 1088, bar_epoch); else xcd_barrier(xbar); } while (0)
#define SEAM(k) do { if (IN(k) && IN((k) + 1)) SEAMX(); } while (0)
#else
#define SEAMX() do { } while (0)
#define SEAM(k) do { } while (0)
#endif
#ifndef MK_DUP
#define MK_DUP -1
#endif
#define PHASE(k) do { if (IN(k)) { run_phase<k>(p, lds, aux, vcu, G, bx, 0); if (MK_DUP == (k)) { SEAMX(); run_phase<k>(p, lds, aux, vcu, G, bx, 1); } } SEAM(k); } while (0)
    PHASE(0); PHASE(1); PHASE(2); PHASE(3); PHASE(4); PHASE(5); PHASE(6); PHASE(7); PHASE(8);
#undef IN
#undef SEAM
}
constexpr int N_PHASES = 9;

static size_t al(size_t v) { return (v + 255) & ~(size_t)255; }
static Params make_params(void* const* d_in, float* out, unsigned char* ws, int NB, int b0, bool alias, unsigned char* gates) {
    Params p{};
    for (int i = 0; i < 26; ++i) p.in[i] = (const float*)d_in[i];
    p.out = out; p.NB = NB; p.ph_lo = 0; p.ph_hi = N_PHASES; p.pad = 0;
    p.x = (const float*)d_in[0] + (size_t)b0 * TOK * 1024; p.pos = (const int*)d_in[1] + (size_t)b0 * TOK;
    for (int i = 0; i < 32; ++i) p.inv_freq[i] = powf(10000.0f, -(float)i / 32.0f);
    const size_t M = (size_t)NB * TOK; size_t off = 0;
    auto take = [&](size_t bytes) { unsigned char* q = ws + off; off += al(bytes); return q; };
    p.ctl = (unsigned*)take(1 << 20);
    p.ssq_q = (float*)take(M * 4); p.ssq_kv = (float*)take(M * 4); p.ssq_kpe = (float*)take(M * 4); p.ssq_h = (float*)take(M * 4); p.inv_x = (float*)take(M * 4);
    p.sloc = (float*)take((size_t)NB * 32 * 16 * 128 * 4);
    p.rcos = (float*)take(M * 32 * 4); p.rsin = (float*)take(M * 32 * 4);
    p.kpe = (bf16_t*)take(M * 64 * 2);
    p.W1t = (bf16_t*)take((size_t)3328 * 1024 * 2); p.Wqt = (bf16_t*)take((size_t)2048 * 384 * 2); p.Wkvt = (bf16_t*)take((size_t)2048 * 256 * 2);
    p.Wglut = (bf16_t*)take((size_t)512 * 512 * 2); p.Wost = (bf16_t*)take((size_t)1024 * 512 * 2); p.Womt = (bf16_t*)take((size_t)1024 * 1024 * 2);
    p.Woutt = (bf16_t*)take((size_t)1024 * 1024 * 2); p.Wupt = (bf16_t*)take((size_t)4096 * 1024 * 2); p.Wdnt = (bf16_t*)take((size_t)1024 * 4096 * 2);
    if (alias) {
        unsigned char* rXB = take(M * 2048); unsigned char* rU = take(M * 1024); unsigned char* rQL = take(M * 1280); unsigned char* rQKV = take(M * 8192); unsigned char* rT1 = take(M * 2048);
        p.XB = (bf16_t*)rXB; p.ATT = (bf16_t*)rXB; p.HB = (bf16_t*)rXB;
        p.U = (bf16_t*)rU; p.Z2 = (bf16_t*)rU;
        p.QL = (bf16_t*)rQL; p.CKV = (bf16_t*)(rQL + M * 768); p.Z = (bf16_t*)rQL;
        p.Q = (bf16_t*)rQKV; p.K = (bf16_t*)(rQKV + M * 3072); p.V = (bf16_t*)(rQKV + M * 6144); p.HID = (bf16_t*)rQKV;
        p.T1 = (bf16_t*)rT1;
        p.SGS = (bf16_t*)out; p.SGM = (bf16_t*)((unsigned char*)out + M * 2048);
    } else {
        p.XB = (bf16_t*)take(M * 2048); p.ATT = (bf16_t*)take(M * 2048); p.HB = (bf16_t*)take(M * 2048);
        p.U = (bf16_t*)take(M * 1024); p.Z2 = (bf16_t*)take(M * 1024); p.Z = (bf16_t*)take(M * 1024);
        p.QL = (bf16_t*)take(M * 768); p.CKV = (bf16_t*)take(M * 512);
        p.Q = (bf16_t*)take(M * 3072); p.K = (bf16_t*)take(M * 3072); p.V = (bf16_t*)take(M * 2048); p.HID = (bf16_t*)take(M * 8192);
        p.T1 = (bf16_t*)take(M * 2048);
        p.SGS = (bf16_t*)gates; p.SGM = (bf16_t*)(gates + M * 2048);
    }
    return p;
}
static int g_grid = 0;
static int mk_grid() {
    if (g_grid == 0) {
        int dev = 0, cus = 0, per_cu = 0;
        hipGetDevice(&dev); hipDeviceGetAttribute(&cus, hipDeviceAttributeMultiprocessorCount, dev);
        hipFuncSetAttribute((const void*)mk_kernel, hipFuncAttributeMaxDynamicSharedMemorySize, LDS_BYTES);
        hipOccupancyMaxActiveBlocksPerMultiprocessor(&per_cu, (const void*)mk_kernel, 512, LDS_BYTES);
        (void)hipGetLastError();
        g_grid = (per_cu >= 1) ? cus : -1;
        if (g_grid < 0) fprintf(stderr, "mk: occupancy query reports %d blocks per CU\n", per_cu);
    }
    return g_grid;
}
static void mk_launch_phases(Params p, int lo, int hi, bool coop, hipStream_t stream) {
    const int grid = mk_grid(); if (grid <= 0) return;
    p.ph_lo = lo; p.ph_hi = hi;
    if (coop) { void* args[] = {&p}; hipError_t e = hipLaunchCooperativeKernel((const void*)mk_kernel, dim3(grid), dim3(512), args, LDS_BYTES, stream);
        if (e != hipSuccess) fprintf(stderr, "mk: cooperative launch failed: %s\n", hipGetErrorString(e)); }
    else hipLaunchKernelGGL(mk_kernel, dim3(grid), dim3(512), LDS_BYTES, stream, p);
}
#if MK_MODE == 2
struct NaiveBufs { float *XN, *PROJ, *QLN, *CKN, *QR, *KVR, *Qh, *Kh, *Vh, *S, *ATT, *Y, *Z, *G, *Z2, *YS, *YM, *MIX, *T, *H, *HN, *DN; };
static void naive_batch(void* const* d_in, int b, float* ob, const NaiveBufs& n, hipStream_t stream) {
    const float* x = (const float*)d_in[0]; const int* pos = (const int*)d_in[1];
    const float* norm_mix = (const float*)d_in[2]; const float* w_in = (const float*)d_in[3];
    const float* q_a_norm = (const float*)d_in[4]; const float* kv_a_norm = (const float*)d_in[5];
    const float* w_q_b = (const float*)d_in[6]; const float* w_kv_b = (const float*)d_in[7];
    const float* q_norm = (const float*)d_in[8]; const float* k_norm = (const float*)d_in[9];
    const float* w_o_mla = (const float*)d_in[10];
    const float* a_re = (const float*)d_in[11]; const float* a_im = (const float*)d_in[12]; const float* log_dt = (const float*)d_in[13];
    const float* b_re = (const float*)d_in[14]; const float* b_im = (const float*)d_in[15];
    const float* c_re = (const float*)d_in[16]; const float* c_im = (const float*)d_in[17]; const float* dsk = (const float*)d_in[18];
    const float* w_glu = (const float*)d_in[19]; const float* b_glu = (const float*)d_in[20]; const float* w_o_ssm = (const float*)d_in[21];
    const float* w_out = (const float*)d_in[22]; const float* norm_mlp = (const float*)d_in[23];
    const float* w_up = (const float*)d_in[24]; const float* w_down = (const float*)d_in[25];
    const int Mb = SEQ; const float scale = 1.0f / sqrtf(192.f);
    const float* xb = x + (size_t)b * Mb * 1024; const int* pb = pos + (size_t)b * Mb;
    k_rmsnorm<<<Mb, 256, 0, stream>>>(xb, 1024, norm_mix, n.XN, 1024, 1024);
    gemm(stream, n.XN, 1024, w_in, D_IN, n.PROJ, D_IN, Mb, D_IN, 1024, false, 0);
    k_rmsnorm<<<Mb, 256, 0, stream>>>(n.PROJ + OFF_QL, D_IN, q_a_norm, n.QLN, 384, 384);
    k_rmsnorm<<<Mb, 256, 0, stream>>>(n.PROJ + OFF_KV, D_IN, kv_a_norm, n.CKN, 256, 256);
    gemm(stream, n.QLN, 384, w_q_b, 1536, n.QR, 1536, Mb, 1536, 384, false, 0);
    gemm(stream, n.CKN, 256, w_kv_b, 2048, n.KVR, 2048, Mb, 2048, 256, false, 0);
    k_qkprep<<<dim3(Mb, NH), 192, 0, stream>>>(n.QR, n.KVR, n.PROJ, pb, q_norm, k_norm, n.Qh, n.Kh, n.Vh, Mb);
    for (int h = 0; h < NH; ++h) {
        gemm(stream, n.Qh + (size_t)h * Mb * 192, 192, n.Kh + (size_t)h * Mb * 192, 192, n.S, Mb, Mb, Mb, 192, true, 1);
        k_softmax<<<Mb, 256, 0, stream>>>(n.S, Mb, scale);
        gemm(stream, n.S, Mb, n.Vh + (size_t)h * Mb * 128, 128, n.ATT + h * 128, 1024, Mb, 128, Mb, false, 2);
    }
    k_ssm<<<SSM_G, 64, 0, stream>>>(n.PROJ, a_re, a_im, log_dt, b_re, b_im, c_re, c_im, dsk, n.Y, Mb);
    const size_t n512 = (size_t)Mb * 512, n1024 = (size_t)Mb * 1024, n4096 = (size_t)Mb * 4096;
    k_gelu<<<(unsigned)(n512 / 256), 256, 0, stream>>>(n.Y, n.Z, n512);
    gemm(stream, n.Z, 512, w_glu, 512, n.G, 512, Mb, 512, 512, false, 0);
    k_glu<<<(unsigned)(n512 / 256), 256, 0, stream>>>(n.Z, n.G, b_glu, n.Z2, n512);
    gemm(stream, n.Z2, 512, w_o_ssm, 1024, n.YS, 1024, Mb, 1024, 512, false, 0);
    gemm(stream, n.ATT, 1024, w_o_mla, 1024, n.YM, 1024, Mb, 1024, 1024, false, 0);
    k_mix<<<(unsigned)(n1024 / 256), 256, 0, stream>>>(n.PROJ, n.YS, n.YM, n.MIX, n1024);
    gemm(stream, n.MIX, 1024, w_out, 1024, n.T, 1024, Mb, 1024, 1024, false, 0);
    k_add<<<(unsigned)(n1024 / 256), 256, 0, stream>>>(xb, n.T, n.H, n1024);
    k_rmsnorm<<<Mb, 256, 0, stream>>>(n.H, 1024, norm_mlp, n.HN, 1024, 1024);
    gemm(stream, n.HN, 1024, w_up, 4096, n.S, 4096, Mb, 4096, 1024, false, 0);
    k_relu2<<<(unsigned)(n4096 / 256), 256, 0, stream>>>(n.S, n4096);
    gemm(stream, n.S, 4096, w_down, 1024, n.DN, 1024, Mb, 1024, 4096, false, 0);
    k_add<<<(unsigned)(n1024 / 256), 256, 0, stream>>>(n.H, n.DN, ob, n1024);
}
__device__ __forceinline__ float bfv(const bf16_t* p, size_t i) { return __uint_as_float((unsigned)p[i] << 16); }
__global__ void __launch_bounds__(256) k_check(int id, size_t n, Params p, NaiveBufs nb, const float* nout, const float* oout, float* res) {
    __shared__ float red[4];
    const int Mb = TOK; float sd = 0.f, sr = 0.f;
    for (size_t i = (size_t)blockIdx.x * 256 + threadIdx.x; i < n; i += (size_t)gridDim.x * 256) {
        float a = 0.f, r = 0.f;
        switch (id) {
            case 1: { const size_t rr = i / 512, c = i % 512; a = bfv(p.U, i); r = nb.PROJ[rr * D_IN + c]; } break;
            case 2: { const size_t rr = i / 384, c = i % 384; a = bfv(p.QL, i); r = nb.PROJ[rr * D_IN + 512 + c]; } break;
            case 3: { const size_t rr = i / 256, c = i % 256; a = bfv(p.CKV, i); r = nb.PROJ[rr * D_IN + 896 + c]; } break;
            case 4: { const size_t rr = i / 1024, c = i % 1024; a = bfv(p.SGS, i); r = sigmoidf_(nb.PROJ[rr * D_IN + OFF_GS + c]); } break;
            case 5: { const size_t rr = i / 1024, c = i % 1024; a = bfv(p.SGM, i); r = sigmoidf_(nb.PROJ[rr * D_IN + OFF_GM + c]); } break;
            case 6: case 7: { const size_t h = i / ((size_t)Mb * 192), l = (i / 192) % Mb, s = i % 192; const size_t d = s < 128 ? s : 128 + dperm((int)s - 128);
                if (id == 6) { a = bfv(p.Q, i); r = nb.Qh[(h * Mb + l) * 192 + d] * QSCALE; }
                else { a = bfv(p.K, ((h * 64 + l / 64) * 24 + s / 8) * 512 + (l % 64) * 8 + s % 8); r = nb.Kh[(h * Mb + l) * 192 + d]; } } break;
            case 8: { const size_t h = i / ((size_t)Mb * 128), l = (i / 128) % Mb, d = i % 128; a = bfv(p.V, ((h * 64 + l / 64) * 4 + d / 32) * 2048 + (l % 64) * 32 + d % 32); r = nb.Vh[(h * Mb + l) * 128 + d]; } break;
            case 9: a = bfv(p.ATT, i); r = nb.ATT[i]; break;
            case 10: a = bfv(p.Z, i); r = nb.Z[i]; break;
            case 11: a = bfv(p.Z2, i); r = nb.Z2[i]; break;
            case 12: a = bfv(p.T1, i); r = nb.MIX[i]; break;
            case 13: a = bfv(p.HB, i); r = nb.H[i]; break;
            case 14: a = bfv(p.HID, i); r = nb.S[i]; break;
            case 15: a = oout[i]; r = nout[i]; break;
        }
        const float d = a - r; sd += d * d; sr += r * r;
    }
    sd = block_sum256(sd, red); sr = block_sum256(sr, red);
    if (threadIdx.x == 0) { atomicAdd(res + 2 * id, sd); atomicAdd(res + 2 * id + 1, sr); }
}
__global__ void k_final(const float* res, float* out, int nchk, int first) {
    float code = 9900.f;
    for (int id = first; id <= nchk; ++id) { const float rvr = res[2 * id] / res[2 * id + 1];
        if (!(rvr < 2e-4f)) { const int sev = !(rvr < 0.1f) ? 0 : (rvr >= 1e-2f) ? 1 : (rvr >= 1e-3f) ? 2 : 3; code = 100.f * id + 10.f * sev; break; } }
    out[0] = code;
}
#ifndef MK_FIRST_CHECK
#define MK_FIRST_CHECK 1
#endif
extern "C" void kernel_launch(void* const* d_in, const int* in_sizes, int n_in, void* d_out, int out_size, void* d_ws, size_t ws_size, hipStream_t stream) {
    unsigned char* ws = (unsigned char*)d_ws; float* out = (float*)d_out;
    const size_t MiB = 1u << 20; const int Mb = TOK;
    float* w = (float*)(ws + 150 * MiB); size_t off = 0;
    auto take = [&](size_t n) { float* q = w + off; off += n; return q; };
    const size_t slot = (size_t)Mb * 1024;
    NaiveBufs n;
    n.PROJ = take((size_t)Mb * D_IN); n.Qh = take((size_t)Mb * 1536); n.Kh = take((size_t)Mb * 1536); n.Vh = take((size_t)Mb * 1024);
    n.S = take((size_t)Mb * 4096); n.Y = take((size_t)Mb * 512); n.Z = take((size_t)Mb * 512);
    n.G = take((size_t)Mb * 512); n.Z2 = take((size_t)Mb * 512);
    float* scratch = take((size_t)Mb * 5248);
    n.XN = scratch; n.QLN = scratch + (size_t)Mb * 1024; n.CKN = n.QLN + (size_t)Mb * 384; n.QR = n.CKN + (size_t)Mb * 256; n.KVR = n.QR + (size_t)Mb * 1536;
    n.YS = scratch; n.YM = scratch + (size_t)Mb * 1024; n.T = scratch + (size_t)Mb * 2048; n.HN = scratch + (size_t)Mb * 3072; n.DN = scratch + (size_t)Mb * 4096;
    float* res = take(64);
    float* out2 = out + slot; unsigned char* gates = (unsigned char*)(out + 2 * slot); n.ATT = out + 3 * slot; n.MIX = out + 4 * slot; n.H = out + 5 * slot;
    hipMemsetAsync(ws, 0, 1 << 20, stream); hipMemsetAsync(res, 0, 64 * 4, stream);
    hipMemsetAsync(out, 0, (size_t)out_size * 4, stream);
    naive_batch(d_in, 0, out, n, stream);
    Params p = make_params(d_in, out2, ws, 1, 0, false, gates);
    for (int ph = 0; ph < N_PHASES; ++ph) mk_launch_phases(p, ph, ph + 1, false, stream);
    const size_t cnt[16] = {0, (size_t)Mb * 512, (size_t)Mb * 384, (size_t)Mb * 256, (size_t)Mb * 1024, (size_t)Mb * 1024, (size_t)Mb * 1536, (size_t)Mb * 1536, (size_t)Mb * 1024,
                            (size_t)Mb * 1024, (size_t)Mb * 512, (size_t)Mb * 512, (size_t)Mb * 1024, (size_t)Mb * 1024, (size_t)Mb * 4096, (size_t)Mb * 1024};
    for (int id = 1; id <= 15; ++id) k_check<<<1024, 256, 0, stream>>>(id, cnt[id], p, n, out, out2, res);
    k_final<<<1, 1, 0, stream>>>(res, out, 15, MK_FIRST_CHECK);
}
#else
extern "C" void kernel_launch(void* const* d_in, const int* in_sizes, int n_in, void* d_out, int out_size, void* d_ws, size_t ws_size, hipStream_t stream) {
    Params p = make_params(d_in, (float*)d_out, (unsigned char*)d_ws, 8, 0, true, nullptr);
    hipMemsetAsync(d_ws, 0, 65536, stream);
#if MK_MODE == 0
    mk_launch_phases(p, 0, N_PHASES, true, stream);
#else
    for (int ph = 0; ph < N_PHASES; ++ph) mk_launch_phases(p, ph, ph + 1, false, stream);
#endif
}
#endif
```

```cpp
#include <hip/hip_runtime.h>
#include <hip/hip_cooperative_groups.h>
#include <cstdint>
#include <cstdio>
#include <cmath>
#define MK_MODE 0
#define MK_FIRST_CHECK 1
#define LAS __attribute__((address_space(3)))
typedef unsigned short bf16_t;
typedef short bf16x8 __attribute__((ext_vector_type(8)));
typedef short s16x4 __attribute__((ext_vector_type(4)));
typedef float f32x4 __attribute__((ext_vector_type(4)));
typedef float f32x16 __attribute__((ext_vector_type(16)));
typedef unsigned u32x4 __attribute__((ext_vector_type(4)));
typedef unsigned u32x2 __attribute__((ext_vector_type(2)));

constexpr int TOK = 4096;
constexpr float LOG2E = 1.4426950408889634f;
constexpr float QSCALE = 0.07216878364870322f * LOG2E;

struct Params {
    const float* in[26];
    float* out;
    unsigned* ctl;
    float *ssq_q, *ssq_kv, *ssq_kpe, *ssq_h, *inv_x;
    float* sloc;
    float *rcos, *rsin;
    bf16_t* kpe;
    bf16_t *W1t, *Wqt, *Wkvt, *Wglut, *Wost, *Womt, *Woutt, *Wupt, *Wdnt;
    bf16_t *XB, *U, *QL, *CKV, *Q, *K, *V, *ATT, *Z, *Z2, *T1, *HB, *HID, *SGS, *SGM;
    const float* x; const int* pos;
    int NB, ph_lo, ph_hi, pad;
    float inv_freq[32];
};

typedef float f32x2_t __attribute__((ext_vector_type(2))); typedef __bf16 bf16x2_t __attribute__((ext_vector_type(2)));
__device__ __forceinline__ unsigned cvt_pk_bf16(float lo, float hi) { f32x2_t v = {lo, hi}; bf16x2_t b = __builtin_convertvector(v, bf16x2_t); return __builtin_bit_cast(unsigned, b); }
__device__ __forceinline__ u32x4 pack8(const f32x4 a, const f32x4 b) { u32x4 w; w.x = cvt_pk_bf16(a[0], a[1]); w.y = cvt_pk_bf16(a[2], a[3]); w.z = cvt_pk_bf16(b[0], b[1]); w.w = cvt_pk_bf16(b[2], b[3]); return w; }
__device__ __forceinline__ float bf_lo(unsigned w) { return __uint_as_float(w << 16); }
__device__ __forceinline__ float bf_hi(unsigned w) { return __uint_as_float(w & 0xffff0000u); }
__device__ __forceinline__ void unpack8(const u32x4 w, f32x4& a, f32x4& b) { a = (f32x4){bf_lo(w.x), bf_hi(w.x), bf_lo(w.y), bf_hi(w.y)}; b = (f32x4){bf_lo(w.z), bf_hi(w.z), bf_lo(w.w), bf_hi(w.w)}; }
__device__ __forceinline__ float fast_sigmoid(float v) { return __builtin_amdgcn_rcpf(1.f + __builtin_amdgcn_exp2f(-v * LOG2E)); }
__device__ __forceinline__ float fast_tanh(float v) { const float e = __builtin_amdgcn_exp2f(-2.f * LOG2E * fabsf(v)); const float t = (1.f - e) * __builtin_amdgcn_rcpf(1.f + e); return v < 0.f ? -t : t; }
__device__ __forceinline__ float gelu_t(float x) { return 0.5f * x * (1.f + fast_tanh(0.7978845608028654f * (x + 0.044715f * x * x * x))); }
__host__ __device__ __forceinline__ int dperm(int s) { const int wc = s >> 5, fq = (s >> 3) & 3, n = (s >> 2) & 1, j = s & 3; return 32 * n + 16 * wc + 4 * fq + j; }

namespace pg8 {
constexpr int BM = 256, BK = 64, HALF = 128, HTB = HALF * BK * 2, STAGE_BYTES = 8 * HTB, NXCD = 8, WGM = 8;
__host__ __device__ __forceinline__ int lds_byte(int r, int c) { const int st = (r >> 4) * 2 + (c >> 5), rr = r & 15, cc = c & 31, ob = rr * 64 + cc * 2; return st * 1024 + (ob ^ (((ob >> 9) & 1) << 5)); }
__host__ __device__ __forceinline__ void stage_rc(int b, int& R, int& C) { const int st = b / 1024, sb = b % 1024, swz = sb ^ (((sb >> 9) & 1) << 5); R = (st >> 1) * 16 + swz / 64; C = (st & 1) * 32 + (swz % 64) / 2; }
__host__ __device__ __forceinline__ int perm32(int rho) { const int n = rho >> 4, i = rho & 15; return 8 * (i >> 2) + 4 * n + (i & 3); }
struct Unit { int pm, pn; };
struct Gemm { const bf16_t* A; int lda; const bf16_t* Bt; int ldb; int M, N, K; };
struct StaticOrder {
    int nM, nN, nwg, G, c;
    __device__ void init(int M, int N, int G_, int c_) { nM = M / BM; nN = N / BM; nwg = nM * nN; G = G_; c = c_; }
    __device__ bool next(int i, Unit& u) const {
        const long L = (long)i * G + c; if (L >= nwg) return false;
        int wgid = (int)L; { const int q = nwg / NXCD, r = nwg % NXCD, xcd = wgid % NXCD, off = wgid / NXCD; wgid = (xcd < r ? xcd * (q + 1) : r * (q + 1) + (xcd - r) * q) + off; }
        const int nig = WGM * nN, gid = wgid / nig, fm = gid * WGM, gsz = (nM - fm) < WGM ? (nM - fm) : WGM;
        u.pm = fm + ((wgid % nig) % gsz); u.pn = (wgid % nig) / gsz; return true;
    }
};
typedef f32x4 Acc[2][2][4][2];

template <class Epi>
__device__ __forceinline__ void gemm_phase(LAS unsigned char* lds, LAS unsigned char* aux, const Gemm g, const StaticOrder& S, const Epi& E) {
    int tid = threadIdx.x; asm volatile("" : "+v"(tid));
    const int wid = __builtin_amdgcn_readfirstlane(tid >> 6), lane = tid & 63, wr = wid >> 2, wc = wid & 3, fr = lane & 15, fq = lane >> 4;
    const int K = g.K, nt = K / BK;
    unsigned voffA[2], voffB[2];
#pragma unroll
    for (int i = 0; i < 2; ++i) { int R, C; stage_rc(tid * 16 + i * 8192, R, C); const int Rb = (R & ~31) + perm32(R & 31);
        voffA[i] = (unsigned)(R * g.lda + C) * 2u; voffB[i] = (unsigned)(Rb * g.ldb + C) * 2u; }
    const size_t kstep = (size_t)(BK * 2);
    const size_t hstepA = (size_t)HALF * g.lda * 2, hstepB = (size_t)HALF * g.ldb * 2;
    const size_t tstepA = 2 * hstepA, tstepB = 2 * hstepB;
    const unsigned ldsw = (unsigned)wid * 1024u;
    const int aoff = lds_byte(wr * 64 + fr, fq * 8), boff = lds_byte(wc * 32 + fr, fq * 8);
#define PG8_SA(b, h) (((b) * 2 + (h)) * HTB)
#define PG8_SB(b, h) ((4 + (b) * 2 + (h)) * HTB)
#define PG8_STAGE(bufoff, gbase, voff) do { _Pragma("unroll") for (int _i = 0; _i < 2; ++_i) \
        __builtin_amdgcn_global_load_lds((const unsigned*)((const char*)(gbase) + (voff)[_i]), (LAS unsigned*)(lds + (bufoff) + ldsw + _i * 8192), 16, 0, 0); } while (0)
#define PG8_LDA(dst, b, h) do { _Pragma("unroll") for (int m = 0; m < 4; ++m) _Pragma("unroll") for (int k = 0; k < 2; ++k) dst[m][k] = *(const LAS bf16x8*)(lds + PG8_SA(b, h) + aoff + m * 2048 + k * 1024); } while (0)
#define PG8_LDB(dst, b, h) do { _Pragma("unroll") for (int n = 0; n < 2; ++n) _Pragma("unroll") for (int k = 0; k < 2; ++k) dst[n][k] = *(const LAS bf16x8*)(lds + PG8_SB(b, h) + boff + n * 2048 + k * 1024); } while (0)
#define PG8_MMA(ai, bj, At, Bt) do { __builtin_amdgcn_s_setprio(1); _Pragma("unroll") for (int m = 0; m < 4; ++m) _Pragma("unroll") for (int n = 0; n < 2; ++n) _Pragma("unroll") for (int k = 0; k < 2; ++k) \
        acc[ai][bj][m][n] = __builtin_amdgcn_mfma_f32_16x16x32_bf16(Bt[n][k], At[m][k], acc[ai][bj][m][n], 0, 0, 0); __builtin_amdgcn_s_setprio(0); } while (0)
#define PG8_WAIT_V(n) asm volatile("s_waitcnt vmcnt(" #n ")" ::: "memory")
#define PG8_WAIT_L(n) asm volatile("s_waitcnt lgkmcnt(" #n ")" ::: "memory")
#define PG8_BAR __builtin_amdgcn_s_barrier()
#define PG8_SCHED __builtin_amdgcn_sched_barrier(0)
    Unit cur, nxt; int ui = 0;
    if (!S.next(0, cur)) return;
    Acc acc;
#pragma unroll
    for (int a = 0; a < 2; ++a)
#pragma unroll
        for (int b = 0; b < 2; ++b)
#pragma unroll
            for (int m = 0; m < 4; ++m)
#pragma unroll
                for (int n = 0; n < 2; ++n) acc[a][b][m][n] = (f32x4){0.f, 0.f, 0.f, 0.f};
    bf16x8 At[4][2], B0[2][2], B1[2][2];
    const char* cA = (const char*)g.A + (size_t)cur.pm * tstepA; const char* cB = (const char*)g.Bt + (size_t)cur.pn * tstepB;
    PG8_STAGE(PG8_SB(0, 0), cB, voffB); PG8_STAGE(PG8_SB(0, 1), cB + hstepB, voffB); PG8_STAGE(PG8_SA(0, 0), cA, voffA); PG8_STAGE(PG8_SA(0, 1), cA + hstepA, voffA);
    if (wr == 1) PG8_BAR;
    PG8_WAIT_V(2); PG8_BAR;
    PG8_STAGE(PG8_SB(1, 0), cB + kstep, voffB); PG8_STAGE(PG8_SA(1, 0), cA + kstep, voffA); PG8_STAGE(PG8_SB(1, 1), cB + hstepB + kstep, voffB);
    PG8_WAIT_V(6); PG8_BAR;
    for (;;) {
        const bool has_next = S.next(ui + 1, nxt);
        const char* nA = has_next ? (const char*)g.A + (size_t)nxt.pm * tstepA : cA; const char* nB = has_next ? (const char*)g.Bt + (size_t)nxt.pn * tstepB : cB;
#pragma unroll 1
        for (int t = 0; t < nt; t += 2) {
            const bool last = (t == nt - 2);
            const char* a1 = cA + (size_t)(t + 1) * kstep;
            const char* a2 = last ? nA : cA + (size_t)(t + 2) * kstep; const char* b2 = last ? nB : cB + (size_t)(t + 2) * kstep;
            const char* a3 = a2 + kstep; const char* b3 = b2 + kstep;
            PG8_LDB(B0, 0, 0); PG8_LDB(B1, 0, 1); PG8_SCHED; PG8_LDA(At, 0, 0); PG8_STAGE(PG8_SA(1, 1), a1 + hstepA, voffA);
            PG8_WAIT_V(8); PG8_WAIT_L(0); PG8_BAR; PG8_MMA(0, 0, At, B0); PG8_MMA(0, 1, At, B1); PG8_BAR; PG8_SCHED;
            PG8_LDA(At, 0, 1); PG8_STAGE(PG8_SB(0, 0), b2, voffB); PG8_STAGE(PG8_SB(0, 1), b2 + hstepB, voffB); PG8_STAGE(PG8_SA(0, 0), a2, voffA);
            PG8_WAIT_V(8); PG8_WAIT_L(0); PG8_BAR; PG8_MMA(1, 0, At, B0); PG8_MMA(1, 1, At, B1); PG8_BAR; PG8_SCHED;
            PG8_LDB(B0, 1, 0); PG8_LDB(B1, 1, 1); PG8_SCHED; PG8_LDA(At, 1, 0); PG8_STAGE(PG8_SA(0, 1), a2 + hstepA, voffA);
            PG8_WAIT_V(8); PG8_WAIT_L(0); PG8_BAR; PG8_MMA(0, 0, At, B0); PG8_MMA(0, 1, At, B1); PG8_BAR; PG8_SCHED;
            PG8_LDA(At, 1, 1); PG8_STAGE(PG8_SB(1, 0), b3, voffB); PG8_STAGE(PG8_SB(1, 1), b3 + hstepB, voffB); PG8_STAGE(PG8_SA(1, 0), a3, voffA);
            PG8_WAIT_V(8); PG8_WAIT_L(0); PG8_BAR; PG8_MMA(1, 0, At, B0); PG8_MMA(1, 1, At, B1); PG8_BAR; PG8_SCHED;
        }
        if (wr == 0) PG8_BAR;
        E(acc, cur, wr, wc, fr, fq, aux, wid, lane);
        if (!has_next) break;
#pragma unroll
        for (int a = 0; a < 2; ++a)
#pragma unroll
            for (int b = 0; b < 2; ++b)
#pragma unroll
                for (int m = 0; m < 4; ++m)
#pragma unroll
                    for (int n = 0; n < 2; ++n) acc[a][b][m][n] = (f32x4){0.f, 0.f, 0.f, 0.f};
        cur = nxt; cA = nA; cB = nB; ++ui;
        if (wr == 1) PG8_BAR;
    }
    PG8_WAIT_V(0);
    PG8_BAR;
#undef PG8_SA
#undef PG8_SB
#undef PG8_STAGE
#undef PG8_LDA
#undef PG8_LDB
#undef PG8_MMA
#undef PG8_SCHED
}
}
using pg8::Acc; using pg8::Unit;

#define EPI_ARGS const Acc& acc, const Unit& u, int wr, int wc, int fr_, int fq_, LAS unsigned char* aux, int wid, int lane
#define EPI_OPAQUE int fr = fr_, fq = fq_; asm volatile("" : "+v"(fr), "+v"(fq));
#define ROWLOOP for (int ai = 0; ai < 2; ++ai) _Pragma("unroll") for (int m = 0; m < 4; ++m)

__device__ __forceinline__ float fq_sum(float s) { s += __shfl_xor(s, 16); s += __shfl_xor(s, 32); return s; }
__device__ __forceinline__ float sq4(const f32x4 v) { return (v[0] * v[0] + v[1] * v[1]) + (v[2] * v[2] + v[3] * v[3]); }

struct EpiG1 {
    const float* inv_x; bf16_t *U, *QL, *CKV, *KPE, *SGS, *SGM; float *ssq_q, *ssq_kv, *ssq_kpe; const float *rcos, *rsin; const float* k_norm; int dry;
    __device__ __forceinline__ void operator()(EPI_ARGS) const {
        EPI_OPAQUE
        const int pn = u.pn, cw = wc * 32 + 8 * fq;
#pragma unroll
        ROWLOOP {
            const int row = u.pm * 256 + ai * 128 + wr * 64 + m * 16 + fr; const float s = inv_x[row];
            f32x4 v[2][2];
#pragma unroll
            for (int bj = 0; bj < 2; ++bj)
#pragma unroll
                for (int n = 0; n < 2; ++n) v[bj][n] = acc[ai][bj][m][n] * s;
            if (pn < 2) {
#pragma unroll
                for (int bj = 0; bj < 2; ++bj) *(u32x4*)(U + (size_t)row * 512 + pn * 256 + bj * 128 + cw) = pack8(v[bj][0], v[bj][1]);
            } else if (pn == 2) {
#pragma unroll
                for (int bj = 0; bj < 2; ++bj) *(u32x4*)(QL + (size_t)row * 384 + bj * 128 + cw) = pack8(v[bj][0], v[bj][1]);
                const float q = fq_sum(sq4(v[0][0]) + sq4(v[0][1]) + sq4(v[1][0]) + sq4(v[1][1]));
                if (fq == 0 && !dry) atomicAdd(ssq_q + row, q);
            } else if (pn == 3) {
                *(u32x4*)(QL + (size_t)row * 384 + 256 + cw) = pack8(v[0][0], v[0][1]);
                *(u32x4*)(CKV + (size_t)row * 256 + cw) = pack8(v[1][0], v[1][1]);
                const float q = fq_sum(sq4(v[0][0]) + sq4(v[0][1])), k = fq_sum(sq4(v[1][0]) + sq4(v[1][1]));
                if (fq == 0 && !dry) { atomicAdd(ssq_q + row, q); atomicAdd(ssq_kv + row, k); }
            } else if (pn == 4) {
                *(u32x4*)(CKV + (size_t)row * 256 + 128 + cw) = pack8(v[0][0], v[0][1]);
                const float k = fq_sum(sq4(v[0][0]) + sq4(v[0][1]));
                if (fq == 0 && !dry) atomicAdd(ssq_kv + row, k);
                if (wc < 2) {
                    const int i0 = 16 * wc + 4 * fq;
                    const f32x4 c = *(const f32x4*)(rcos + (size_t)row * 32 + i0), sn = *(const f32x4*)(rsin + (size_t)row * 32 + i0);
                    const f32x4 g1 = *(const f32x4*)(k_norm + 128 + i0), g2 = *(const f32x4*)(k_norm + 160 + i0);
                    const f32x4 x1 = v[1][0] * g1, x2 = v[1][1] * g2;
                    const f32x4 r1 = x1 * c - x2 * sn, r2 = x2 * c + x1 * sn;
                    *(u32x4*)(KPE + (size_t)row * 64 + cw) = pack8(r1, r2);
                    const float p = fq_sum(sq4(v[1][0]) + sq4(v[1][1]));
                    if (fq == 0 && !dry) atomicAdd(ssq_kpe + row, p);
                }
            } else {
                bf16_t* G = (pn < 9) ? SGS : SGM; const int c0 = ((pn < 9) ? (pn - 5) : (pn - 9)) * 256;
#pragma unroll
                for (int bj = 0; bj < 2; ++bj) { f32x4 a, b;
#pragma unroll
                    for (int j = 0; j < 4; ++j) { a[j] = fast_sigmoid(v[bj][0][j]); b[j] = fast_sigmoid(v[bj][1][j]); }
                    *(u32x4*)(G + (size_t)row * 1024 + c0 + bj * 128 + cw) = pack8(a, b); }
            }
        }
    }
};

__device__ __forceinline__ void row_reduce4(const float (&part)[2][4], float (&tot)[2][4], int wr, int wc, int fr, int fq, LAS unsigned char* aux) {
    LAS float* red = (LAS float*)aux;
#pragma unroll
    ROWLOOP { const float s = fq_sum(part[ai][m]); if (fq == 0) red[(ai * 128 + wr * 64 + m * 16 + fr) * 4 + wc] = s; }
    asm volatile("s_waitcnt lgkmcnt(0)" ::: "memory"); __builtin_amdgcn_s_barrier(); asm volatile("" ::: "memory");
#pragma unroll
    ROWLOOP { const f32x4 t = *(const LAS f32x4*)(red + (ai * 128 + wr * 64 + m * 16 + fr) * 4); tot[ai][m] = (t[0] + t[1]) + (t[2] + t[3]); }
    asm volatile("s_waitcnt lgkmcnt(0)" ::: "memory"); __builtin_amdgcn_s_barrier(); asm volatile("" ::: "memory");
}

struct EpiQ {
    const float* ssq_q; const float *rcos, *rsin; const float* q_norm; bf16_t* Q;
    __device__ __forceinline__ void operator()(EPI_ARGS) const {
        EPI_OPAQUE
        const int h = u.pn, cw = wc * 32 + 8 * fq;
        float part[2][4], tot[2][4], rs[2][4];
#pragma unroll
        ROWLOOP { const int row = u.pm * 256 + ai * 128 + wr * 64 + m * 16 + fr; const float s = __builtin_amdgcn_rsqf(ssq_q[row] * (1.f / 384.f) + 1e-6f); rs[ai][m] = s;
            part[ai][m] = (sq4(acc[ai][0][m][0]) + sq4(acc[ai][0][m][1]) + sq4(acc[ai][1][m][0]) + sq4(acc[ai][1][m][1])) * s * s; }
        row_reduce4(part, tot, wr, wc, fr, fq, aux);
        const f32x4 g0 = *(const f32x4*)(q_norm + cw), g1 = *(const f32x4*)(q_norm + cw + 4);
        const int i0 = 16 * (wc & 1) + 4 * fq;
        const f32x4 gr1 = *(const f32x4*)(q_norm + 128 + i0), gr2 = *(const f32x4*)(q_norm + 160 + i0);
#pragma unroll
        ROWLOOP { const int row = u.pm * 256 + ai * 128 + wr * 64 + m * 16 + fr;
            const float f = rs[ai][m] * __builtin_amdgcn_rsqf(tot[ai][m] * (1.f / 192.f) + 1e-6f) * QSCALE;
            const int b = row / TOK, l = row % TOK; bf16_t* qrow = Q + ((size_t)(b * 8 + h) * TOK + l) * 192;
            *(u32x4*)(qrow + cw) = pack8(acc[ai][0][m][0] * f * g0, acc[ai][0][m][1] * f * g1);
            if (wc < 2) {
                const f32x4 c = *(const f32x4*)(rcos + (size_t)row * 32 + i0), sn = *(const f32x4*)(rsin + (size_t)row * 32 + i0);
                const f32x4 x1 = acc[ai][1][m][0] * f * gr1, x2 = acc[ai][1][m][1] * f * gr2;
                *(u32x4*)(qrow + 128 + cw) = pack8(x1 * c - x2 * sn, x2 * c + x1 * sn);
            }
            asm volatile("" ::: "memory");
        }
    }
};

struct EpiKV {
    const float *ssq_kv, *ssq_kpe; const float* k_norm; const bf16_t* KPE; bf16_t *K, *V;
    __device__ __forceinline__ void operator()(EPI_ARGS) const {
        EPI_OPAQUE
        const int h = u.pn, cw = wc * 32 + 8 * fq;
        float part[2][4], tot[2][4], rs[2][4];
#pragma unroll
        ROWLOOP { const int row = u.pm * 256 + ai * 128 + wr * 64 + m * 16 + fr; const float s = __builtin_amdgcn_rsqf(ssq_kv[row] * (1.f / 256.f) + 1e-6f); rs[ai][m] = s;
            part[ai][m] = (sq4(acc[ai][0][m][0]) + sq4(acc[ai][0][m][1])) * s * s; }
        row_reduce4(part, tot, wr, wc, fr, fq, aux);
        const f32x4 g0 = *(const f32x4*)(k_norm + cw), g1 = *(const f32x4*)(k_norm + cw + 4);
#pragma unroll
        ROWLOOP { const int row = u.pm * 256 + ai * 128 + wr * 64 + m * 16 + fr;
            const float ik = __builtin_amdgcn_rsqf((tot[ai][m] + ssq_kpe[row]) * (1.f / 192.f) + 1e-6f), f = rs[ai][m] * ik;
            const int b = row / TOK, l = row % TOK; const size_t tl = (size_t)(b * 8 + h) * 64 + (l >> 6); const int kv = l & 63;
            bf16_t* kt = K + tl * 12288 + kv * 8;
            *(u32x4*)(kt + (4 * wc + fq) * 512) = pack8(acc[ai][0][m][0] * f * g0, acc[ai][0][m][1] * f * g1);
            if (wc < 2) { const u32x4 w = *(const u32x4*)(KPE + (size_t)row * 64 + cw); f32x4 a, c; unpack8(w, a, c);
                *(u32x4*)(kt + (16 + 4 * wc + fq) * 512) = pack8(a * ik, c * ik); }
            *(u32x4*)(V + tl * 8192 + wc * 2048 + kv * 32 + fq * 8) = pack8(acc[ai][1][m][0] * rs[ai][m], acc[ai][1][m][1] * rs[ai][m]);
            asm volatile("" ::: "memory");
        }
    }
};

struct EpiGlu {
    const bf16_t* Z; const float* bias; bf16_t* Z2;
    __device__ __forceinline__ void operator()(EPI_ARGS) const {
        EPI_OPAQUE
#pragma unroll
        for (int bj = 0; bj < 2; ++bj) { const int col = u.pn * 256 + bj * 128 + wc * 32 + 8 * fq;
            const f32x4 b0 = *(const f32x4*)(bias + col), b1 = *(const f32x4*)(bias + col + 4);
#pragma unroll
            ROWLOOP { const int row = u.pm * 256 + ai * 128 + wr * 64 + m * 16 + fr;
                f32x4 z0, z1; unpack8(*(const u32x4*)(Z + (size_t)row * 512 + col), z0, z1);
                f32x4 o0, o1;
#pragma unroll
                for (int j = 0; j < 4; ++j) { o0[j] = z0[j] * fast_sigmoid(acc[ai][bj][m][0][j] + b0[j]); o1[j] = z1[j] * fast_sigmoid(acc[ai][bj][m][1][j] + b1[j]); }
                *(u32x4*)(Z2 + (size_t)row * 512 + col) = pack8(o0, o1); }
        }
    }
};
template <bool SECOND> struct EpiMix {
    const bf16_t* SG; bf16_t* T1;
    __device__ __forceinline__ void operator()(EPI_ARGS) const {
        EPI_OPAQUE
#pragma unroll
        for (int bj = 0; bj < 2; ++bj) { const int col = u.pn * 256 + bj * 128 + wc * 32 + 8 * fq;
#pragma unroll
            ROWLOOP { const size_t o = (size_t)(u.pm * 256 + ai * 128 + wr * 64 + m * 16 + fr) * 1024 + col;
                f32x4 s0, s1; unpack8(*(const u32x4*)(SG + o), s0, s1);
                f32x4 r0 = s0 * acc[ai][bj][m][0], r1 = s1 * acc[ai][bj][m][1];
                if (SECOND) { f32x4 t0, t1; unpack8(*(const u32x4*)(T1 + o), t0, t1); r0 += t0; r1 += t1; }
                *(u32x4*)(T1 + o) = pack8(r0, r1); }
        }
    }
};
struct EpiOut {
    const float* x; float* out; bf16_t* HB; float* ssq_h; int dry;
    __device__ __forceinline__ void operator()(EPI_ARGS) const {
        EPI_OPAQUE
#pragma unroll
        ROWLOOP { const int row = u.pm * 256 + ai * 128 + wr * 64 + m * 16 + fr; float q = 0.f;
#pragma unroll
            for (int bj = 0; bj < 2; ++bj) { const size_t o = (size_t)row * 1024 + u.pn * 256 + bj * 128 + wc * 32 + 8 * fq;
                const f32x4 h0 = *(const f32x4*)(x + o) + acc[ai][bj][m][0], h1 = *(const f32x4*)(x + o + 4) + acc[ai][bj][m][1];
                *(u32x4*)(HB + o) = pack8(h0, h1); q += sq4(h0) + sq4(h1); }
            q = fq_sum(q); if (fq == 0 && !dry) atomicAdd(ssq_h + row, q); }
    }
};
struct EpiUp {
    const float* ssq_h; bf16_t* HID;
    __device__ __forceinline__ void operator()(EPI_ARGS) const {
        EPI_OPAQUE
#pragma unroll
        ROWLOOP { const int row = u.pm * 256 + ai * 128 + wr * 64 + m * 16 + fr; const float s = __builtin_amdgcn_rsqf(ssq_h[row] * (1.f / 1024.f) + 1e-6f);
#pragma unroll
            for (int bj = 0; bj < 2; ++bj) { f32x4 a, b;
#pragma unroll
                for (int j = 0; j < 4; ++j) { const float p = fmaxf(acc[ai][bj][m][0][j] * s, 0.f), q = fmaxf(acc[ai][bj][m][1][j] * s, 0.f); a[j] = p * p; b[j] = q * q; }
                *(u32x4*)(HID + (size_t)row * 4096 + u.pn * 256 + bj * 128 + wc * 32 + 8 * fq) = pack8(a, b); } }
    }
};
struct EpiDown {
    const bf16_t* HB; float* out; float sc;
    __device__ __forceinline__ void operator()(EPI_ARGS) const {
        EPI_OPAQUE
#pragma unroll
        ROWLOOP { const int row = u.pm * 256 + ai * 128 + wr * 64 + m * 16 + fr;
#pragma unroll
            for (int bj = 0; bj < 2; ++bj) { const size_t o = (size_t)row * 1024 + u.pn * 256 + bj * 128 + wc * 32 + 8 * fq;
                f32x4 h0, h1; unpack8(*(const u32x4*)(HB + o), h0, h1);
                *(f32x4*)(out + o) = h0 + acc[ai][bj][m][0] * sc; *(f32x4*)(out + o + 4) = h1 + acc[ai][bj][m][1] * sc; } }
    }
};
#define XB_TMO      128
#define XB_XCNT(j)  (256  + 64 * (j))
#define XB_XSUB(j)  (1280 + 64 * (j))
#define XB_XGEN(j)  (2304 + 64 * (j))
#define XB_TOP      3328
#define XB_TOPGEN   3392
#define XCD_BAR_WORDS 3456
#define XB_SPIN_CAP (1u << 18)
__device__ __forceinline__ unsigned xb_ld(unsigned* p)              { return __hip_atomic_load(p, __ATOMIC_RELAXED, __HIP_MEMORY_SCOPE_AGENT); }
__device__ __forceinline__ unsigned xb_add(unsigned* p, unsigned v) { return __hip_atomic_fetch_add(p, v, __ATOMIC_RELAXED, __HIP_MEMORY_SCOPE_AGENT); }
__device__ __forceinline__ unsigned xb_xcc_id() { return (unsigned)__builtin_amdgcn_s_getreg((3 << 11) | 20) & 0xFu; }
#define XB_SPIN(cond, bar) do { unsigned _sp = 0; while (cond) { __builtin_amdgcn_s_sleep(1); \
    if ((++_sp & 255u) == 0u) { if (xb_ld(&(bar)[XB_TMO])) break; if (_sp > XB_SPIN_CAP) { atomicAdd(&(bar)[XB_TMO], 1u); break; } } } } while (0)
struct XcdBarrier { unsigned* bar; unsigned x; volatile LAS unsigned* st; };
__device__ __forceinline__ XcdBarrier xcd_barrier_post(unsigned* bar, volatile LAS unsigned* st) {
    XcdBarrier b; b.bar = bar; b.x = xb_xcc_id(); b.st = st;
    if (threadIdx.x == 0) (void)xb_add(&bar[XB_XCNT(b.x)], 1u);
    return b;
}
__device__ __forceinline__ void xcd_barrier_complete(unsigned* bar, unsigned x, unsigned& nloc, unsigned& nx) {
    const unsigned G = gridDim.x * gridDim.y * gridDim.z;
    unsigned sum, cnt, mine, sp = 0u;
    for (;;) {
        sum = 0u; cnt = 0u; mine = 0u;
#pragma unroll
        for (unsigned j = 0; j < 16; ++j) { const unsigned c = xb_ld(&bar[XB_XCNT(j)]); sum += c; cnt += (c > 0u) ? 1u : 0u; mine = (j == x) ? c : mine; }
        if (sum == G) break;
        __builtin_amdgcn_s_sleep(1);
        if ((++sp & 255u) == 0u) { if (xb_ld(&bar[XB_TMO])) break; if (sp > XB_SPIN_CAP) { atomicAdd(&bar[XB_TMO], 1u); break; } }
    }
    nloc = mine > 0u ? mine : 1u; nx = cnt > 0u ? cnt : 1u;
}
__device__ __forceinline__ void xcd_barrier(const XcdBarrier& b) {
    asm volatile("s_waitcnt vmcnt(0)" ::: "memory");
    __syncthreads();
    if (threadIdx.x == 0) {
        unsigned* bar = b.bar;
        __builtin_amdgcn_s_waitcnt(0);
        unsigned nloc = b.st[0], nx = b.st[1];
        if (nloc == 0u) { xcd_barrier_complete(bar, b.x, nloc, nx); b.st[0] = nloc; b.st[1] = nx; }
        const unsigned old = xb_add(&bar[XB_XSUB(b.x)], 1u);
        const unsigned gen = old / nloc;
        if (old + 1u == (gen + 1u) * nloc) {
            __builtin_amdgcn_fence(__ATOMIC_RELEASE, "agent");
            asm volatile("s_waitcnt vmcnt(0)" ::: "memory");
            const unsigned og = xb_add(&bar[XB_TOP], 1u);
            const unsigned tg = og / nx;
            if (og + 1u == (tg + 1u) * nx) xb_add(&bar[XB_TOPGEN], 1u);
            else XB_SPIN(xb_ld(&bar[XB_TOPGEN]) == tg, bar);
            __builtin_amdgcn_fence(__ATOMIC_ACQUIRE, "agent");
            xb_add(&bar[XB_XGEN(b.x)], 1u);
            asm volatile("s_waitcnt vmcnt(0)" ::: "memory");
        } else {
            XB_SPIN(xb_ld(&bar[XB_XGEN(b.x)]) == gen, bar);
            __builtin_amdgcn_fence(__ATOMIC_ACQUIRE, "agent");
            asm volatile("s_waitcnt vmcnt(0)" ::: "memory");
        }
    }
    __syncthreads();
}

__device__ __forceinline__ void ctr_barrier(unsigned* ctr, unsigned* tmo, unsigned& epoch) {
    __threadfence();
    __syncthreads();
    ++epoch;
    if (threadIdx.x == 0) {
        const unsigned target = epoch * gridDim.x;
        xb_add(ctr, 1u);
        unsigned sp = 0;
        while (xb_ld(ctr) < target) { __builtin_amdgcn_s_sleep(1); if ((++sp & 1023u) == 0u) { if (sp > (1u << 22)) { atomicAdd(tmo, 1u); break; } } }
    }
    __syncthreads();
    __threadfence();
}
namespace att {
constexpr int KSLOT = 24576, VSLOT = 16384, NSLOT = 3;
constexpr int LDS_K = 0, LDS_V = NSLOT * KSLOT, LDS_WS = LDS_V + NSLOT * VSLOT, LDS_END = LDS_WS + 8 * 256;
__device__ __forceinline__ int crow(int r, int hi) { return (r & 3) + 8 * (r >> 2) + 4 * hi; }
__device__ __forceinline__ s16x4 vtr(const LAS unsigned char* p) { typedef short v4i16_t __attribute__((ext_vector_type(4))); return __builtin_bit_cast(s16x4, __builtin_amdgcn_ds_read_tr16_b64_v4i16((LAS v4i16_t*)p)); }
#define ATT_WAIT_V(n) asm volatile("s_waitcnt vmcnt(" #n ")" ::: "memory")

__device__ __forceinline__ void attn_unit(int bh, int qb, const bf16_t* Qg, const bf16_t* Kg, const bf16_t* Vg, bf16_t* Og, LAS unsigned char* lds, float* tprobe) {
    int tid = threadIdx.x; asm volatile("" : "+v"(tid));
    const int lane = tid & 63, r32 = lane & 31, hi = lane >> 5; const int wid = __builtin_amdgcn_readfirstlane(tid >> 6);
    const int b = bh >> 3, h = bh & 7;
    const int NT = 4 * (qb + 1);
    const char* kbase = (const char*)Kg + (size_t)bh * 64 * KSLOT + lane * 16;
    const char* vbase = (const char*)Vg + (size_t)bh * 64 * VSLOT + lane * 16;
    LAS float* wsf = (LAS float*)(lds + LDS_WS) + wid * 64;
#define ATT_ISSUE_K(t, slot) do { _Pragma("unroll") for (int _p = 0; _p < 3; ++_p) __builtin_amdgcn_global_load_lds((const unsigned*)(kbase + (size_t)(t) * KSLOT + (wid + 8 * _p) * 1024), (LAS unsigned*)(lds + LDS_K + (slot) * KSLOT + (wid + 8 * _p) * 1024), 16, 0, 0); } while (0)
#define ATT_ISSUE_V(t, slot) do { _Pragma("unroll") for (int _p = 0; _p < 2; ++_p) __builtin_amdgcn_global_load_lds((const unsigned*)(vbase + (size_t)(t) * VSLOT + (wid + 8 * _p) * 1024), (LAS unsigned*)(lds + LDS_V + (slot) * VSLOT + (wid + 8 * _p) * 1024), 16, 0, 0); } while (0)
    const bf16_t* qrow = Qg + ((size_t)bh * TOK + qb * 256 + wid * 32 + r32) * 192 + hi * 8;
    bf16x8 qf[12];
#pragma unroll
    for (int d0 = 0; d0 < 12; ++d0) qf[d0] = *(const bf16x8*)(qrow + d0 * 16);
    ATT_ISSUE_K(0, 0); ATT_ISSUE_V(0, 0); ATT_ISSUE_K(1, 1);
    float mrow = -1e30f, lsum = 0.f, alpha = 1.f;
    f32x16 o[4];
#pragma unroll
    for (int d = 0; d < 4; ++d) o[d] = (f32x16){0.f, 0.f, 0.f, 0.f, 0.f, 0.f, 0.f, 0.f, 0.f, 0.f, 0.f, 0.f, 0.f, 0.f, 0.f, 0.f};
    const int qrel = wid * 32 + r32;
    u32x4 pw[2] = {(u32x4){0u, 0u, 0u, 0u}, (u32x4){0u, 0u, 0u, 0u}};
    f32x16 pA = o[0], pB = o[0];
    bool need = false;
    const LAS unsigned char* vp0 = lds + LDS_V + ((lane >> 4) & 1) * 32 + (lane & 3) * 8 + (4 * hi + ((lane & 15) >> 2)) * 64;
#define SBAR() __builtin_amdgcn_sched_barrier(0)
#define XBAR() __builtin_amdgcn_sched_barrier(0x406)
#define ATT_LDK(buf, g) do { _Pragma("unroll") for (int _i = 0; _i < 4; ++_i) kf[buf][_i] = *(const LAS bf16x8*)(kp + (4 * (g) + _i) * 2048); } while (0)
#define ATT_QK(P, ks, hh) do { const LAS unsigned char* kp = lds + LDS_K + (ks) * KSLOT + hi * 1024 + r32 * 16 + (hh) * 512; bf16x8 kf[2][4]; \
        P = (f32x16){0.f, 0.f, 0.f, 0.f, 0.f, 0.f, 0.f, 0.f, 0.f, 0.f, 0.f, 0.f, 0.f, 0.f, 0.f, 0.f}; \
        ATT_LDK(0, 0); \
        _Pragma("unroll") for (int g = 0; g < 3; ++g) { \
            if (g < 2) ATT_LDK((g + 1) & 1, g + 1); \
            XBAR(); \
            _Pragma("unroll") for (int _i = 0; _i < 4; ++_i) P = __builtin_amdgcn_mfma_f32_32x32x16_bf16(kf[g & 1][_i], qf[4 * g + _i], P, 0, 0, 0); \
            XBAR(); } } while (0)
#define ATT_START(P, jbs) do { \
        if ((jbs) >= 0) { const int kb = 32 * (jbs) + 4 * hi; \
            _Pragma("unroll") for (int r = 0; r < 16; ++r) { const int kv = kb + (r & 3) + 8 * (r >> 2); if (kv > qrel) P[r] = -INFINITY; } } \
        float rm = fmaxf(P[0], P[1]); \
        _Pragma("unroll") for (int r = 2; r < 16; ++r) rm = fmaxf(rm, P[r]); \
        { auto rr = __builtin_amdgcn_permlane32_swap(__float_as_uint(rm), __float_as_uint(rm), false, false); rm = fmaxf(__uint_as_float(rr[0]), __uint_as_float(rr[1])); } \
        const float mnew = fmaxf(mrow, rm); need = __any(mnew > mrow); alpha = __builtin_amdgcn_exp2f(mrow - mnew); mrow = mnew; \
        _Pragma("unroll") for (int r = 0; r < 16; ++r) P[r] -= mnew; } while (0)
#define ATT_RESC() do { if (need) { lsum *= alpha; if (hi == 0) wsf[r32] = alpha; asm volatile("s_waitcnt lgkmcnt(0)" ::: "memory"); \
            _Pragma("unroll") for (int r = 0; r < 16; ++r) { const float a_ = wsf[crow(r, hi)]; _Pragma("unroll") for (int d = 0; d < 4; ++d) o[d][r] *= a_; } need = false; } } while (0)
#define ATT_FIN(P) do { float ps = 0.f; \
        _Pragma("unroll") for (int r = 0; r < 16; ++r) { P[r] = __builtin_amdgcn_exp2f(P[r]); ps += P[r]; } \
        lsum += ps; \
        _Pragma("unroll") for (int k = 0; k < 2; ++k) \
            pw[k] = (u32x4){cvt_pk_bf16(P[8 * k], P[8 * k + 1]), cvt_pk_bf16(P[8 * k + 2], P[8 * k + 3]), cvt_pk_bf16(P[8 * k + 4], P[8 * k + 5]), cvt_pk_bf16(P[8 * k + 6], P[8 * k + 7])}; } while (0)
#define ATT_LDV(buf, d, hh) do { _Pragma("unroll") for (int ks = 0; ks < 2; ++ks) { vlo[buf][ks] = vtr(vp + (d) * 4096 + (2 * (hh) + ks) * 1024); vhi[buf][ks] = vtr(vp + (d) * 4096 + (2 * (hh) + ks) * 1024 + 512); } } while (0)
#define ATT_PV(vslot, hh) do { const LAS unsigned char* vp = vp0 + (vslot) * VSLOT; s16x4 vlo[2][2], vhi[2][2]; \
        ATT_LDV(0, 0, hh); \
        _Pragma("unroll") for (int d = 0; d < 4; ++d) { \
            if (d < 3) ATT_LDV((d + 1) & 1, d + 1, hh); \
            XBAR(); \
            _Pragma("unroll") for (int ks = 0; ks < 2; ++ks) { const s16x4 lo = vlo[d & 1][ks], hv = vhi[d & 1][ks]; \
                const bf16x8 vf = (bf16x8){lo[0], lo[1], lo[2], lo[3], hv[0], hv[1], hv[2], hv[3]}; \
                o[d] = __builtin_amdgcn_mfma_f32_32x32x16_bf16(__builtin_bit_cast(bf16x8, pw[ks]), vf, o[d], 0, 0, 0); } \
            XBAR(); } } while (0)
    int s0 = 0, sm1 = 2;
#define ATT_STEP(t, hh, PC, PP, pvs, MASKED) do { \
        const int jbs = (MASKED) ? (2 * (t) + (hh) - 2 * (NT - 4)) : -1; \
        SBAR(); ATT_QK(PC, s0, hh); ATT_FIN(PP); SBAR(); \
        ATT_PV(pvs, 1 - (hh)); ATT_START(PC, jbs); SBAR(); \
        ATT_RESC(); } while (0)
#define ATT_SYNC(t) do { \
        if ((t) + 1 < NT) ATT_WAIT_V(3); else ATT_WAIT_V(0); \
        __builtin_amdgcn_s_barrier(); asm volatile("" ::: "memory"); \
        if ((t) + 1 < NT) ATT_ISSUE_V((t) + 1, (s0 == 2) ? 0 : s0 + 1); \
        if ((t) + 2 < NT) ATT_ISSUE_K((t) + 2, sm1); } while (0)
#define ATT_ROT() do { sm1 = s0; s0 = (s0 == 2) ? 0 : s0 + 1; } while (0)
    ATT_SYNC(0);
    { const int jb0 = (NT == 4) ? 0 : -1;
      ATT_QK(pA, s0, 0); ATT_START(pA, jb0); ATT_RESC();
      if (NT == 4) ATT_STEP(0, 1, pB, pA, s0, true); else ATT_STEP(0, 1, pB, pA, s0, false); }
    ATT_ROT();
    int t = 1;
    for (; t < NT - 4; ++t) {
        ATT_SYNC(t);
        ATT_STEP(t, 0, pA, pB, sm1, false);
        ATT_STEP(t, 1, pB, pA, s0, false);
        ATT_ROT();
    }
    for (; t < NT; ++t) {
        ATT_SYNC(t);
        ATT_STEP(t, 0, pA, pB, sm1, true);
        ATT_STEP(t, 1, pB, pA, s0, true);
        ATT_ROT();
    }
    ATT_SYNC(NT);
    ATT_FIN(pB); ATT_PV(sm1, 1);
#undef ATT_SYNC
#undef ATT_ROT
#undef ATT_STEP
#undef ATT_QK
#undef ATT_START
#undef ATT_RESC
#undef ATT_FIN
    { auto rr = __builtin_amdgcn_permlane32_swap(__float_as_uint(lsum), __float_as_uint(lsum), false, false); lsum = __uint_as_float(rr[0]) + __uint_as_float(rr[1]); }
    if (hi == 0) wsf[32 + r32] = lsum;
    asm volatile("s_waitcnt lgkmcnt(0)" ::: "memory");
    bf16_t* orow = Og + ((size_t)b * TOK + qb * 256 + wid * 32) * 1024 + h * 128 + r32;
#pragma unroll
    for (int r = 0; r < 16; ++r) { const int q = crow(r, hi); const float il = __builtin_amdgcn_rcpf(wsf[32 + q]);
#pragma unroll
        for (int d = 0; d < 4; ++d) { const unsigned w = cvt_pk_bf16(o[d][r] * il, 0.f); orow[(size_t)q * 1024 + d * 32] = (bf16_t)(w & 0xffffu); } }
    asm volatile("s_waitcnt lgkmcnt(0)" ::: "memory"); __builtin_amdgcn_s_barrier(); asm volatile("" ::: "memory");
#undef ATT_ISSUE_K
#undef ATT_ISSUE_V
#undef ATT_PV
#undef ATT_LDV
#undef ATT_LDK
#undef XBAR
#undef SBAR
}

__device__ __forceinline__ void attn_phase(const Params& p, LAS unsigned char* lds, int vcu, int G) {
    const int nitems = p.NB * 8 * 8;
    for (int it = vcu; it < nitems; it += G) {
        const int bh = it >> 3, s = it & 7;
        attn_unit(bh, s, p.Q, p.K, p.V, p.ATT, lds, (float*)(p.ctl + 2048));
        attn_unit(bh, 15 - s, p.Q, p.K, p.V, p.ATT, lds, (float*)(p.ctl + 2048));
    }
}
}
namespace ssm {
constexpr int CH = 256, NCH = TOK / CH, XROW = 272;
struct Cplx { float r, i; };
__device__ __forceinline__ Cplx cmul(Cplx a, Cplx b) { return {a.r * b.r - a.i * b.i, a.r * b.i + a.i * b.r}; }

template <bool OUT>
__device__ __forceinline__ void ssm_item(const Params& p, int item, LAS unsigned char* xt  ) {
    int lane = threadIdx.x & 63; asm volatile("" : "+v"(lane));
    const int j = lane & 31, hi = lane >> 5;
    const int cp = item & 7, g = (item >> 3) & 31, b = item >> 8;
    const int chunk = 2 * cp + hi;
    const float* a_re = p.in[11]; const float* a_im = p.in[12]; const float* log_dt = p.in[13];
    const float* b_re = p.in[14]; const float* b_im = p.in[15]; const float* c_re = p.in[16]; const float* c_im = p.in[17]; const float* dsk = p.in[18];
    const float dt = expf(log_dt[g]);
    Cplx lam[2], fac[2];
#pragma unroll
    for (int k = 0; k < 2; ++k) { const int pp = g * 64 + 32 * k + j; const float ar = a_re[pp], ai = a_im[pp];
        const float mag = expf(ar * dt); lam[k] = {mag * cosf(ai * dt), mag * sinf(ai * dt)};
        const float nr = lam[k].r - 1.f, ni = lam[k].i, den = ar * ar + ai * ai; fac[k] = {(nr * ar + ni * ai) / den, (ni * ar - nr * ai) / den}; }
    bf16x8 bfr[4];
#pragma unroll
    for (int k = 0; k < 2; ++k) { const int pp = g * 64 + 32 * k + j; float br[8], bi[8];
        const f32x4 r0 = *(const f32x4*)(b_re + pp * 16 + 8 * hi), r1 = *(const f32x4*)(b_re + pp * 16 + 8 * hi + 4);
        const f32x4 i0 = *(const f32x4*)(b_im + pp * 16 + 8 * hi), i1 = *(const f32x4*)(b_im + pp * 16 + 8 * hi + 4);
#pragma unroll
        for (int q = 0; q < 4; ++q) { br[q] = r0[q]; br[4 + q] = r1[q]; bi[q] = i0[q]; bi[4 + q] = i1[q]; }
        u32x4 wr_, wi_;
#pragma unroll
        for (int q = 0; q < 4; ++q) { const float ar0 = fac[k].r * br[2 * q] - fac[k].i * bi[2 * q], ar1 = fac[k].r * br[2 * q + 1] - fac[k].i * bi[2 * q + 1];
            const float ai0 = fac[k].r * bi[2 * q] + fac[k].i * br[2 * q], ai1 = fac[k].r * bi[2 * q + 1] + fac[k].i * br[2 * q + 1];
            wr_[q] = cvt_pk_bf16(ar0, ar1); wi_[q] = cvt_pk_bf16(ai0, ai1); }
        bfr[2 * k] = __builtin_bit_cast(bf16x8, wr_); bfr[2 * k + 1] = __builtin_bit_cast(bf16x8, wi_); }
    const int hA = (j >> 2) & 1, rA = (j & 3) + 4 * (j >> 3);
    const size_t rowA0 = (size_t)b * TOK + (size_t)(2 * cp + hA) * CH + rA;
    const bf16_t* ua = p.U + rowA0 * 512 + g * 16 + 8 * hi;
    Cplx x[2] = {{0.f, 0.f}, {0.f, 0.f}};
    bf16x8 cfr[8]; float dv[8];
    if (OUT) {
        Cplx l256[2];
#pragma unroll
        for (int k = 0; k < 2; ++k) { Cplx t = lam[k];
#pragma unroll
            for (int s = 0; s < 8; ++s) t = cmul(t, t);
            l256[k] = t; }
        const float* sl = p.sloc + ((size_t)(b * 32 + g) * NCH) * 128;
        for (int c = 0; c < 2 * cp + 1; ++c) { if (c < chunk) {
#pragma unroll
            for (int k = 0; k < 2; ++k) { const float2 s = *(const float2*)(sl + (size_t)c * 128 + (32 * k + j) * 2); const Cplx t = cmul(l256[k], x[k]); x[k] = {t.r + s.x, t.i + s.y}; } } }
#pragma unroll
        for (int ks = 0; ks < 8; ++ks) { u32x4 w = (u32x4){0u, 0u, 0u, 0u};
            if (j < 16) { const f32x4 cr = *(const f32x4*)(c_re + (g * 16 + j) * 64 + 8 * ks + 4 * hi), ci = *(const f32x4*)(c_im + (g * 16 + j) * 64 + 8 * ks + 4 * hi);
#pragma unroll
                for (int q = 0; q < 4; ++q) w[q] = cvt_pk_bf16(cr[q], -ci[q]); }
            cfr[ks] = __builtin_bit_cast(bf16x8, w); }
#pragma unroll
        for (int q = 0; q < 8; ++q) dv[q] = dsk[g * 16 + 4 * hi + (q & 3) + 8 * (q >> 2)];
    }
    for (int tile = 0; tile < CH / 16; ++tile) {
        const bf16x8 af = *(const bf16x8*)(ua + (size_t)tile * 16 * 512);
        f32x16 bu[4];
#pragma unroll
        for (int q = 0; q < 4; ++q) bu[q] = __builtin_amdgcn_mfma_f32_32x32x16_bf16(af, bfr[q], (f32x16){0.f, 0.f, 0.f, 0.f, 0.f, 0.f, 0.f, 0.f, 0.f, 0.f, 0.f, 0.f, 0.f, 0.f, 0.f, 0.f}, 0, 0, 0);
#pragma unroll
        for (int r = 0; r < 16; ++r) {
#pragma unroll
            for (int k = 0; k < 2; ++k) { const float nr = fmaf(lam[k].r, x[k].r, fmaf(-lam[k].i, x[k].i, bu[2 * k][r])), ni = fmaf(lam[k].r, x[k].i, fmaf(lam[k].i, x[k].r, bu[2 * k + 1][r]));
                x[k] = {nr, ni}; if (OUT) { bu[2 * k][r] = nr; bu[2 * k + 1][r] = ni; } }
        }
        if (OUT) {
#pragma unroll
            for (int r = 0; r < 16; ++r) { LAS unsigned* rowp = (LAS unsigned*)(xt + (16 * hi + r) * XROW);
                rowp[j] = cvt_pk_bf16(bu[0][r], bu[1][r]); rowp[32 + j] = cvt_pk_bf16(bu[2][r], bu[3][r]); }
            asm volatile("s_waitcnt lgkmcnt(0)" ::: "memory");
            f32x16 y = (f32x16){0.f, 0.f, 0.f, 0.f, 0.f, 0.f, 0.f, 0.f, 0.f, 0.f, 0.f, 0.f, 0.f, 0.f, 0.f, 0.f};
#pragma unroll
            for (int ks = 0; ks < 8; ++ks) { const bf16x8 xf = *(const LAS bf16x8*)(xt + j * XROW + (16 * ks + 8 * hi) * 2);
                y = __builtin_amdgcn_mfma_f32_32x32x16_bf16(cfr[ks], xf, y, 0, 0, 0); }
            const int hn = j >> 4, rn = j & 15;
            const size_t row = (size_t)b * TOK + (size_t)(2 * cp + hn) * CH + tile * 16 + rn;
#pragma unroll
            for (int q2 = 0; q2 < 2; ++q2) { const int c0 = 4 * hi + 8 * q2;
                const u32x2 uw = *(const u32x2*)(p.U + row * 512 + g * 16 + c0);
                const float u0 = bf_lo(uw.x), u1 = bf_hi(uw.x), u2 = bf_lo(uw.y), u3 = bf_hi(uw.y);
                const float z0 = gelu_t(y[4 * q2 + 0] + dv[4 * q2 + 0] * u0), z1 = gelu_t(y[4 * q2 + 1] + dv[4 * q2 + 1] * u1);
                const float z2 = gelu_t(y[4 * q2 + 2] + dv[4 * q2 + 2] * u2), z3 = gelu_t(y[4 * q2 + 3] + dv[4 * q2 + 3] * u3);
                *(u32x2*)(p.Z + row * 512 + g * 16 + c0) = (u32x2){cvt_pk_bf16(z0, z1), cvt_pk_bf16(z2, z3)}; }
            asm volatile("s_waitcnt lgkmcnt(0)" ::: "memory");
        }
    }
    if (!OUT) {
        float* sl = p.sloc + (((size_t)(b * 32 + g) * NCH + chunk) * 64) * 2;
#pragma unroll
        for (int k = 0; k < 2; ++k) *(float2*)(sl + (32 * k + j) * 2) = make_float2(x[k].r, x[k].i);
    }
}
template <bool OUT>
__device__ __forceinline__ void ssm_phase(const Params& p, LAS unsigned char* lds, int vcu, int G) {
    const int wid = __builtin_amdgcn_readfirstlane(threadIdx.x >> 6);
    const int nitems = p.NB * 32 * 8;
    for (int it = vcu * 8 + wid; it < nitems; it += G * 8) ssm_item<OUT>(p, it, lds + wid * (32 * XROW));
}
}
__device__ __forceinline__ int src_col(int mode, int n) {
    if (mode == 0) return n;
    if (mode == 1) { if (n < 1152) return n; if (n < 1216) return 1152 + dperm(n - 1152); if (n < 1280) return -1; if (n < 2304) return 1216 + (n - 1280); return 2240 + (n - 2304); }
    const int h = n >> 8, c = n & 255; if (c < 128) return 192 * h + c; if (c < 192) return 192 * h + 128 + dperm(c - 128); return -1;
}
__device__ __forceinline__ unsigned f2bf(float f) { unsigned u = __builtin_bit_cast(unsigned, f); return (u + 0x7fffu + ((u >> 16) & 1u)) >> 16; }
__device__ __forceinline__ unsigned pk2(float lo, float hi) { return f2bf(lo) | (f2bf(hi) << 16); }
__device__ __forceinline__ void p0_item(const float* W, int K, int Nsrc, const float* gain, bf16_t* WT, int nblk, int mode, LAS float* scr, int item, int lane) {
    const int kb = item / nblk, nb = item % nblk, k0 = 64 * kb, n0 = 32 * nb;
    const int sc = src_col(mode, n0 + (lane & 31));
#pragma unroll 8
    for (int i = 0; i < 32; ++i) { const int kk = 2 * i + (lane >> 5); float v = 0.f; if (sc >= 0) { v = W[(size_t)(k0 + kk) * Nsrc + sc]; if (gain) v *= gain[k0 + kk]; } scr[kk * 33 + (lane & 31)] = v; }
    asm volatile("s_waitcnt lgkmcnt(0)" ::: "memory");
    const int c = lane & 7;
#pragma unroll
    for (int jj = 0; jj < 4; ++jj) { const int n = (lane >> 3) + 8 * jj; const LAS float* s = scr + (8 * c) * 33 + n;
        u32x4 o; o.x = pk2(s[0 * 33], s[1 * 33]); o.y = pk2(s[2 * 33], s[3 * 33]); o.z = pk2(s[4 * 33], s[5 * 33]); o.w = pk2(s[6 * 33], s[7 * 33]);
        *(u32x4*)(WT + (size_t)(n0 + n) * K + k0 + 8 * c) = o; }
    asm volatile("s_waitcnt lgkmcnt(0)" ::: "memory");
}
__device__ __forceinline__ float wave_sum(float v) {
#pragma unroll
    for (int o = 1; o < 64; o <<= 1) v += __shfl_xor(v, o);
    return v;
}
__device__ __forceinline__ void p0_prologue(const Params& p, LAS unsigned char* lds, int vcu, int G) {
    const int lane = threadIdx.x & 63, wid = __builtin_amdgcn_readfirstlane(threadIdx.x >> 6);
    LAS float* scr = (LAS float*)(lds + wid * 16384);
    const int gw = vcu * 8 + wid, NGW = G * 8;
    constexpr int I1 = 16 * 104, IQ = 6 * 64, IKV = 4 * 64, IGL = 8 * 16, IOS = 8 * 32, IOM = 16 * 32, IOU = 16 * 32, IUP = 16 * 128, IDN = 64 * 32;
    constexpr int NITEMS = I1 + IQ + IKV + IGL + IOS + IOM + IOU + IUP + IDN;
    for (int it = gw; it < NITEMS; it += NGW) {
        int r = it;
        if (r < I1) { p0_item(p.in[3], 1024, 3264, p.in[2], p.W1t, 104, 1, scr, r, lane); continue; } r -= I1;
        if (r < IQ) { p0_item(p.in[6], 384, 1536, p.in[4], p.Wqt, 64, 2, scr, r, lane); continue; } r -= IQ;
        if (r < IKV) { p0_item(p.in[7], 256, 2048, p.in[5], p.Wkvt, 64, 0, scr, r, lane); continue; } r -= IKV;
        if (r < IGL) { p0_item(p.in[19], 512, 512, nullptr, p.Wglut, 16, 0, scr, r, lane); continue; } r -= IGL;
        if (r < IOS) { p0_item(p.in[21], 512, 1024, nullptr, p.Wost, 32, 0, scr, r, lane); continue; } r -= IOS;
        if (r < IOM) { p0_item(p.in[10], 1024, 1024, nullptr, p.Womt, 32, 0, scr, r, lane); continue; } r -= IOM;
        if (r < IOU) { p0_item(p.in[22], 1024, 1024, nullptr, p.Woutt, 32, 0, scr, r, lane); continue; } r -= IOU;
        if (r < IUP) { p0_item(p.in[24], 1024, 4096, p.in[23], p.Wupt, 128, 0, scr, r, lane); continue; } r -= IUP;
        p0_item(p.in[25], 4096, 1024, nullptr, p.Wdnt, 32, 0, scr, r, lane);
    }
    const int M = p.NB * TOK;
    for (int m0 = gw * 4; m0 < M; m0 += NGW * 4) {
        f32x4 v[4][4]; float s[4];
#pragma unroll
        for (int r = 0; r < 4; ++r) { const f32x4* xr = (const f32x4*)(p.x + (size_t)(m0 + r) * 1024) + lane;
#pragma unroll
            for (int jj = 0; jj < 4; ++jj) v[r][jj] = xr[64 * jj]; }
#pragma unroll
        for (int r = 0; r < 4; ++r) { s[r] = 0.f;
#pragma unroll
            for (int jj = 0; jj < 4; ++jj) s[r] += sq4(v[r][jj]);
            s[r] = wave_sum(s[r]);
            u32x2* o8 = (u32x2*)(p.XB + (size_t)(m0 + r) * 1024) + lane;
#pragma unroll
            for (int jj = 0; jj < 4; ++jj) o8[64 * jj] = (u32x2){cvt_pk_bf16(v[r][jj][0], v[r][jj][1]), cvt_pk_bf16(v[r][jj][2], v[r][jj][3])}; }
        if (lane < 4) { const int mm = m0 + lane; const float sv = lane == 0 ? s[0] : lane == 1 ? s[1] : lane == 2 ? s[2] : s[3];
            p.inv_x[mm] = rsqrtf(sv * (1.f / 1024.f) + 1e-6f); p.ssq_q[mm] = 0.f; p.ssq_kv[mm] = 0.f; p.ssq_kpe[mm] = 0.f; p.ssq_h[mm] = 0.f; }
        { const int mm = m0 + (lane >> 5) * 2, i = lane & 31;
#pragma unroll
          for (int r = 0; r < 2; ++r) { const float ang = (float)p.pos[mm + r] * p.inv_freq[i]; p.rcos[(size_t)(mm + r) * 32 + i] = cosf(ang); p.rsin[(size_t)(mm + r) * 32 + i] = sinf(ang); } }
    }
}

constexpr int LDS_RING = 131072, LDS_AUX = LDS_RING, LDS_BYTES = LDS_RING + 4096 + 256;
#ifndef MK_MODE
#define MK_MODE 0
#endif
namespace cg = cooperative_groups;
template <int K>
__device__ __forceinline__ void run_phase(const Params& p, LAS unsigned char* lds, LAS unsigned char* aux, int vcu, int G, int bx, int dry) {
    const int M = p.NB * TOK;
    if (K == 0) { p0_prologue(p, lds, vcu, G); __syncthreads(); }
    if (K == 1) {
        pg8::Gemm g{p.XB, 1024, p.W1t, 1024, M, 3328, 1024}; pg8::StaticOrder S; S.init(M, 3328, G, bx);
        EpiG1 E{p.inv_x, p.U, p.QL, p.CKV, p.kpe, p.SGS, p.SGM, p.ssq_q, p.ssq_kv, p.ssq_kpe, p.rcos, p.rsin, p.in[9], dry};
        pg8::gemm_phase(lds, aux, g, S, E);
    }
#ifndef MK_DUPSUB
#define MK_DUPSUB 7
#endif
#define SUBON(b) (!dry || (MK_DUPSUB & (b)))
    if (K == 2) {
        if (SUBON(4) && (vcu & 1)) { ssm::ssm_phase<false>(p, lds, vcu, G); __syncthreads(); }
        if (SUBON(1)) { pg8::Gemm g{p.QL, 384, p.Wqt, 384, M, 2048, 384}; pg8::StaticOrder S; S.init(M, 2048, G, bx);
          EpiQ E{p.ssq_q, p.rcos, p.rsin, p.in[8], p.Q}; pg8::gemm_phase(lds, aux, g, S, E); }
        if (SUBON(2)) { pg8::Gemm g{p.CKV, 256, p.Wkvt, 256, M, 2048, 256}; pg8::StaticOrder S; S.init(M, 2048, G, bx);
          EpiKV E{p.ssq_kv, p.ssq_kpe, p.in[9], p.kpe, p.K, p.V}; pg8::gemm_phase(lds, aux, g, S, E); }
        if (SUBON(4) && !(vcu & 1)) ssm::ssm_phase<false>(p, lds, vcu, G);
        __syncthreads();
    }
    if (K == 3) {
        if (SUBON(1)) att::attn_phase(p, lds, vcu, G);
        if (SUBON(2)) ssm::ssm_phase<true>(p, lds, vcu, G);
        __syncthreads();
    }
    if (K == 4) {
        pg8::Gemm g{p.Z, 512, p.Wglut, 512, M, 512, 512}; pg8::StaticOrder S; S.init(M, 512, G, bx);
        EpiGlu E{p.Z, p.in[20], p.Z2}; pg8::gemm_phase(lds, aux, g, S, E);
    }
    if (K == 5) {
        { pg8::Gemm g{p.Z2, 512, p.Wost, 512, M, 1024, 512}; pg8::StaticOrder S; S.init(M, 1024, G, bx);
          EpiMix<false> E{p.SGS, p.T1}; pg8::gemm_phase(lds, aux, g, S, E); }
        { pg8::Gemm g{p.ATT, 1024, p.Womt, 1024, M, 1024, 1024}; pg8::StaticOrder S; S.init(M, 1024, G, bx);
          EpiMix<true> E{p.SGM, p.T1}; pg8::gemm_phase(lds, aux, g, S, E); }
    }
    if (K == 6) {
        pg8::Gemm g{p.T1, 1024, p.Woutt, 1024, M, 1024, 1024}; pg8::StaticOrder S; S.init(M, 1024, G, bx);
        EpiOut E{p.x, p.out, p.HB, p.ssq_h, dry}; pg8::gemm_phase(lds, aux, g, S, E);
    }
    if (K == 7) {
        pg8::Gemm g{p.HB, 1024, p.Wupt, 1024, M, 4096, 1024}; pg8::StaticOrder S; S.init(M, 4096, G, bx);
        EpiUp E{p.ssq_h, p.HID}; pg8::gemm_phase(lds, aux, g, S, E);
    }
    if (K == 8) {
        pg8::Gemm g{p.HID, 4096, p.Wdnt, 4096, M, 1024, 4096}; pg8::StaticOrder S; S.init(M, 1024, G, bx);
        EpiDown E{p.HB, p.out, 1.f}; pg8::gemm_phase(lds, aux, g, S, E);
    }
}
__global__ void __launch_bounds__(512, 2) mk_kernel(Params p) {
    extern __shared__ __attribute__((aligned(16))) unsigned char lds_raw[];
    LAS unsigned char* lds = (LAS unsigned char*)lds_raw;
    LAS unsigned char* aux = lds + LDS_AUX;
    const int G = gridDim.x, bx = blockIdx.x;
    const int vcu = (G % 8 == 0) ? (bx % 8) * (G / 8) + bx / 8 : bx;
#ifndef MK_PHMASK
#define MK_PHMASK 0x1ff
#endif
#define IN(k) (((MK_PHMASK >> (k)) & 1) && p.ph_lo <= (k) && (k) < p.ph_hi)
#if MK_MODE == 0
#ifndef MK_CGSYNC
#define MK_CGSYNC 0
#endif
    volatile LAS unsigned* bst = (volatile LAS unsigned*)(lds + LDS_AUX + 4096);
    if (threadIdx.x < 2) bst[threadIdx.x] = 0u;
    __syncthreads();
    XcdBarrier xbar = xcd_barrier_post(p.ctl + 4096, bst);
    if (p.NB < 0) cg::this_grid().sync();
#ifndef MK_BAR
#define MK_BAR 2
#endif
    unsigned bar_epoch = 0;
#define SEAMX() do { if (MK_CGSYNC) cg::this_grid().sync(); else if (MK_BAR == 1) ctr_barrier(p.ctl + 1024, p.ctl + 1088, bar_epoch); else xcd_barrier(xbar); } while (0)
#define SEAM(k) do { if (IN(k) && IN((k) + 1)) SEAMX(); } while (0)
#else
#define SEAMX() do { } while (0)
#define SEAM(k) do { } while (0)
#endif
#ifndef MK_DUP
#define MK_DUP -1
#endif
#define PHASE(k) do { if (IN(k)) { run_phase<k>(p, lds, aux, vcu, G, bx, 0); if (MK_DUP == (k)) { SEAMX(); run_phase<k>(p, lds, aux, vcu, G, bx, 1); } } SEAM(k); } while (0)
    PHASE(0); PHASE(1); PHASE(2); PHASE(3); PHASE(4); PHASE(5); PHASE(6); PHASE(7); PHASE(8);
#ifdef MK_TPROBE
    SEAMX();
    if (blockIdx.x == 0 && threadIdx.x == 0) p.out[0] += 12.f * logf(((const float*)(p.ctl + 2048))[MK_TPROBE] * MK_TPROBE_SCALE);
#endif
#undef IN
#undef SEAM
}
constexpr int N_PHASES = 9;

static size_t al(size_t v) { return (v + 255) & ~(size_t)255; }
static Params make_params(void* const* d_in, float* out, unsigned char* ws, int NB, int b0, bool alias, unsigned char* gates) {
    Params p{};
    for (int i = 0; i < 26; ++i) p.in[i] = (const float*)d_in[i];
    p.out = out; p.NB = NB; p.ph_lo = 0; p.ph_hi = N_PHASES; p.pad = 0;
    p.x = (const float*)d_in[0] + (size_t)b0 * TOK * 1024; p.pos = (const int*)d_in[1] + (size_t)b0 * TOK;
    for (int i = 0; i < 32; ++i) p.inv_freq[i] = powf(10000.0f, -(float)i / 32.0f);
    const size_t M = (size_t)NB * TOK; size_t off = 0;
    auto take = [&](size_t bytes) { unsigned char* q = ws + off; off += al(bytes); return q; };
    p.ctl = (unsigned*)take(1 << 20);
    p.ssq_q = (float*)take(M * 4); p.ssq_kv = (float*)take(M * 4); p.ssq_kpe = (float*)take(M * 4); p.ssq_h = (float*)take(M * 4); p.inv_x = (float*)take(M * 4);
    p.sloc = (float*)take((size_t)NB * 32 * 16 * 128 * 4);
    p.rcos = (float*)take(M * 32 * 4); p.rsin = (float*)take(M * 32 * 4);
    p.kpe = (bf16_t*)take(M * 64 * 2);
    p.W1t = (bf16_t*)take((size_t)3328 * 1024 * 2); p.Wqt = (bf16_t*)take((size_t)2048 * 384 * 2); p.Wkvt = (bf16_t*)take((size_t)2048 * 256 * 2);
    p.Wglut = (bf16_t*)take((size_t)512 * 512 * 2); p.Wost = (bf16_t*)take((size_t)1024 * 512 * 2); p.Womt = (bf16_t*)take((size_t)1024 * 1024 * 2);
    p.Woutt = (bf16_t*)take((size_t)1024 * 1024 * 2); p.Wupt = (bf16_t*)take((size_t)4096 * 1024 * 2); p.Wdnt = (bf16_t*)take((size_t)1024 * 4096 * 2);
    if (alias) {
        unsigned char* rXB = take(M * 2048); unsigned char* rU = take(M * 1024); unsigned char* rQL = take(M * 1280); unsigned char* rQKV = take(M * 8192); unsigned char* rT1 = take(M * 2048);
        p.XB = (bf16_t*)rXB; p.ATT = (bf16_t*)rXB; p.HB = (bf16_t*)rXB;
        p.U = (bf16_t*)rU; p.Z2 = (bf16_t*)rU;
        p.QL = (bf16_t*)rQL; p.CKV = (bf16_t*)(rQL + M * 768); p.Z = (bf16_t*)rQL;
        p.Q = (bf16_t*)rQKV; p.K = (bf16_t*)(rQKV + M * 3072); p.V = (bf16_t*)(rQKV + M * 6144); p.HID = (bf16_t*)rQKV;
        p.T1 = (bf16_t*)rT1;
        p.SGS = (bf16_t*)out; p.SGM = (bf16_t*)((unsigned char*)out + M * 2048);
    } else {
        p.XB = (bf16_t*)take(M * 2048); p.ATT = (bf16_t*)take(M * 2048); p.HB = (bf16_t*)take(M * 2048);
        p.U = (bf16_t*)take(M * 1024); p.Z2 = (bf16_t*)take(M * 1024); p.Z = (bf16_t*)take(M * 1024);
        p.QL = (bf16_t*)take(M * 768); p.CKV = (bf16_t*)take(M * 512);
        p.Q = (bf16_t*)take(M * 3072); p.K = (bf16_t*)take(M * 3072); p.V = (bf16_t*)take(M * 2048); p.HID = (bf16_t*)take(M * 8192);
        p.T1 = (bf16_t*)take(M * 2048);
        p.SGS = (bf16_t*)gates; p.SGM = (bf16_t*)(gates + M * 2048);
    }
    return p;
}
static int g_grid = 0;
static int mk_grid() {
    if (g_grid == 0) {
        int dev = 0, cus = 0, per_cu = 0;
        hipGetDevice(&dev); hipDeviceGetAttribute(&cus, hipDeviceAttributeMultiprocessorCount, dev);
        hipFuncSetAttribute((const void*)mk_kernel, hipFuncAttributeMaxDynamicSharedMemorySize, LDS_BYTES);
        hipOccupancyMaxActiveBlocksPerMultiprocessor(&per_cu, (const void*)mk_kernel, 512, LDS_BYTES);
        (void)hipGetLastError();
        g_grid = (per_cu >= 1) ? cus : -1;
        if (g_grid < 0) fprintf(stderr, "mk: occupancy query reports %d blocks per CU\n", per_cu);
    }
    return g_grid;
}
static void mk_launch_phases(Params p, int lo, int hi, bool coop, hipStream_t stream) {
    const int grid = mk_grid(); if (grid <= 0) return;
    p.ph_lo = lo; p.ph_hi = hi;
    if (coop) { void* args[] = {&p}; hipError_t e = hipLaunchCooperativeKernel((const void*)mk_kernel, dim3(grid), dim3(512), args, LDS_BYTES, stream);
        if (e != hipSuccess) fprintf(stderr, "mk: cooperative launch failed: %s\n", hipGetErrorString(e)); }
    else hipLaunchKernelGGL(mk_kernel, dim3(grid), dim3(512), LDS_BYTES, stream, p);
}
#if MK_MODE == 2
struct NaiveBufs { float *XN, *PROJ, *QLN, *CKN, *QR, *KVR, *Qh, *Kh, *Vh, *S, *ATT, *Y, *Z, *G, *Z2, *YS, *YM, *MIX, *T, *H, *HN, *DN; };
static void naive_batch(void* const* d_in, int b, float* ob, const NaiveBufs& n, hipStream_t stream) {
    const float* x = (const float*)d_in[0]; const int* pos = (const int*)d_in[1];
    const float* norm_mix = (const float*)d_in[2]; const float* w_in = (const float*)d_in[3];
    const float* q_a_norm = (const float*)d_in[4]; const float* kv_a_norm = (const float*)d_in[5];
    const float* w_q_b = (const float*)d_in[6]; const float* w_kv_b = (const float*)d_in[7];
    const float* q_norm = (const float*)d_in[8]; const float* k_norm = (const float*)d_in[9];
    const float* w_o_mla = (const float*)d_in[10];
    const float* a_re = (const float*)d_in[11]; const float* a_im = (const float*)d_in[12]; const float* log_dt = (const float*)d_in[13];
    const float* b_re = (const float*)d_in[14]; const float* b_im = (const float*)d_in[15];
    const float* c_re = (const float*)d_in[16]; const float* c_im = (const float*)d_in[17]; const float* dsk = (const float*)d_in[18];
    const float* w_glu = (const float*)d_in[19]; const float* b_glu = (const float*)d_in[20]; const float* w_o_ssm = (const float*)d_in[21];
    const float* w_out = (const float*)d_in[22]; const float* norm_mlp = (const float*)d_in[23];
    const float* w_up = (const float*)d_in[24]; const float* w_down = (const float*)d_in[25];
    const int Mb = SEQ; const float scale = 1.0f / sqrtf(192.f);
    const float* xb = x + (size_t)b * Mb * 1024; const int* pb = pos + (size_t)b * Mb;
    k_rmsnorm<<<Mb, 256, 0, stream>>>(xb, 1024, norm_mix, n.XN, 1024, 1024);
    gemm(stream, n.XN, 1024, w_in, D_IN, n.PROJ, D_IN, Mb, D_IN, 1024, false, 0);
    k_rmsnorm<<<Mb, 256, 0, stream>>>(n.PROJ + OFF_QL, D_IN, q_a_norm, n.QLN, 384, 384);
    k_rmsnorm<<<Mb, 256, 0, stream>>>(n.PROJ + OFF_KV, D_IN, kv_a_norm, n.CKN, 256, 256);
    gemm(stream, n.QLN, 384, w_q_b, 1536, n.QR, 1536, Mb, 1536, 384, false, 0);
    gemm(stream, n.CKN, 256, w_kv_b, 2048, n.KVR, 2048, Mb, 2048, 256, false, 0);
    k_qkprep<<<dim3(Mb, NH), 192, 0, stream>>>(n.QR, n.KVR, n.PROJ, pb, q_norm, k_norm, n.Qh, n.Kh, n.Vh, Mb);
    for (int h = 0; h < NH; ++h) {
        gemm(stream, n.Qh + (size_t)h * Mb * 192, 192, n.Kh + (size_t)h * Mb * 192, 192, n.S, Mb, Mb, Mb, 192, true, 1);
        k_softmax<<<Mb, 256, 0, stream>>>(n.S, Mb, scale);
        gemm(stream, n.S, Mb, n.Vh + (size_t)h * Mb * 128, 128, n.ATT + h * 128, 1024, Mb, 128, Mb, false, 2);
    }
    k_ssm<<<SSM_G, 64, 0, stream>>>(n.PROJ, a_re, a_im, log_dt, b_re, b_im, c_re, c_im, dsk, n.Y, Mb);
    const size_t n512 = (size_t)Mb * 512, n1024 = (size_t)Mb * 1024, n4096 = (size_t)Mb * 4096;
    k_gelu<<<(unsigned)(n512 / 256), 256, 0, stream>>>(n.Y, n.Z, n512);
    gemm(stream, n.Z, 512, w_glu, 512, n.G, 512, Mb, 512, 512, false, 0);
    k_glu<<<(unsigned)(n512 / 256), 256, 0, stream>>>(n.Z, n.G, b_glu, n.Z2, n512);
    gemm(stream, n.Z2, 512, w_o_ssm, 1024, n.YS, 1024, Mb, 1024, 512, false, 0);
    gemm(stream, n.ATT, 1024, w_o_mla, 1024, n.YM, 1024, Mb, 1024, 1024, false, 0);
    k_mix<<<(unsigned)(n1024 / 256), 256, 0, stream>>>(n.PROJ, n.YS, n.YM, n.MIX, n1024);
    gemm(stream, n.MIX, 1024, w_out, 1024, n.T, 1024, Mb, 1024, 1024, false, 0);
    k_add<<<(unsigned)(n1024 / 256), 256, 0, stream>>>(xb, n.T, n.H, n1024);
    k_rmsnorm<<<Mb, 256, 0, stream>>>(n.H, 1024, norm_mlp, n.HN, 1024, 1024);
    gemm(stream, n.HN, 1024, w_up, 4096, n.S, 4096, Mb, 4096, 1024, false, 0);
    k_relu2<<<(unsigned)(n4096 / 256), 256, 0, stream>>>(n.S, n4096);
    gemm(stream, n.S, 4096, w_down, 1024, n.DN, 1024, Mb, 1024, 4096, false, 0);
    k_add<<<(unsigned)(n1024 / 256), 256, 0, stream>>>(n.H, n.DN, ob, n1024);
}
__device__ __forceinline__ float bfv(const bf16_t* p, size_t i) { return __uint_as_float((unsigned)p[i] << 16); }
__global__ void __launch_bounds__(256) k_check(int id, size_t n, Params p, NaiveBufs nb, const float* nout, const float* oout, float* res) {
    __shared__ float red[4];
    const int Mb = TOK; float sd = 0.f, sr = 0.f;
    for (size_t i = (size_t)blockIdx.x * 256 + threadIdx.x; i < n; i += (size_t)gridDim.x * 256) {
        float a = 0.f, r = 0.f;
        switch (id) {
            case 1: { const size_t rr = i / 512, c = i % 512; a = bfv(p.U, i); r = nb.PROJ[rr * D_IN + c]; } break;
            case 2: { const size_t rr = i / 384, c = i % 384; a = bfv(p.QL, i); r = nb.PROJ[rr * D_IN + 512 + c]; } break;
            case 3: { const size_t rr = i / 256, c = i % 256; a = bfv(p.CKV, i); r = nb.PROJ[rr * D_IN + 896 + c]; } break;
            case 4: { const size_t rr = i / 1024, c = i % 1024; a = bfv(p.SGS, i); r = sigmoidf_(nb.PROJ[rr * D_IN + OFF_GS + c]); } break;
            case 5: { const size_t rr = i / 1024, c = i % 1024; a = bfv(p.SGM, i); r = sigmoidf_(nb.PROJ[rr * D_IN + OFF_GM + c]); } break;
            case 6: case 7: { const size_t h = i / ((size_t)Mb * 192), l = (i / 192) % Mb, s = i % 192; const size_t d = s < 128 ? s : 128 + dperm((int)s - 128);
                if (id == 6) { a = bfv(p.Q, i); r = nb.Qh[(h * Mb + l) * 192 + d] * QSCALE; }
                else { a = bfv(p.K, ((h * 64 + l / 64) * 24 + s / 8) * 512 + (l % 64) * 8 + s % 8); r = nb.Kh[(h * Mb + l) * 192 + d]; } } break;
            case 8: { const size_t h = i / ((size_t)Mb * 128), l = (i / 128) % Mb, d = i % 128; a = bfv(p.V, ((h * 64 + l / 64) * 4 + d / 32) * 2048 + (l % 64) * 32 + d % 32); r = nb.Vh[(h * Mb + l) * 128 + d]; } break;
            case 9: a = bfv(p.ATT, i); r = nb.ATT[i]; break;
            case 10: a = bfv(p.Z, i); r = nb.Z[i]; break;
            case 11: a = bfv(p.Z2, i); r = nb.Z2[i]; break;
            case 12: a = bfv(p.T1, i); r = nb.MIX[i]; break;
            case 13: a = bfv(p.HB, i); r = nb.H[i]; break;
            case 14: a = bfv(p.HID, i); r = nb.S[i]; break;
            case 15: a = oout[i]; r = nout[i]; break;
        }
        const float d = a - r; sd += d * d; sr += r * r;
    }
    sd = block_sum256(sd, red); sr = block_sum256(sr, red);
    if (threadIdx.x == 0) { atomicAdd(res + 2 * id, sd); atomicAdd(res + 2 * id + 1, sr); }
}
__global__ void k_final(const float* res, float* out, int nchk, int first) {
    float code = 9900.f;
    for (int id = first; id <= nchk; ++id) { const float rvr = res[2 * id] / res[2 * id + 1];
        if (!(rvr < 2e-4f)) { const int sev = !(rvr < 0.1f) ? 0 : (rvr >= 1e-2f) ? 1 : (rvr >= 1e-3f) ? 2 : 3; code = 100.f * id + 10.f * sev; break; } }
    out[0] = code;
}
#ifndef MK_FIRST_CHECK
#define MK_FIRST_CHECK 1
#endif
extern "C" void kernel_launch(void* const* d_in, const int* in_sizes, int n_in, void* d_out, int out_size, void* d_ws, size_t ws_size, hipStream_t stream) {
    unsigned char* ws = (unsigned char*)d_ws; float* out = (float*)d_out;
    const size_t MiB = 1u << 20; const int Mb = TOK;
    float* w = (float*)(ws + 150 * MiB); size_t off = 0;
    auto take = [&](size_t n) { float* q = w + off; off += n; return q; };
    const size_t slot = (size_t)Mb * 1024;
    NaiveBufs n;
    n.PROJ = take((size_t)Mb * D_IN); n.Qh = take((size_t)Mb * 1536); n.Kh = take((size_t)Mb * 1536); n.Vh = take((size_t)Mb * 1024);
    n.S = take((size_t)Mb * 4096); n.Y = take((size_t)Mb * 512); n.Z = take((size_t)Mb * 512);
    n.G = take((size_t)Mb * 512); n.Z2 = take((size_t)Mb * 512);
    float* scratch = take((size_t)Mb * 5248);
    n.XN = scratch; n.QLN = scratch + (size_t)Mb * 1024; n.CKN = n.QLN + (size_t)Mb * 384; n.QR = n.CKN + (size_t)Mb * 256; n.KVR = n.QR + (size_t)Mb * 1536;
    n.YS = scratch; n.YM = scratch + (size_t)Mb * 1024; n.T = scratch + (size_t)Mb * 2048; n.HN = scratch + (size_t)Mb * 3072; n.DN = scratch + (size_t)Mb * 4096;
    float* res = take(64);
    float* out2 = out + slot; unsigned char* gates = (unsigned char*)(out + 2 * slot); n.ATT = out + 3 * slot; n.MIX = out + 4 * slot; n.H = out + 5 * slot;
    hipMemsetAsync(ws, 0, 1 << 20, stream); hipMemsetAsync(res, 0, 64 * 4, stream);
    hipMemsetAsync(out, 0, (size_t)out_size * 4, stream);
    naive_batch(d_in, 0, out, n, stream);
    Params p = make_params(d_in, out2, ws, 1, 0, false, gates);
    for (int ph = 0; ph < N_PHASES; ++ph) mk_launch_phases(p, ph, ph + 1, false, stream);
    const size_t cnt[16] = {0, (size_t)Mb * 512, (size_t)Mb * 384, (size_t)Mb * 256, (size_t)Mb * 1024, (size_t)Mb * 1024, (size_t)Mb * 1536, (size_t)Mb * 1536, (size_t)Mb * 1024,
                            (size_t)Mb * 1024, (size_t)Mb * 512, (size_t)Mb * 512, (size_t)Mb * 1024, (size_t)Mb * 1024, (size_t)Mb * 4096, (size_t)Mb * 1024};
    for (int id = 1; id <= 15; ++id) k_check<<<1024, 256, 0, stream>>>(id, cnt[id], p, n, out, out2, res);
    k_final<<<1, 1, 0, stream>>>(res, out, 15, MK_FIRST_CHECK);
}
#else
extern "C" void kernel_launch(void* const* d_in, const int* in_sizes, int n_in, void* d_out, int out_size, void* d_ws, size_t ws_size, hipStream_t stream) {
    Params p = make_params(d_in, (float*)d_out, (unsigned char*)d_ws, 8, 0, true, nullptr);
    hipMemsetAsync(d_ws, 0, 65536, stream);
#if MK_MODE == 0
    mk_launch_phases(p, 0, N_PHASES, true, stream);
#else
    for (int ph = 0; ph < N_PHASES; ++ph) mk_launch_phases(p, ph, ph + 1, false, stream);
#endif
}
#endif
```

```cpp
#include <hip/hip_runtime.h>
#include <hip/hip_cooperative_groups.h>
#include <cstdint>
#include <cstdio>
#include <cmath>
#define MK_MODE 0
#define MK_FIRST_CHECK 1
#define LAS __attribute__((address_space(3)))
typedef unsigned short bf16_t;
typedef short bf16x8 __attribute__((ext_vector_type(8)));
typedef short s16x4 __attribute__((ext_vector_type(4)));
typedef float f32x4 __attribute__((ext_vector_type(4)));
typedef float f32x16 __attribute__((ext_vector_type(16)));
typedef unsigned u32x4 __attribute__((ext_vector_type(4)));
typedef unsigned u32x2 __attribute__((ext_vector_type(2)));

constexpr int TOK = 4096;
constexpr float LOG2E = 1.4426950408889634f;
constexpr float QSCALE = 0.07216878364870322f * LOG2E;

struct Params {
    const float* in[26];
    float* out;
    unsigned* ctl;
    float *ssq_q, *ssq_kv, *ssq_kpe, *ssq_h, *inv_x;
    float* sloc;
    float *rcos, *rsin;
    bf16_t* kpe;
    bf16_t *W1t, *Wqt, *Wkvt, *Wglut, *Wost, *Womt, *Woutt, *Wupt, *Wdnt;
    bf16_t *XB, *U, *QL, *CKV, *Q, *K, *V, *ATT, *Z, *Z2, *T1, *HB, *HID, *SGS, *SGM;
    const float* x; const int* pos;
    int NB, ph_lo, ph_hi, pad;
    float inv_freq[32];
};

typedef float f32x2_t __attribute__((ext_vector_type(2))); typedef __bf16 bf16x2_t __attribute__((ext_vector_type(2)));
__device__ __forceinline__ unsigned cvt_pk_bf16(float lo, float hi) { f32x2_t v = {lo, hi}; bf16x2_t b = __builtin_convertvector(v, bf16x2_t); return __builtin_bit_cast(unsigned, b); }
__device__ __forceinline__ u32x4 pack8(const f32x4 a, const f32x4 b) { u32x4 w; w.x = cvt_pk_bf16(a[0], a[1]); w.y = cvt_pk_bf16(a[2], a[3]); w.z = cvt_pk_bf16(b[0], b[1]); w.w = cvt_pk_bf16(b[2], b[3]); return w; }
__device__ __forceinline__ float bf_lo(unsigned w) { return __uint_as_float(w << 16); }
__device__ __forceinline__ float bf_hi(unsigned w) { return __uint_as_float(w & 0xffff0000u); }
__device__ __forceinline__ void unpack8(const u32x4 w, f32x4& a, f32x4& b) { a = (f32x4){bf_lo(w.x), bf_hi(w.x), bf_lo(w.y), bf_hi(w.y)}; b = (f32x4){bf_lo(w.z), bf_hi(w.z), bf_lo(w.w), bf_hi(w.w)}; }
__device__ __forceinline__ float fast_sigmoid(float v) { return __builtin_amdgcn_rcpf(1.f + __builtin_amdgcn_exp2f(-v * LOG2E)); }
__device__ __forceinline__ float fast_tanh(float v) { const float e = __builtin_amdgcn_exp2f(-2.f * LOG2E * fabsf(v)); const float t = (1.f - e) * __builtin_amdgcn_rcpf(1.f + e); return v < 0.f ? -t : t; }
__device__ __forceinline__ float gelu_t(float x) { return 0.5f * x * (1.f + fast_tanh(0.7978845608028654f * (x + 0.044715f * x * x * x))); }
__host__ __device__ __forceinline__ int dperm(int s) { const int wc = s >> 5, fq = (s >> 3) & 3, n = (s >> 2) & 1, j = s & 3; return 32 * n + 16 * wc + 4 * fq + j; }

namespace pg8 {
constexpr int BM = 256, BK = 64, HALF = 128, HTB = HALF * BK * 2, STAGE_BYTES = 8 * HTB, NXCD = 8, WGM = 8;
__host__ __device__ __forceinline__ int lds_byte(int r, int c) { const int st = (r >> 4) * 2 + (c >> 5), rr = r & 15, cc = c & 31, ob = rr * 64 + cc * 2; return st * 1024 + (ob ^ (((ob >> 9) & 1) << 5)); }
__host__ __device__ __forceinline__ void stage_rc(int b, int& R, int& C) { const int st = b / 1024, sb = b % 1024, swz = sb ^ (((sb >> 9) & 1) << 5); R = (st >> 1) * 16 + swz / 64; C = (st & 1) * 32 + (swz % 64) / 2; }
__host__ __device__ __forceinline__ int perm32(int rho) { const int n = rho >> 4, i = rho & 15; return 8 * (i >> 2) + 4 * n + (i & 3); }
struct Unit { int pm, pn; };
struct Gemm { const bf16_t* A; int lda; const bf16_t* Bt; int ldb; int M, N, K; };
struct StaticOrder {
    int nM, nN, nwg, G, c;
    __device__ void init(int M, int N, int G_, int c_) { nM = M / BM; nN = N / BM; nwg = nM * nN; G = G_; c = c_; }
    __device__ bool next(int i, Unit& u) const {
        const long L = (long)i * G + c; if (L >= nwg) return false;
        int wgid = (int)L; { const int q = nwg / NXCD, r = nwg % NXCD, xcd = wgid % NXCD, off = wgid / NXCD; wgid = (xcd < r ? xcd * (q + 1) : r * (q + 1) + (xcd - r) * q) + off; }
        const int nig = WGM * nN, gid = wgid / nig, fm = gid * WGM, gsz = (nM - fm) < WGM ? (nM - fm) : WGM;
        u.pm = fm + ((wgid % nig) % gsz); u.pn = (wgid % nig) / gsz; return true;
    }
};
typedef f32x4 Acc[2][2][4][2];

template <class Epi>
__device__ __forceinline__ void gemm_phase(LAS unsigned char* lds, LAS unsigned char* aux, const Gemm g, const StaticOrder& S, const Epi& E) {
    int tid = threadIdx.x; asm volatile("" : "+v"(tid));
    const int wid = __builtin_amdgcn_readfirstlane(tid >> 6), lane = tid & 63, wr = wid >> 2, wc = wid & 3, fr = lane & 15, fq = lane >> 4;
    const int K = g.K, nt = K / BK;
    unsigned voffA[2], voffB[2];
#pragma unroll
    for (int i = 0; i < 2; ++i) { int R, C; stage_rc(tid * 16 + i * 8192, R, C); const int Rb = (R & ~31) + perm32(R & 31);
        voffA[i] = (unsigned)(R * g.lda + C) * 2u; voffB[i] = (unsigned)(Rb * g.ldb + C) * 2u; }
    const size_t kstep = (size_t)(BK * 2);
    const size_t hstepA = (size_t)HALF * g.lda * 2, hstepB = (size_t)HALF * g.ldb * 2;
    const size_t tstepA = 2 * hstepA, tstepB = 2 * hstepB;
    const unsigned ldsw = (unsigned)wid * 1024u;
    const int aoff = lds_byte(wr * 64 + fr, fq * 8), boff = lds_byte(wc * 32 + fr, fq * 8);
#define PG8_SA(b, h) (((b) * 2 + (h)) * HTB)
#define PG8_SB(b, h) ((4 + (b) * 2 + (h)) * HTB)
#define PG8_STAGE(bufoff, gbase, voff) do { _Pragma("unroll") for (int _i = 0; _i < 2; ++_i) \
        __builtin_amdgcn_global_load_lds((const unsigned*)((const char*)(gbase) + (voff)[_i]), (LAS unsigned*)(lds + (bufoff) + ldsw + _i * 8192), 16, 0, 0); } while (0)
#define PG8_LDA(dst, b, h) do { _Pragma("unroll") for (int m = 0; m < 4; ++m) _Pragma("unroll") for (int k = 0; k < 2; ++k) dst[m][k] = *(const LAS bf16x8*)(lds + PG8_SA(b, h) + aoff + m * 2048 + k * 1024); } while (0)
#define PG8_LDB(dst, b, h) do { _Pragma("unroll") for (int n = 0; n < 2; ++n) _Pragma("unroll") for (int k = 0; k < 2; ++k) dst[n][k] = *(const LAS bf16x8*)(lds + PG8_SB(b, h) + boff + n * 2048 + k * 1024); } while (0)
#define PG8_MMA(ai, bj, At, Bt) do { __builtin_amdgcn_s_setprio(1); _Pragma("unroll") for (int m = 0; m < 4; ++m) _Pragma("unroll") for (int n = 0; n < 2; ++n) _Pragma("unroll") for (int k = 0; k < 2; ++k) \
        acc[ai][bj][m][n] = __builtin_amdgcn_mfma_f32_16x16x32_bf16(Bt[n][k], At[m][k], acc[ai][bj][m][n], 0, 0, 0); __builtin_amdgcn_s_setprio(0); } while (0)
#define PG8_WAIT_V(n) asm volatile("s_waitcnt vmcnt(" #n ")" ::: "memory")
#define PG8_WAIT_L(n) asm volatile("s_waitcnt lgkmcnt(" #n ")" ::: "memory")
#define PG8_BAR __builtin_amdgcn_s_barrier()
#define PG8_SCHED __builtin_amdgcn_sched_barrier(0)
    Unit cur, nxt; int ui = 0;
    if (!S.next(0, cur)) return;
    Acc acc;
#pragma unroll
    for (int a = 0; a < 2; ++a)
#pragma unroll
        for (int b = 0; b < 2; ++b)
#pragma unroll
            for (int m = 0; m < 4; ++m)
#pragma unroll
                for (int n = 0; n < 2; ++n) acc[a][b][m][n] = (f32x4){0.f, 0.f, 0.f, 0.f};
    bf16x8 At[4][2], B0[2][2], B1[2][2];
    const char* cA = (const char*)g.A + (size_t)cur.pm * tstepA; const char* cB = (const char*)g.Bt + (size_t)cur.pn * tstepB;
    PG8_STAGE(PG8_SB(0, 0), cB, voffB); PG8_STAGE(PG8_SB(0, 1), cB + hstepB, voffB); PG8_STAGE(PG8_SA(0, 0), cA, voffA); PG8_STAGE(PG8_SA(0, 1), cA + hstepA, voffA);
    if (wr == 1) PG8_BAR;
    PG8_WAIT_V(2); PG8_BAR;
    PG8_STAGE(PG8_SB(1, 0), cB + kstep, voffB); PG8_STAGE(PG8_SA(1, 0), cA + kstep, voffA); PG8_STAGE(PG8_SB(1, 1), cB + hstepB + kstep, voffB);
    PG8_WAIT_V(6); PG8_BAR;
    for (;;) {
        const bool has_next = S.next(ui + 1, nxt);
        const char* nA = has_next ? (const char*)g.A + (size_t)nxt.pm * tstepA : cA; const char* nB = has_next ? (const char*)g.Bt + (size_t)nxt.pn * tstepB : cB;
#pragma unroll 1
        for (int t = 0; t < nt; t += 2) {
            const bool last = (t == nt - 2);
            const char* a1 = cA + (size_t)(t + 1) * kstep;
            const char* a2 = last ? nA : cA + (size_t)(t + 2) * kstep; const char* b2 = last ? nB : cB + (size_t)(t + 2) * kstep;
            const char* a3 = a2 + kstep; const char* b3 = b2 + kstep;
            PG8_LDB(B0, 0, 0); PG8_LDB(B1, 0, 1); PG8_SCHED; PG8_LDA(At, 0, 0); PG8_STAGE(PG8_SA(1, 1), a1 + hstepA, voffA);
            PG8_WAIT_V(8); PG8_WAIT_L(0); PG8_BAR; PG8_MMA(0, 0, At, B0); PG8_MMA(0, 1, At, B1); PG8_BAR; PG8_SCHED;
            PG8_LDA(At, 0, 1); PG8_STAGE(PG8_SB(0, 0), b2, voffB); PG8_STAGE(PG8_SB(0, 1), b2 + hstepB, voffB); PG8_STAGE(PG8_SA(0, 0), a2, voffA);
            PG8_WAIT_V(8); PG8_WAIT_L(0); PG8_BAR; PG8_MMA(1, 0, At, B0); PG8_MMA(1, 1, At, B1); PG8_BAR; PG8_SCHED;
            PG8_LDB(B0, 1, 0); PG8_LDB(B1, 1, 1); PG8_SCHED; PG8_LDA(At, 1, 0); PG8_STAGE(PG8_SA(0, 1), a2 + hstepA, voffA);
            PG8_WAIT_V(8); PG8_WAIT_L(0); PG8_BAR; PG8_MMA(0, 0, At, B0); PG8_MMA(0, 1, At, B1); PG8_BAR; PG8_SCHED;
            PG8_LDA(At, 1, 1); PG8_STAGE(PG8_SB(1, 0), b3, voffB); PG8_STAGE(PG8_SB(1, 1), b3 + hstepB, voffB); PG8_STAGE(PG8_SA(1, 0), a3, voffA);
            PG8_WAIT_V(8); PG8_WAIT_L(0); PG8_BAR; PG8_MMA(1, 0, At, B0); PG8_MMA(1, 1, At, B1); PG8_BAR; PG8_SCHED;
        }
        if (wr == 0) PG8_BAR;
        E(acc, cur, wr, wc, fr, fq, aux, wid, lane);
        if (!has_next) break;
#pragma unroll
        for (int a = 0; a < 2; ++a)
#pragma unroll
            for (int b = 0; b < 2; ++b)
#pragma unroll
                for (int m = 0; m < 4; ++m)
#pragma unroll
                    for (int n = 0; n < 2; ++n) acc[a][b][m][n] = (f32x4){0.f, 0.f, 0.f, 0.f};
        cur = nxt; cA = nA; cB = nB; ++ui;
        if (wr == 1) PG8_BAR;
    }
    PG8_WAIT_V(0);
    PG8_BAR;
#undef PG8_SA
#undef PG8_SB
#undef PG8_STAGE
#undef PG8_LDA
#undef PG8_LDB
#undef PG8_MMA
#undef PG8_SCHED
}
}
using pg8::Acc; using pg8::Unit;

#define EPI_ARGS const Acc& acc, const Unit& u, int wr, int wc, int fr_, int fq_, LAS unsigned char* aux, int wid, int lane
#define EPI_OPAQUE int fr = fr_, fq = fq_; asm volatile("" : "+v"(fr), "+v"(fq));
#define ROWLOOP for (int ai = 0; ai < 2; ++ai) _Pragma("unroll") for (int m = 0; m < 4; ++m)

__device__ __forceinline__ float fq_sum(float s) { s += __shfl_xor(s, 16); s += __shfl_xor(s, 32); return s; }
__device__ __forceinline__ float sq4(const f32x4 v) { return (v[0] * v[0] + v[1] * v[1]) + (v[2] * v[2] + v[3] * v[3]); }

struct EpiG1 {
    const float* inv_x; bf16_t *U, *QL, *CKV, *KPE, *SGS, *SGM; float *ssq_q, *ssq_kv, *ssq_kpe; const float *rcos, *rsin; const float* k_norm; int dry;
    __device__ __forceinline__ void operator()(EPI_ARGS) const {
        EPI_OPAQUE
        const int pn = u.pn, cw = wc * 32 + 8 * fq;
#pragma unroll
        ROWLOOP {
            const int row = u.pm * 256 + ai * 128 + wr * 64 + m * 16 + fr; const float s = inv_x[row];
            f32x4 v[2][2];
#pragma unroll
            for (int bj = 0; bj < 2; ++bj)
#pragma unroll
                for (int n = 0; n < 2; ++n) v[bj][n] = acc[ai][bj][m][n] * s;
            if (pn < 2) {
#pragma unroll
                for (int bj = 0; bj < 2; ++bj) *(u32x4*)(U + (size_t)row * 512 + pn * 256 + bj * 128 + cw) = pack8(v[bj][0], v[bj][1]);
            } else if (pn == 2) {
#pragma unroll
                for (int bj = 0; bj < 2; ++bj) *(u32x4*)(QL + (size_t)row * 384 + bj * 128 + cw) = pack8(v[bj][0], v[bj][1]);
                const float q = fq_sum(sq4(v[0][0]) + sq4(v[0][1]) + sq4(v[1][0]) + sq4(v[1][1]));
                if (fq == 0 && !dry) atomicAdd(ssq_q + row, q);
            } else if (pn == 3) {
                *(u32x4*)(QL + (size_t)row * 384 + 256 + cw) = pack8(v[0][0], v[0][1]);
                *(u32x4*)(CKV + (size_t)row * 256 + cw) = pack8(v[1][0], v[1][1]);
                const float q = fq_sum(sq4(v[0][0]) + sq4(v[0][1])), k = fq_sum(sq4(v[1][0]) + sq4(v[1][1]));
                if (fq == 0 && !dry) { atomicAdd(ssq_q + row, q); atomicAdd(ssq_kv + row, k); }
            } else if (pn == 4) {
                *(u32x4*)(CKV + (size_t)row * 256 + 128 + cw) = pack8(v[0][0], v[0][1]);
                const float k = fq_sum(sq4(v[0][0]) + sq4(v[0][1]));
                if (fq == 0 && !dry) atomicAdd(ssq_kv + row, k);
                if (wc < 2) {
                    const int i0 = 16 * wc + 4 * fq;
                    const f32x4 c = *(const f32x4*)(rcos + (size_t)row * 32 + i0), sn = *(const f32x4*)(rsin + (size_t)row * 32 + i0);
                    const f32x4 g1 = *(const f32x4*)(k_norm + 128 + i0), g2 = *(const f32x4*)(k_norm + 160 + i0);
                    const f32x4 x1 = v[1][0] * g1, x2 = v[1][1] * g2;
                    const f32x4 r1 = x1 * c - x2 * sn, r2 = x2 * c + x1 * sn;
                    *(u32x4*)(KPE + (size_t)row * 64 + cw) = pack8(r1, r2);
                    const float p = fq_sum(sq4(v[1][0]) + sq4(v[1][1]));
                    if (fq == 0 && !dry) atomicAdd(ssq_kpe + row, p);
                }
            } else {
                bf16_t* G = (pn < 9) ? SGS : SGM; const int c0 = ((pn < 9) ? (pn - 5) : (pn - 9)) * 256;
#pragma unroll
                for (int bj = 0; bj < 2; ++bj) { f32x4 a, b;
#pragma unroll
                    for (int j = 0; j < 4; ++j) { a[j] = fast_sigmoid(v[bj][0][j]); b[j] = fast_sigmoid(v[bj][1][j]); }
                    *(u32x4*)(G + (size_t)row * 1024 + c0 + bj * 128 + cw) = pack8(a, b); }
            }
        }
    }
};

__device__ __forceinline__ void row_reduce4(const float (&part)[2][4], float (&tot)[2][4], int wr, int wc, int fr, int fq, LAS unsigned char* aux) {
    LAS float* red = (LAS float*)aux;
#pragma unroll
    ROWLOOP { const float s = fq_sum(part[ai][m]); if (fq == 0) red[(ai * 128 + wr * 64 + m * 16 + fr) * 4 + wc] = s; }
    asm volatile("s_waitcnt lgkmcnt(0)" ::: "memory"); __builtin_amdgcn_s_barrier(); asm volatile("" ::: "memory");
#pragma unroll
    ROWLOOP { const f32x4 t = *(const LAS f32x4*)(red + (ai * 128 + wr * 64 + m * 16 + fr) * 4); tot[ai][m] = (t[0] + t[1]) + (t[2] + t[3]); }
    asm volatile("s_waitcnt lgkmcnt(0)" ::: "memory"); __builtin_amdgcn_s_barrier(); asm volatile("" ::: "memory");
}

struct EpiQ {
    const float* ssq_q; const float *rcos, *rsin; const float* q_norm; bf16_t* Q;
    __device__ __forceinline__ void operator()(EPI_ARGS) const {
        EPI_OPAQUE
        const int h = u.pn, cw = wc * 32 + 8 * fq;
        float part[2][4], tot[2][4], rs[2][4];
#pragma unroll
        ROWLOOP { const int row = u.pm * 256 + ai * 128 + wr * 64 + m * 16 + fr; const float s = __builtin_amdgcn_rsqf(ssq_q[row] * (1.f / 384.f) + 1e-6f); rs[ai][m] = s;
            part[ai][m] = (sq4(acc[ai][0][m][0]) + sq4(acc[ai][0][m][1]) + sq4(acc[ai][1][m][0]) + sq4(acc[ai][1][m][1])) * s * s; }
        row_reduce4(part, tot, wr, wc, fr, fq, aux);
        const f32x4 g0 = *(const f32x4*)(q_norm + cw), g1 = *(const f32x4*)(q_norm + cw + 4);
        const int i0 = 16 * (wc & 1) + 4 * fq;
        const f32x4 gr1 = *(const f32x4*)(q_norm + 128 + i0), gr2 = *(const f32x4*)(q_norm + 160 + i0);
#pragma unroll
        ROWLOOP { const int row = u.pm * 256 + ai * 128 + wr * 64 + m * 16 + fr;
            const float f = rs[ai][m] * __builtin_amdgcn_rsqf(tot[ai][m] * (1.f / 192.f) + 1e-6f) * QSCALE;
            const int b = row / TOK, l = row % TOK; bf16_t* qrow = Q + ((size_t)(b * 8 + h) * TOK + l) * 192;
            *(u32x4*)(qrow + cw) = pack8(acc[ai][0][m][0] * f * g0, acc[ai][0][m][1] * f * g1);
            if (wc < 2) {
                const f32x4 c = *(const f32x4*)(rcos + (size_t)row * 32 + i0), sn = *(const f32x4*)(rsin + (size_t)row * 32 + i0);
                const f32x4 x1 = acc[ai][1][m][0] * f * gr1, x2 = acc[ai][1][m][1] * f * gr2;
                *(u32x4*)(qrow + 128 + cw) = pack8(x1 * c - x2 * sn, x2 * c + x1 * sn);
            }
            asm volatile("" ::: "memory");
        }
    }
};

struct EpiKV {
    const float *ssq_kv, *ssq_kpe; const float* k_norm; const bf16_t* KPE; bf16_t *K, *V;
    __device__ __forceinline__ void operator()(EPI_ARGS) const {
        EPI_OPAQUE
        const int h = u.pn, cw = wc * 32 + 8 * fq;
        float part[2][4], tot[2][4], rs[2][4];
#pragma unroll
        ROWLOOP { const int row = u.pm * 256 + ai * 128 + wr * 64 + m * 16 + fr; const float s = __builtin_amdgcn_rsqf(ssq_kv[row] * (1.f / 256.f) + 1e-6f); rs[ai][m] = s;
            part[ai][m] = (sq4(acc[ai][0][m][0]) + sq4(acc[ai][0][m][1])) * s * s; }
        row_reduce4(part, tot, wr, wc, fr, fq, aux);
        const f32x4 g0 = *(const f32x4*)(k_norm + cw), g1 = *(const f32x4*)(k_norm + cw + 4);
#pragma unroll
        ROWLOOP { const int row = u.pm * 256 + ai * 128 + wr * 64 + m * 16 + fr;
            const float ik = __builtin_amdgcn_rsqf((tot[ai][m] + ssq_kpe[row]) * (1.f / 192.f) + 1e-6f), f = rs[ai][m] * ik;
            const int b = row / TOK, l = row % TOK; const size_t tl = (size_t)(b * 8 + h) * 64 + (l >> 6); const int kv = l & 63;
            bf16_t* kt = K + tl * 12288 + kv * 8;
            *(u32x4*)(kt + (4 * wc + fq) * 512) = pack8(acc[ai][0][m][0] * f * g0, acc[ai][0][m][1] * f * g1);
            if (wc < 2) { const u32x4 w = *(const u32x4*)(KPE + (size_t)row * 64 + cw); f32x4 a, c; unpack8(w, a, c);
                *(u32x4*)(kt + (16 + 4 * wc + fq) * 512) = pack8(a * ik, c * ik); }
            *(u32x4*)(V + tl * 8192 + wc * 2048 + kv * 32 + fq * 8) = pack8(acc[ai][1][m][0] * rs[ai][m], acc[ai][1][m][1] * rs[ai][m]);
            asm volatile("" ::: "memory");
        }
    }
};

struct EpiGlu {
    const bf16_t* Z; const float* bias; bf16_t* Z2;
    __device__ __forceinline__ void operator()(EPI_ARGS) const {
        EPI_OPAQUE
#pragma unroll
        for (int bj = 0; bj < 2; ++bj) { const int col = u.pn * 256 + bj * 128 + wc * 32 + 8 * fq;
            const f32x4 b0 = *(const f32x4*)(bias + col), b1 = *(const f32x4*)(bias + col + 4);
#pragma unroll
            ROWLOOP { const int row = u.pm * 256 + ai * 128 + wr * 64 + m * 16 + fr;
                f32x4 z0, z1; unpack8(*(const u32x4*)(Z + (size_t)row * 512 + col), z0, z1);
                f32x4 o0, o1;
#pragma unroll
                for (int j = 0; j < 4; ++j) { o0[j] = z0[j] * fast_sigmoid(acc[ai][bj][m][0][j] + b0[j]); o1[j] = z1[j] * fast_sigmoid(acc[ai][bj][m][1][j] + b1[j]); }
                *(u32x4*)(Z2 + (size_t)row * 512 + col) = pack8(o0, o1); }
        }
    }
};
template <bool SECOND> struct EpiMix {
    const bf16_t* SG; bf16_t* T1;
    __device__ __forceinline__ void operator()(EPI_ARGS) const {
        EPI_OPAQUE
#pragma unroll
        for (int bj = 0; bj < 2; ++bj) { const int col = u.pn * 256 + bj * 128 + wc * 32 + 8 * fq;
#pragma unroll
            ROWLOOP { const size_t o = (size_t)(u.pm * 256 + ai * 128 + wr * 64 + m * 16 + fr) * 1024 + col;
                f32x4 s0, s1; unpack8(*(const u32x4*)(SG + o), s0, s1);
                f32x4 r0 = s0 * acc[ai][bj][m][0], r1 = s1 * acc[ai][bj][m][1];
                if (SECOND) { f32x4 t0, t1; unpack8(*(const u32x4*)(T1 + o), t0, t1); r0 += t0; r1 += t1; }
                *(u32x4*)(T1 + o) = pack8(r0, r1); }
        }
    }
};
struct EpiOut {
    const float* x; float* out; bf16_t* HB; float* ssq_h; int dry;
    __device__ __forceinline__ void operator()(EPI_ARGS) const {
        EPI_OPAQUE
#pragma unroll
        ROWLOOP { const int row = u.pm * 256 + ai * 128 + wr * 64 + m * 16 + fr; float q = 0.f;
#pragma unroll
            for (int bj = 0; bj < 2; ++bj) { const size_t o = (size_t)row * 1024 + u.pn * 256 + bj * 128 + wc * 32 + 8 * fq;
                const f32x4 h0 = *(const f32x4*)(x + o) + acc[ai][bj][m][0], h1 = *(const f32x4*)(x + o + 4) + acc[ai][bj][m][1];
                *(u32x4*)(HB + o) = pack8(h0, h1); q += sq4(h0) + sq4(h1); }
            q = fq_sum(q); if (fq == 0 && !dry) atomicAdd(ssq_h + row, q); }
    }
};
struct EpiUp {
    const float* ssq_h; bf16_t* HID;
    __device__ __forceinline__ void operator()(EPI_ARGS) const {
        EPI_OPAQUE
#pragma unroll
        ROWLOOP { const int row = u.pm * 256 + ai * 128 + wr * 64 + m * 16 + fr; const float s = __builtin_amdgcn_rsqf(ssq_h[row] * (1.f / 1024.f) + 1e-6f);
#pragma unroll
            for (int bj = 0; bj < 2; ++bj) { f32x4 a, b;
#pragma unroll
                for (int j = 0; j < 4; ++j) { const float p = fmaxf(acc[ai][bj][m][0][j] * s, 0.f), q = fmaxf(acc[ai][bj][m][1][j] * s, 0.f); a[j] = p * p; b[j] = q * q; }
                *(u32x4*)(HID + (size_t)row * 4096 + u.pn * 256 + bj * 128 + wc * 32 + 8 * fq) = pack8(a, b); } }
    }
};
struct EpiDown {
    const bf16_t* HB; float* out; float sc;
    __device__ __forceinline__ void operator()(EPI_ARGS) const {
        EPI_OPAQUE
#pragma unroll
        ROWLOOP { const int row = u.pm * 256 + ai * 128 + wr * 64 + m * 16 + fr;
#pragma unroll
            for (int bj = 0; bj < 2; ++bj) { const size_t o = (size_t)row * 1024 + u.pn * 256 + bj * 128 + wc * 32 + 8 * fq;
                f32x4 h0, h1; unpack8(*(const u32x4*)(HB + o), h0, h1);
                *(f32x4*)(out + o) = h0 + acc[ai][bj][m][0] * sc; *(f32x4*)(out + o + 4) = h1 + acc[ai][bj][m][1] * sc; } }
    }
};
#define XB_TMO      128
#define XB_XCNT(j)  (256  + 64 * (j))
#define XB_XSUB(j)  (1280 + 64 * (j))
#define XB_XGEN(j)  (2304 + 64 * (j))
#define XB_TOP      3328
#define XB_TOPGEN   3392
#define XCD_BAR_WORDS 3456
#define XB_SPIN_CAP (1u << 18)
__device__ __forceinline__ unsigned xb_ld(unsigned* p)              { return __hip_atomic_load(p, __ATOMIC_RELAXED, __HIP_MEMORY_SCOPE_AGENT); }
__device__ __forceinline__ unsigned xb_add(unsigned* p, unsigned v) { return __hip_atomic_fetch_add(p, v, __ATOMIC_RELAXED, __HIP_MEMORY_SCOPE_AGENT); }
__device__ __forceinline__ unsigned xb_xcc_id() { return (unsigned)__builtin_amdgcn_s_getreg((3 << 11) | 20) & 0xFu; }
#define XB_SPIN(cond, bar) do { unsigned _sp = 0; while (cond) { __builtin_amdgcn_s_sleep(1); \
    if ((++_sp & 255u) == 0u) { if (xb_ld(&(bar)[XB_TMO])) break; if (_sp > XB_SPIN_CAP) { atomicAdd(&(bar)[XB_TMO], 1u); break; } } } } while (0)
struct XcdBarrier { unsigned* bar; unsigned x; volatile LAS unsigned* st; };
__device__ __forceinline__ XcdBarrier xcd_barrier_post(unsigned* bar, volatile LAS unsigned* st) {
    XcdBarrier b; b.bar = bar; b.x = xb_xcc_id(); b.st = st;
    if (threadIdx.x == 0) (void)xb_add(&bar[XB_XCNT(b.x)], 1u);
    return b;
}
__device__ __forceinline__ void xcd_barrier_complete(unsigned* bar, unsigned x, unsigned& nloc, unsigned& nx) {
    const unsigned G = gridDim.x * gridDim.y * gridDim.z;
    unsigned sum, cnt, mine, sp = 0u;
    for (;;) {
        sum = 0u; cnt = 0u; mine = 0u;
#pragma unroll
        for (unsigned j = 0; j < 16; ++j) { const unsigned c = xb_ld(&bar[XB_XCNT(j)]); sum += c; cnt += (c > 0u) ? 1u : 0u; mine = (j == x) ? c : mine; }
        if (sum == G) break;
        __builtin_amdgcn_s_sleep(1);
        if ((++sp & 255u) == 0u) { if (xb_ld(&bar[XB_TMO])) break; if (sp > XB_SPIN_CAP) { atomicAdd(&bar[XB_TMO], 1u); break; } }
    }
    nloc = mine > 0u ? mine : 1u; nx = cnt > 0u ? cnt : 1u;
}
__device__ __forceinline__ void xcd_barrier(const XcdBarrier& b) {
    asm volatile("s_waitcnt vmcnt(0)" ::: "memory");
    __syncthreads();
    if (threadIdx.x == 0) {
        unsigned* bar = b.bar;
        __builtin_amdgcn_s_waitcnt(0);
        unsigned nloc = b.st[0], nx = b.st[1];
        if (nloc == 0u) { xcd_barrier_complete(bar, b.x, nloc, nx); b.st[0] = nloc; b.st[1] = nx; }
        const unsigned old = xb_add(&bar[XB_XSUB(b.x)], 1u);
        const unsigned gen = old / nloc;
        if (old + 1u == (gen + 1u) * nloc) {
            __builtin_amdgcn_fence(__ATOMIC_RELEASE, "agent");
            asm volatile("s_waitcnt vmcnt(0)" ::: "memory");
            const unsigned og = xb_add(&bar[XB_TOP], 1u);
            const unsigned tg = og / nx;
            if (og + 1u == (tg + 1u) * nx) xb_add(&bar[XB_TOPGEN], 1u);
            else XB_SPIN(xb_ld(&bar[XB_TOPGEN]) == tg, bar);
            __builtin_amdgcn_fence(__ATOMIC_ACQUIRE, "agent");
            xb_add(&bar[XB_XGEN(b.x)], 1u);
            asm volatile("s_waitcnt vmcnt(0)" ::: "memory");
        } else {
            XB_SPIN(xb_ld(&bar[XB_XGEN(b.x)]) == gen, bar);
            __builtin_amdgcn_fence(__ATOMIC_ACQUIRE, "agent");
            asm volatile("s_waitcnt vmcnt(0)" ::: "memory");
        }
    }
    __syncthreads();
}

__device__ __forceinline__ void ctr_barrier(unsigned* ctr, unsigned* tmo, unsigned& epoch) {
    __threadfence();
    __syncthreads();
    ++epoch;
    if (threadIdx.x == 0) {
        const unsigned target = epoch * gridDim.x;
        xb_add(ctr, 1u);
        unsigned sp = 0;
        while (xb_ld(ctr) < target) { __builtin_amdgcn_s_sleep(1); if ((++sp & 1023u) == 0u) { if (sp > (1u << 22)) { atomicAdd(tmo, 1u); break; } } }
    }
    __syncthreads();
    __threadfence();
}
namespace att {
constexpr int KSLOT = 24576, VSLOT = 16384, NSLOT = 3;
constexpr int LDS_K = 0, LDS_V = NSLOT * KSLOT, LDS_WS = LDS_V + NSLOT * VSLOT, LDS_END = LDS_WS + 8 * 256;
__device__ __forceinline__ int crow(int r, int hi) { return (r & 3) + 8 * (r >> 2) + 4 * hi; }
__device__ __forceinline__ s16x4 vtr(const LAS unsigned char* p) { typedef short v4i16_t __attribute__((ext_vector_type(4))); return __builtin_bit_cast(s16x4, __builtin_amdgcn_ds_read_tr16_b64_v4i16((LAS v4i16_t*)p)); }
#define ATT_WAIT_V(n) asm volatile("s_waitcnt vmcnt(" #n ")" ::: "memory")
__device__ __forceinline__ void glds16(const void* gsrc, unsigned lds_dst) { unsigned keep;
    asm volatile("s_mov_b32 %0, m0\n\ts_mov_b32 m0, %2\n\ts_nop 0\n\tglobal_load_lds_dwordx4 %1, off\n\ts_mov_b32 m0, %0" : "=&s"(keep) : "v"(gsrc), "s"(lds_dst) : "memory"); }

__device__ __forceinline__ void attn_unit(int bh, int qb, const bf16_t* Qg, const bf16_t* Kg, const bf16_t* Vg, bf16_t* Og, LAS unsigned char* lds, float* tprobe) {
    int tid = threadIdx.x; asm volatile("" : "+v"(tid));
    const int lane = tid & 63, r32 = lane & 31, hi = lane >> 5; const int wid = __builtin_amdgcn_readfirstlane(tid >> 6);
    const int b = bh >> 3, h = bh & 7;
    const int NT = 4 * (qb + 1);
    const char* kbase = (const char*)Kg + (size_t)bh * 64 * KSLOT + lane * 16;
    const char* vbase = (const char*)Vg + (size_t)bh * 64 * VSLOT + lane * 16;
    LAS float* wsf = (LAS float*)(lds + LDS_WS) + wid * 64;
    const unsigned lds0 = (unsigned)(uintptr_t)lds;
#define ATT_ISSUE_K(t, slot) do { _Pragma("unroll") for (int _p = 0; _p < 3; ++_p) glds16(kbase + (size_t)(t) * KSLOT + (wid + 8 * _p) * 1024, (unsigned)__builtin_amdgcn_readfirstlane(lds0 + LDS_K + (slot) * KSLOT + (wid + 8 * _p) * 1024)); } while (0)
#define ATT_ISSUE_V(t, slot) do { _Pragma("unroll") for (int _p = 0; _p < 2; ++_p) glds16(vbase + (size_t)(t) * VSLOT + (wid + 8 * _p) * 1024, (unsigned)__builtin_amdgcn_readfirstlane(lds0 + LDS_V + (slot) * VSLOT + (wid + 8 * _p) * 1024)); } while (0)
    const bf16_t* qrow = Qg + ((size_t)bh * TOK + qb * 256 + wid * 32 + r32) * 192 + hi * 8;
    bf16x8 qf[12];
#pragma unroll
    for (int d0 = 0; d0 < 12; ++d0) qf[d0] = *(const bf16x8*)(qrow + d0 * 16);
    ATT_ISSUE_K(0, 0); ATT_ISSUE_V(0, 0); ATT_ISSUE_K(1, 1);
    float mrow = -1e30f, lsum = 0.f, alpha = 1.f;
    f32x16 o[4];
#pragma unroll
    for (int d = 0; d < 4; ++d) o[d] = (f32x16){0.f, 0.f, 0.f, 0.f, 0.f, 0.f, 0.f, 0.f, 0.f, 0.f, 0.f, 0.f, 0.f, 0.f, 0.f, 0.f};
    const int qrel = wid * 32 + r32;
    u32x4 pw[2] = {(u32x4){0u, 0u, 0u, 0u}, (u32x4){0u, 0u, 0u, 0u}};
    f32x16 pA = o[0], pB = o[0];
    bool need = false;
    const LAS unsigned char* vp0 = lds + LDS_V + ((lane >> 4) & 1) * 32 + (lane & 3) * 8 + (4 * hi + ((lane & 15) >> 2)) * 64;
#define SBAR() __builtin_amdgcn_sched_barrier(0)
#define XBAR() __builtin_amdgcn_sched_barrier(0x406)
#define ATT_LDK(buf, g) do { _Pragma("unroll") for (int _i = 0; _i < 4; ++_i) kf[buf][_i] = *(const LAS bf16x8*)(kp + (4 * (g) + _i) * 2048); } while (0)
#define ATT_QK(P, ks, hh) do { const LAS unsigned char* kp = lds + LDS_K + (ks) * KSLOT + hi * 1024 + r32 * 16 + (hh) * 512; bf16x8 kf[2][4]; \
        P = (f32x16){0.f, 0.f, 0.f, 0.f, 0.f, 0.f, 0.f, 0.f, 0.f, 0.f, 0.f, 0.f, 0.f, 0.f, 0.f, 0.f}; \
        ATT_LDK(0, 0); \
        _Pragma("unroll") for (int g = 0; g < 3; ++g) { \
            if (g < 2) ATT_LDK((g + 1) & 1, g + 1); \
            XBAR(); \
            _Pragma("unroll") for (int _i = 0; _i < 4; ++_i) P = __builtin_amdgcn_mfma_f32_32x32x16_bf16(kf[g & 1][_i], qf[4 * g + _i], P, 0, 0, 0); \
            XBAR(); } } while (0)
#define ATT_START(P, jbs) do { \
        if ((jbs) >= 0) { const int kb = 32 * (jbs) + 4 * hi; \
            _Pragma("unroll") for (int r = 0; r < 16; ++r) { const int kv = kb + (r & 3) + 8 * (r >> 2); if (kv > qrel) P[r] = -INFINITY; } } \
        float rm = fmaxf(P[0], P[1]); \
        _Pragma("unroll") for (int r = 2; r < 16; ++r) rm = fmaxf(rm, P[r]); \
        { auto rr = __builtin_amdgcn_permlane32_swap(__float_as_uint(rm), __float_as_uint(rm), false, false); rm = fmaxf(__uint_as_float(rr[0]), __uint_as_float(rr[1])); } \
        const float mnew = fmaxf(mrow, rm); need = __any(mnew > mrow); alpha = __builtin_amdgcn_exp2f(mrow - mnew); mrow = mnew; \
        _Pragma("unroll") for (int r = 0; r < 16; ++r) P[r] -= mnew; } while (0)
#define ATT_RESC() do { if (need) { lsum *= alpha; if (hi == 0) wsf[r32] = alpha; asm volatile("s_waitcnt lgkmcnt(0)" ::: "memory"); \
            _Pragma("unroll") for (int r = 0; r < 16; ++r) { const float a_ = wsf[crow(r, hi)]; _Pragma("unroll") for (int d = 0; d < 4; ++d) o[d][r] *= a_; } need = false; } } while (0)
#define ATT_FIN(P) do { float ps = 0.f; \
        _Pragma("unroll") for (int r = 0; r < 16; ++r) { P[r] = __builtin_amdgcn_exp2f(P[r]); ps += P[r]; } \
        lsum += ps; \
        _Pragma("unroll") for (int k = 0; k < 2; ++k) \
            pw[k] = (u32x4){cvt_pk_bf16(P[8 * k], P[8 * k + 1]), cvt_pk_bf16(P[8 * k + 2], P[8 * k + 3]), cvt_pk_bf16(P[8 * k + 4], P[8 * k + 5]), cvt_pk_bf16(P[8 * k + 6], P[8 * k + 7])}; } while (0)
#define ATT_LDV(buf, d, hh) do { _Pragma("unroll") for (int ks = 0; ks < 2; ++ks) { vlo[buf][ks] = vtr(vp + (d) * 4096 + (2 * (hh) + ks) * 1024); vhi[buf][ks] = vtr(vp + (d) * 4096 + (2 * (hh) + ks) * 1024 + 512); } } while (0)
#define ATT_PV(vslot, hh) do { const LAS unsigned char* vp = vp0 + (vslot) * VSLOT; s16x4 vlo[2][2], vhi[2][2]; \
        ATT_LDV(0, 0, hh); \
        _Pragma("unroll") for (int d = 0; d < 4; ++d) { \
            if (d < 3) ATT_LDV((d + 1) & 1, d + 1, hh); \
            XBAR(); \
            _Pragma("unroll") for (int ks = 0; ks < 2; ++ks) { const s16x4 lo = vlo[d & 1][ks], hv = vhi[d & 1][ks]; \
                const bf16x8 vf = (bf16x8){lo[0], lo[1], lo[2], lo[3], hv[0], hv[1], hv[2], hv[3]}; \
                o[d] = __builtin_amdgcn_mfma_f32_32x32x16_bf16(__builtin_bit_cast(bf16x8, pw[ks]), vf, o[d], 0, 0, 0); } \
            XBAR(); } } while (0)
    int s0 = 0, sm1 = 2;
#define ATT_STEP(t, hh, PC, PP, pvs, MASKED) do { \
        const int jbs = (MASKED) ? (2 * (t) + (hh) - 2 * (NT - 4)) : -1; \
        SBAR(); ATT_QK(PC, s0, hh); ATT_FIN(PP); SBAR(); \
        ATT_PV(pvs, 1 - (hh)); ATT_START(PC, jbs); SBAR(); \
        ATT_RESC(); } while (0)
#define ATT_SYNC(t) do { \
        if ((t) + 1 < NT) ATT_WAIT_V(3); else ATT_WAIT_V(0); \
        __builtin_amdgcn_s_barrier(); asm volatile("" ::: "memory"); \
        if ((t) + 1 < NT) ATT_ISSUE_V((t) + 1, (s0 == 2) ? 0 : s0 + 1); \
        if ((t) + 2 < NT) ATT_ISSUE_K((t) + 2, sm1); } while (0)
#define ATT_ROT() do { sm1 = s0; s0 = (s0 == 2) ? 0 : s0 + 1; } while (0)
    ATT_SYNC(0);
    { const int jb0 = (NT == 4) ? 0 : -1;
      ATT_QK(pA, s0, 0); ATT_START(pA, jb0); ATT_RESC();
      if (NT == 4) ATT_STEP(0, 1, pB, pA, s0, true); else ATT_STEP(0, 1, pB, pA, s0, false); }
    ATT_ROT();
    int t = 1;
    for (; t < NT - 4; ++t) {
        ATT_SYNC(t);
        ATT_STEP(t, 0, pA, pB, sm1, false);
        ATT_STEP(t, 1, pB, pA, s0, false);
        ATT_ROT();
    }
    for (; t < NT; ++t) {
        ATT_SYNC(t);
        ATT_STEP(t, 0, pA, pB, sm1, true);
        ATT_STEP(t, 1, pB, pA, s0, true);
        ATT_ROT();
    }
    ATT_SYNC(NT);
    ATT_FIN(pB); ATT_PV(sm1, 1);
#undef ATT_SYNC
#undef ATT_ROT
#undef ATT_STEP
#undef ATT_QK
#undef ATT_START
#undef ATT_RESC
#undef ATT_FIN
    { auto rr = __builtin_amdgcn_permlane32_swap(__float_as_uint(lsum), __float_as_uint(lsum), false, false); lsum = __uint_as_float(rr[0]) + __uint_as_float(rr[1]); }
    if (hi == 0) wsf[32 + r32] = lsum;
    asm volatile("s_waitcnt lgkmcnt(0)" ::: "memory");
    bf16_t* orow = Og + ((size_t)b * TOK + qb * 256 + wid * 32) * 1024 + h * 128 + r32;
#pragma unroll
    for (int r = 0; r < 16; ++r) { const int q = crow(r, hi); const float il = __builtin_amdgcn_rcpf(wsf[32 + q]);
#pragma unroll
        for (int d = 0; d < 4; ++d) { const unsigned w = cvt_pk_bf16(o[d][r] * il, 0.f); orow[(size_t)q * 1024 + d * 32] = (bf16_t)(w & 0xffffu); } }
    asm volatile("s_waitcnt lgkmcnt(0)" ::: "memory"); __builtin_amdgcn_s_barrier(); asm volatile("" ::: "memory");
#undef ATT_ISSUE_K
#undef ATT_ISSUE_V
#undef ATT_PV
#undef ATT_LDV
#undef ATT_LDK
#undef XBAR
#undef SBAR
}

__device__ __forceinline__ void attn_phase(const Params& p, LAS unsigned char* lds, int vcu, int G) {
    const int nitems = p.NB * 8 * 8;
    for (int it = vcu; it < nitems; it += G) {
        const int bh = it >> 3, s = it & 7;
        attn_unit(bh, s, p.Q, p.K, p.V, p.ATT, lds, (float*)(p.ctl + 2048));
        attn_unit(bh, 15 - s, p.Q, p.K, p.V, p.ATT, lds, (float*)(p.ctl + 2048));
    }
}
}
namespace ssm {
constexpr int CH = 256, NCH = TOK / CH, XROW = 272;
struct Cplx { float r, i; };
__device__ __forceinline__ Cplx cmul(Cplx a, Cplx b) { return {a.r * b.r - a.i * b.i, a.r * b.i + a.i * b.r}; }

template <bool OUT>
__device__ __forceinline__ void ssm_item(const Params& p, int item, LAS unsigned char* xt  ) {
    int lane = threadIdx.x & 63; asm volatile("" : "+v"(lane));
    const int j = lane & 31, hi = lane >> 5;
    const int cp = item & 7, g = (item >> 3) & 31, b = item >> 8;
    const int chunk = 2 * cp + hi;
    const float* a_re = p.in[11]; const float* a_im = p.in[12]; const float* log_dt = p.in[13];
    const float* b_re = p.in[14]; const float* b_im = p.in[15]; const float* c_re = p.in[16]; const float* c_im = p.in[17]; const float* dsk = p.in[18];
    const float dt = expf(log_dt[g]);
    Cplx lam[2], fac[2];
#pragma unroll
    for (int k = 0; k < 2; ++k) { const int pp = g * 64 + 32 * k + j; const float ar = a_re[pp], ai = a_im[pp];
        const float mag = expf(ar * dt); lam[k] = {mag * cosf(ai * dt), mag * sinf(ai * dt)};
        const float nr = lam[k].r - 1.f, ni = lam[k].i, den = ar * ar + ai * ai; fac[k] = {(nr * ar + ni * ai) / den, (ni * ar - nr * ai) / den}; }
    bf16x8 bfr[4];
#pragma unroll
    for (int k = 0; k < 2; ++k) { const int pp = g * 64 + 32 * k + j; float br[8], bi[8];
        const f32x4 r0 = *(const f32x4*)(b_re + pp * 16 + 8 * hi), r1 = *(const f32x4*)(b_re + pp * 16 + 8 * hi + 4);
        const f32x4 i0 = *(const f32x4*)(b_im + pp * 16 + 8 * hi), i1 = *(const f32x4*)(b_im + pp * 16 + 8 * hi + 4);
#pragma unroll
        for (int q = 0; q < 4; ++q) { br[q] = r0[q]; br[4 + q] = r1[q]; bi[q] = i0[q]; bi[4 + q] = i1[q]; }
        u32x4 wr_, wi_;
#pragma unroll
        for (int q = 0; q < 4; ++q) { const float ar0 = fac[k].r * br[2 * q] - fac[k].i * bi[2 * q], ar1 = fac[k].r * br[2 * q + 1] - fac[k].i * bi[2 * q + 1];
            const float ai0 = fac[k].r * bi[2 * q] + fac[k].i * br[2 * q], ai1 = fac[k].r * bi[2 * q + 1] + fac[k].i * br[2 * q + 1];
            wr_[q] = cvt_pk_bf16(ar0, ar1); wi_[q] = cvt_pk_bf16(ai0, ai1); }
        bfr[2 * k] = __builtin_bit_cast(bf16x8, wr_); bfr[2 * k + 1] = __builtin_bit_cast(bf16x8, wi_); }
    const int hA = (j >> 2) & 1, rA = (j & 3) + 4 * (j >> 3);
    const size_t rowA0 = (size_t)b * TOK + (size_t)(2 * cp + hA) * CH + rA;
    const bf16_t* ua = p.U + rowA0 * 512 + g * 16 + 8 * hi;
    Cplx x[2] = {{0.f, 0.f}, {0.f, 0.f}};
    bf16x8 cfr[8]; float dv[8];
    if (OUT) {
        Cplx l256[2];
#pragma unroll
        for (int k = 0; k < 2; ++k) { Cplx t = lam[k];
#pragma unroll
            for (int s = 0; s < 8; ++s) t = cmul(t, t);
            l256[k] = t; }
        const float* sl = p.sloc + ((size_t)(b * 32 + g) * NCH) * 128;
        for (int c = 0; c < 2 * cp + 1; ++c) { if (c < chunk) {
#pragma unroll
            for (int k = 0; k < 2; ++k) { const float2 s = *(const float2*)(sl + (size_t)c * 128 + (32 * k + j) * 2); const Cplx t = cmul(l256[k], x[k]); x[k] = {t.r + s.x, t.i + s.y}; } } }
#pragma unroll
        for (int ks = 0; ks < 8; ++ks) { u32x4 w = (u32x4){0u, 0u, 0u, 0u};
            if (j < 16) { const f32x4 cr = *(const f32x4*)(c_re + (g * 16 + j) * 64 + 8 * ks + 4 * hi), ci = *(const f32x4*)(c_im + (g * 16 + j) * 64 + 8 * ks + 4 * hi);
#pragma unroll
                for (int q = 0; q < 4; ++q) w[q] = cvt_pk_bf16(cr[q], -ci[q]); }
            cfr[ks] = __builtin_bit_cast(bf16x8, w); }
#pragma unroll
        for (int q = 0; q < 8; ++q) dv[q] = dsk[g * 16 + 4 * hi + (q & 3) + 8 * (q >> 2)];
    }
    for (int tile = 0; tile < CH / 16; ++tile) {
        const bf16x8 af = *(const bf16x8*)(ua + (size_t)tile * 16 * 512);
        f32x16 bu[4];
#pragma unroll
        for (int q = 0; q < 4; ++q) bu[q] = __builtin_amdgcn_mfma_f32_32x32x16_bf16(af, bfr[q], (f32x16){0.f, 0.f, 0.f, 0.f, 0.f, 0.f, 0.f, 0.f, 0.f, 0.f, 0.f, 0.f, 0.f, 0.f, 0.f, 0.f}, 0, 0, 0);
#pragma unroll
        for (int r = 0; r < 16; ++r) {
#pragma unroll
            for (int k = 0; k < 2; ++k) { const float nr = fmaf(lam[k].r, x[k].r, fmaf(-lam[k].i, x[k].i, bu[2 * k][r])), ni = fmaf(lam[k].r, x[k].i, fmaf(lam[k].i, x[k].r, bu[2 * k + 1][r]));
                x[k] = {nr, ni}; if (OUT) { bu[2 * k][r] = nr; bu[2 * k + 1][r] = ni; } }
        }
        if (OUT) {
#pragma unroll
            for (int r = 0; r < 16; ++r) { LAS unsigned* rowp = (LAS unsigned*)(xt + (16 * hi + r) * XROW);
                rowp[j] = cvt_pk_bf16(bu[0][r], bu[1][r]); rowp[32 + j] = cvt_pk_bf16(bu[2][r], bu[3][r]); }
            asm volatile("s_waitcnt lgkmcnt(0)" ::: "memory");
            f32x16 y = (f32x16){0.f, 0.f, 0.f, 0.f, 0.f, 0.f, 0.f, 0.f, 0.f, 0.f, 0.f, 0.f, 0.f, 0.f, 0.f, 0.f};
#pragma unroll
            for (int ks = 0; ks < 8; ++ks) { const bf16x8 xf = *(const LAS bf16x8*)(xt + j * XROW + (16 * ks + 8 * hi) * 2);
                y = __builtin_amdgcn_mfma_f32_32x32x16_bf16(cfr[ks], xf, y, 0, 0, 0); }
            const int hn = j >> 4, rn = j & 15;
            const size_t row = (size_t)b * TOK + (size_t)(2 * cp + hn) * CH + tile * 16 + rn;
#pragma unroll
            for (int q2 = 0; q2 < 2; ++q2) { const int c0 = 4 * hi + 8 * q2;
                const u32x2 uw = *(const u32x2*)(p.U + row * 512 + g * 16 + c0);
                const float u0 = bf_lo(uw.x), u1 = bf_hi(uw.x), u2 = bf_lo(uw.y), u3 = bf_hi(uw.y);
                const float z0 = gelu_t(y[4 * q2 + 0] + dv[4 * q2 + 0] * u0), z1 = gelu_t(y[4 * q2 + 1] + dv[4 * q2 + 1] * u1);
                const float z2 = gelu_t(y[4 * q2 + 2] + dv[4 * q2 + 2] * u2), z3 = gelu_t(y[4 * q2 + 3] + dv[4 * q2 + 3] * u3);
                *(u32x2*)(p.Z + row * 512 + g * 16 + c0) = (u32x2){cvt_pk_bf16(z0, z1), cvt_pk_bf16(z2, z3)}; }
            asm volatile("s_waitcnt lgkmcnt(0)" ::: "memory");
        }
    }
    if (!OUT) {
        float* sl = p.sloc + (((size_t)(b * 32 + g) * NCH + chunk) * 64) * 2;
#pragma unroll
        for (int k = 0; k < 2; ++k) *(float2*)(sl + (32 * k + j) * 2) = make_float2(x[k].r, x[k].i);
    }
}
template <bool OUT>
__device__ __forceinline__ void ssm_phase(const Params& p, LAS unsigned char* lds, int vcu, int G) {
    const int wid = __builtin_amdgcn_readfirstlane(threadIdx.x >> 6);
    const int nitems = p.NB * 32 * 8;
    for (int it = vcu * 8 + wid; it < nitems; it += G * 8) ssm_item<OUT>(p, it, lds + wid * (32 * XROW));
}
}
__device__ __forceinline__ int src_col(int mode, int n) {
    if (mode == 0) return n;
    if (mode == 1) { if (n < 1152) return n; if (n < 1216) return 1152 + dperm(n - 1152); if (n < 1280) return -1; if (n < 2304) return 1216 + (n - 1280); return 2240 + (n - 2304); }
    const int h = n >> 8, c = n & 255; if (c < 128) return 192 * h + c; if (c < 192) return 192 * h + 128 + dperm(c - 128); return -1;
}
__device__ __forceinline__ unsigned f2bf(float f) { unsigned u = __builtin_bit_cast(unsigned, f); return (u + 0x7fffu + ((u >> 16) & 1u)) >> 16; }
__device__ __forceinline__ unsigned pk2(float lo, float hi) { return f2bf(lo) | (f2bf(hi) << 16); }
__device__ __forceinline__ void p0_item(const float* W, int K, int Nsrc, const float* gain, bf16_t* WT, int nblk, int mode, LAS float* scr, int item, int lane) {
    const int kb = item / nblk, nb = item % nblk, k0 = 64 * kb, n0 = 32 * nb;
    const int sc = src_col(mode, n0 + (lane & 31));
#pragma unroll 8
    for (int i = 0; i < 32; ++i) { const int kk = 2 * i + (lane >> 5); float v = 0.f; if (sc >= 0) { v = W[(size_t)(k0 + kk) * Nsrc + sc]; if (gain) v *= gain[k0 + kk]; } scr[kk * 33 + (lane & 31)] = v; }
    asm volatile("s_waitcnt lgkmcnt(0)" ::: "memory");
    const int c = lane & 7;
#pragma unroll
    for (int jj = 0; jj < 4; ++jj) { const int n = (lane >> 3) + 8 * jj; const LAS float* s = scr + (8 * c) * 33 + n;
        u32x4 o; o.x = pk2(s[0 * 33], s[1 * 33]); o.y = pk2(s[2 * 33], s[3 * 33]); o.z = pk2(s[4 * 33], s[5 * 33]); o.w = pk2(s[6 * 33], s[7 * 33]);
        *(u32x4*)(WT + (size_t)(n0 + n) * K + k0 + 8 * c) = o; }
    asm volatile("s_waitcnt lgkmcnt(0)" ::: "memory");
}
__device__ __forceinline__ float wave_sum(float v) {
#pragma unroll
    for (int o = 1; o < 64; o <<= 1) v += __shfl_xor(v, o);
    return v;
}
__device__ __forceinline__ void p0_prologue(const Params& p, LAS unsigned char* lds, int vcu, int G) {
    const int lane = threadIdx.x & 63, wid = __builtin_amdgcn_readfirstlane(threadIdx.x >> 6);
    LAS float* scr = (LAS float*)(lds + wid * 16384);
    const int gw = vcu * 8 + wid, NGW = G * 8;
    constexpr int I1 = 16 * 104, IQ = 6 * 64, IKV = 4 * 64, IGL = 8 * 16, IOS = 8 * 32, IOM = 16 * 32, IOU = 16 * 32, IUP = 16 * 128, IDN = 64 * 32;
    constexpr int NITEMS = I1 + IQ + IKV + IGL + IOS + IOM + IOU + IUP + IDN;
    for (int it = gw; it < NITEMS; it += NGW) {
        int r = it;
        if (r < I1) { p0_item(p.in[3], 1024, 3264, p.in[2], p.W1t, 104, 1, scr, r, lane); continue; } r -= I1;
        if (r < IQ) { p0_item(p.in[6], 384, 1536, p.in[4], p.Wqt, 64, 2, scr, r, lane); continue; } r -= IQ;
        if (r < IKV) { p0_item(p.in[7], 256, 2048, p.in[5], p.Wkvt, 64, 0, scr, r, lane); continue; } r -= IKV;
        if (r < IGL) { p0_item(p.in[19], 512, 512, nullptr, p.Wglut, 16, 0, scr, r, lane); continue; } r -= IGL;
        if (r < IOS) { p0_item(p.in[21], 512, 1024, nullptr, p.Wost, 32, 0, scr, r, lane); continue; } r -= IOS;
        if (r < IOM) { p0_item(p.in[10], 1024, 1024, nullptr, p.Womt, 32, 0, scr, r, lane); continue; } r -= IOM;
        if (r < IOU) { p0_item(p.in[22], 1024, 1024, nullptr, p.Woutt, 32, 0, scr, r, lane); continue; } r -= IOU;
        if (r < IUP) { p0_item(p.in[24], 1024, 4096, p.in[23], p.Wupt, 128, 0, scr, r, lane); continue; } r -= IUP;
        p0_item(p.in[25], 4096, 1024, nullptr, p.Wdnt, 32, 0, scr, r, lane);
    }
    const int M = p.NB * TOK;
    for (int m0 = gw * 4; m0 < M; m0 += NGW * 4) {
        f32x4 v[4][4]; float s[4];
#pragma unroll
        for (int r = 0; r < 4; ++r) { const f32x4* xr = (const f32x4*)(p.x + (size_t)(m0 + r) * 1024) + lane;
#pragma unroll
            for (int jj = 0; jj < 4; ++jj) v[r][jj] = xr[64 * jj]; }
#pragma unroll
        for (int r = 0; r < 4; ++r) { s[r] = 0.f;
#pragma unroll
            for (int jj = 0; jj < 4; ++jj) s[r] += sq4(v[r][jj]);
            s[r] = wave_sum(s[r]);
            u32x2* o8 = (u32x2*)(p.XB + (size_t)(m0 + r) * 1024) + lane;
#pragma unroll
            for (int jj = 0; jj < 4; ++jj) o8[64 * jj] = (u32x2){cvt_pk_bf16(v[r][jj][0], v[r][jj][1]), cvt_pk_bf16(v[r][jj][2], v[r][jj][3])}; }
        if (lane < 4) { const int mm = m0 + lane; const float sv = lane == 0 ? s[0] : lane == 1 ? s[1] : lane == 2 ? s[2] : s[3];
            p.inv_x[mm] = rsqrtf(sv * (1.f / 1024.f) + 1e-6f); p.ssq_q[mm] = 0.f; p.ssq_kv[mm] = 0.f; p.ssq_kpe[mm] = 0.f; p.ssq_h[mm] = 0.f; }
        { const int mm = m0 + (lane >> 5) * 2, i = lane & 31;
#pragma unroll
          for (int r = 0; r < 2; ++r) { const float ang = (float)p.pos[mm + r] * p.inv_freq[i]; p.rcos[(size_t)(mm + r) * 32 + i] = cosf(ang); p.rsin[(size_t)(mm + r) * 32 + i] = sinf(ang); } }
    }
}

constexpr int LDS_RING = 131072, LDS_AUX = LDS_RING, LDS_BYTES = LDS_RING + 4096 + 256;
#ifndef MK_MODE
#define MK_MODE 0
#endif
namespace cg = cooperative_groups;
template <int K>
__device__ __forceinline__ void run_phase(const Params& p, LAS unsigned char* lds, LAS unsigned char* aux, int vcu, int G, int bx, int dry) {
    const int M = p.NB * TOK;
    if (K == 0) { p0_prologue(p, lds, vcu, G); __syncthreads(); }
    if (K == 1) {
        pg8::Gemm g{p.XB, 1024, p.W1t, 1024, M, 3328, 1024}; pg8::StaticOrder S; S.init(M, 3328, G, bx);
        EpiG1 E{p.inv_x, p.U, p.QL, p.CKV, p.kpe, p.SGS, p.SGM, p.ssq_q, p.ssq_kv, p.ssq_kpe, p.rcos, p.rsin, p.in[9], dry};
        pg8::gemm_phase(lds, aux, g, S, E);
    }
#ifndef MK_DUPSUB
#define MK_DUPSUB 7
#endif
#define SUBON(b) (!dry || (MK_DUPSUB & (b)))
    if (K == 2) {
        if (SUBON(4) && (vcu & 1)) { ssm::ssm_phase<false>(p, lds, vcu, G); __syncthreads(); }
        if (SUBON(1)) { pg8::Gemm g{p.QL, 384, p.Wqt, 384, M, 2048, 384}; pg8::StaticOrder S; S.init(M, 2048, G, bx);
          EpiQ E{p.ssq_q, p.rcos, p.rsin, p.in[8], p.Q}; pg8::gemm_phase(lds, aux, g, S, E); }
        if (SUBON(2)) { pg8::Gemm g{p.CKV, 256, p.Wkvt, 256, M, 2048, 256}; pg8::StaticOrder S; S.init(M, 2048, G, bx);
          EpiKV E{p.ssq_kv, p.ssq_kpe, p.in[9], p.kpe, p.K, p.V}; pg8::gemm_phase(lds, aux, g, S, E); }
        if (SUBON(4) && !(vcu & 1)) ssm::ssm_phase<false>(p, lds, vcu, G);
        __syncthreads();
    }
    if (K == 3) {
        if (SUBON(1)) att::attn_phase(p, lds, vcu, G);
        if (SUBON(2)) ssm::ssm_phase<true>(p, lds, vcu, G);
        __syncthreads();
    }
    if (K == 4) {
        pg8::Gemm g{p.Z, 512, p.Wglut, 512, M, 512, 512}; pg8::StaticOrder S; S.init(M, 512, G, bx);
        EpiGlu E{p.Z, p.in[20], p.Z2}; pg8::gemm_phase(lds, aux, g, S, E);
    }
    if (K == 5) {
        { pg8::Gemm g{p.Z2, 512, p.Wost, 512, M, 1024, 512}; pg8::StaticOrder S; S.init(M, 1024, G, bx);
          EpiMix<false> E{p.SGS, p.T1}; pg8::gemm_phase(lds, aux, g, S, E); }
        { pg8::Gemm g{p.ATT, 1024, p.Womt, 1024, M, 1024, 1024}; pg8::StaticOrder S; S.init(M, 1024, G, bx);
          EpiMix<true> E{p.SGM, p.T1}; pg8::gemm_phase(lds, aux, g, S, E); }
    }
    if (K == 6) {
        pg8::Gemm g{p.T1, 1024, p.Woutt, 1024, M, 1024, 1024}; pg8::StaticOrder S; S.init(M, 1024, G, bx);
        EpiOut E{p.x, p.out, p.HB, p.ssq_h, dry}; pg8::gemm_phase(lds, aux, g, S, E);
    }
    if (K == 7) {
        pg8::Gemm g{p.HB, 1024, p.Wupt, 1024, M, 4096, 1024}; pg8::StaticOrder S; S.init(M, 4096, G, bx);
        EpiUp E{p.ssq_h, p.HID}; pg8::gemm_phase(lds, aux, g, S, E);
    }
    if (K == 8) {
        pg8::Gemm g{p.HID, 4096, p.Wdnt, 4096, M, 1024, 4096}; pg8::StaticOrder S; S.init(M, 1024, G, bx);
        EpiDown E{p.HB, p.out, 1.f}; pg8::gemm_phase(lds, aux, g, S, E);
    }
}
__global__ void __launch_bounds__(512, 2) mk_kernel(Params p) {
    extern __shared__ __attribute__((aligned(16))) unsigned char lds_raw[];
    LAS unsigned char* lds = (LAS unsigned char*)lds_raw;
    LAS unsigned char* aux = lds + LDS_AUX;
    const int G = gridDim.x, bx = blockIdx.x;
    const int vcu = (G % 8 == 0) ? (bx % 8) * (G / 8) + bx / 8 : bx;
#ifndef MK_PHMASK
#define MK_PHMASK 0x1ff
#endif
#define IN(k) (((MK_PHMASK >> (k)) & 1) && p.ph_lo <= (k) && (k) < p.ph_hi)
#if MK_MODE == 0
#ifndef MK_CGSYNC
#define MK_CGSYNC 0
#endif
    volatile LAS unsigned* bst = (volatile LAS unsigned*)(lds + LDS_AUX + 4096);
    if (threadIdx.x < 2) bst[threadIdx.x] = 0u;
    __syncthreads();
    XcdBarrier xbar = xcd_barrier_post(p.ctl + 4096, bst);
    if (p.NB < 0) cg::this_grid().sync();
#ifndef MK_BAR
#define MK_BAR 2
#endif
    unsigned bar_epoch = 0;
#define SEAMX() do { if (MK_CGSYNC) cg::this_grid().sync(); else if (MK_BAR == 1) ctr_barrier(p.ctl + 1024, p.ctl + 1088, bar_epoch); else xcd_barrier(xbar); } while (0)
#define SEAM(k) do { if (IN(k) && IN((k) + 1)) SEAMX(); } while (0)
#else
#define SEAMX() do { } while (0)
#define SEAM(k) do { } while (0)
#endif
#ifndef MK_DUP
#define MK_DUP -1
#endif
#define PHASE(k) do { if (IN(k)) { run_phase<k>(p, lds, aux, vcu, G, bx, 0); if (MK_DUP == (k)) { SEAMX(); run_phase<k>(p, lds, aux, vcu, G, bx, 1); } } SEAM(k); } while (0)
    PHASE(0); PHASE(1); PHASE(2); PHASE(3); PHASE(4); PHASE(5); PHASE(6); PHASE(7); PHASE(8);
#ifdef MK_TPROBE
    SEAMX();
    if (blockIdx.x == 0 && threadIdx.x == 0) p.out[0] += 12.f * logf(((const float*)(p.ctl + 2048))[MK_TPROBE] * MK_TPROBE_SCALE);
#endif
#undef IN
#undef SEAM
}
constexpr int N_PHASES = 9;

static size_t al(size_t v) { return (v + 255) & ~(size_t)255; }
static Params make_params(void* const* d_in, float* out, unsigned char* ws, int NB, int b0, bool alias, unsigned char* gates) {
    Params p{};
    for (int i = 0; i < 26; ++i) p.in[i] = (const float*)d_in[i];
    p.out = out; p.NB = NB; p.ph_lo = 0; p.ph_hi = N_PHASES; p.pad = 0;
    p.x = (const float*)d_in[0] + (size_t)b0 * TOK * 1024; p.pos = (const int*)d_in[1] + (size_t)b0 * TOK;
    for (int i = 0; i < 32; ++i) p.inv_freq[i] = powf(10000.0f, -(float)i / 32.0f);
    const size_t M = (size_t)NB * TOK; size_t off = 0;
    auto take = [&](size_t bytes) { unsigned char* q = ws + off; off += al(bytes); return q; };
    p.ctl = (unsigned*)take(1 << 20);
    p.ssq_q = (float*)take(M * 4); p.ssq_kv = (float*)take(M * 4); p.ssq_kpe = (float*)take(M * 4); p.ssq_h = (float*)take(M * 4); p.inv_x = (float*)take(M * 4);
    p.sloc = (float*)take((size_t)NB * 32 * 16 * 128 * 4);
    p.rcos = (float*)take(M * 32 * 4); p.rsin = (float*)take(M * 32 * 4);
    p.kpe = (bf16_t*)take(M * 64 * 2);
    p.W1t = (bf16_t*)take((size_t)3328 * 1024 * 2); p.Wqt = (bf16_t*)take((size_t)2048 * 384 * 2); p.Wkvt = (bf16_t*)take((size_t)2048 * 256 * 2);
    p.Wglut = (bf16_t*)take((size_t)512 * 512 * 2); p.Wost = (bf16_t*)take((size_t)1024 * 512 * 2); p.Womt = (bf16_t*)take((size_t)1024 * 1024 * 2);
    p.Woutt = (bf16_t*)take((size_t)1024 * 1024 * 2); p.Wupt = (bf16_t*)take((size_t)4096 * 1024 * 2); p.Wdnt = (bf16_t*)take((size_t)1024 * 4096 * 2);
    if (alias) {
        unsigned char* rXB = take(M * 2048); unsigned char* rU = take(M * 1024); unsigned char* rQL = take(M * 1280); unsigned char* rQKV = take(M * 8192); unsigned char* rT1 = take(M * 2048);
        p.XB = (bf16_t*)rXB; p.ATT = (bf16_t*)rXB; p.HB = (bf16_t*)rXB;
        p.U = (bf16_t*)rU; p.Z2 = (bf16_t*)rU;
        p.QL = (bf16_t*)rQL; p.CKV = (bf16_t*)(rQL + M * 768); p.Z = (bf16_t*)rQL;
        p.Q = (bf16_t*)rQKV; p.K = (bf16_t*)(rQKV + M * 3072); p.V = (bf16_t*)(rQKV + M * 6144); p.HID = (bf16_t*)rQKV;
        p.T1 = (bf16_t*)rT1;
        p.SGS = (bf16_t*)out; p.SGM = (bf16_t*)((unsigned char*)out + M * 2048);
    } else {
        p.XB = (bf16_t*)take(M * 2048); p.ATT = (bf16_t*)take(M * 2048); p.HB = (bf16_t*)take(M * 2048);
        p.U = (bf16_t*)take(M * 1024); p.Z2 = (bf16_t*)take(M * 1024); p.Z = (bf16_t*)take(M * 1024);
        p.QL = (bf16_t*)take(M * 768); p.CKV = (bf16_t*)take(M * 512);
        p.Q = (bf16_t*)take(M * 3072); p.K = (bf16_t*)take(M * 3072); p.V = (bf16_t*)take(M * 2048); p.HID = (bf16_t*)take(M * 8192);
        p.T1 = (bf16_t*)take(M * 2048);
        p.SGS = (bf16_t*)gates; p.SGM = (bf16_t*)(gates + M * 2048);
    }
    return p;
}
static int g_grid = 0;
static int mk_grid() {
    if (g_grid == 0) {
        int dev = 0, cus = 0, per_cu = 0;
        hipGetDevice(&dev); hipDeviceGetAttribute(&cus, hipDeviceAttributeMultiprocessorCount, dev);
        hipFuncSetAttribute((const void*)mk_kernel, hipFuncAttributeMaxDynamicSharedMemorySize, LDS_BYTES);
        hipOccupancyMaxActiveBlocksPerMultiprocessor(&per_cu, (const void*)mk_kernel, 512, LDS_BYTES);
        (void)hipGetLastError();
        g_grid = (per_cu >= 1) ? cus : -1;
        if (g_grid < 0) fprintf(stderr, "mk: occupancy query reports %d blocks per CU\n", per_cu);
    }
    return g_grid;
}
static void mk_launch_phases(Params p, int lo, int hi, bool coop, hipStream_t stream) {
    const int grid = mk_grid(); if (grid <= 0) return;
    p.ph_lo = lo; p.ph_hi = hi;
    if (coop) { void* args[] = {&p}; hipError_t e = hipLaunchCooperativeKernel((const void*)mk_kernel, dim3(grid), dim3(512), args, LDS_BYTES, stream);
        if (e != hipSuccess) fprintf(stderr, "mk: cooperative launch failed: %s\n", hipGetErrorString(e)); }
    else hipLaunchKernelGGL(mk_kernel, dim3(grid), dim3(512), LDS_BYTES, stream, p);
}
#if MK_MODE == 2
struct NaiveBufs { float *XN, *PROJ, *QLN, *CKN, *QR, *KVR, *Qh, *Kh, *Vh, *S, *ATT, *Y, *Z, *G, *Z2, *YS, *YM, *MIX, *T, *H, *HN, *DN; };
static void naive_batch(void* const* d_in, int b, float* ob, const NaiveBufs& n, hipStream_t stream) {
    const float* x = (const float*)d_in[0]; const int* pos = (const int*)d_in[1];
    const float* norm_mix = (const float*)d_in[2]; const float* w_in = (const float*)d_in[3];
    const float* q_a_norm = (const float*)d_in[4]; const float* kv_a_norm = (const float*)d_in[5];
    const float* w_q_b = (const float*)d_in[6]; const float* w_kv_b = (const float*)d_in[7];
    const float* q_norm = (const float*)d_in[8]; const float* k_norm = (const float*)d_in[9];
    const float* w_o_mla = (const float*)d_in[10];
    const float* a_re = (const float*)d_in[11]; const float* a_im = (const float*)d_in[12]; const float* log_dt = (const float*)d_in[13];
    const float* b_re = (const float*)d_in[14]; const float* b_im = (const float*)d_in[15];
    const float* c_re = (const float*)d_in[16]; const float* c_im = (const float*)d_in[17]; const float* dsk = (const float*)d_in[18];
    const float* w_glu = (const float*)d_in[19]; const float* b_glu = (const float*)d_in[20]; const float* w_o_ssm = (const float*)d_in[21];
    const float* w_out = (const float*)d_in[22]; const float* norm_mlp = (const float*)d_in[23];
    const float* w_up = (const float*)d_in[24]; const float* w_down = (const float*)d_in[25];
    const int Mb = SEQ; const float scale = 1.0f / sqrtf(192.f);
    const float* xb = x + (size_t)b * Mb * 1024; const int* pb = pos + (size_t)b * Mb;
    k_rmsnorm<<<Mb, 256, 0, stream>>>(xb, 1024, norm_mix, n.XN, 1024, 1024);
    gemm(stream, n.XN, 1024, w_in, D_IN, n.PROJ, D_IN, Mb, D_IN, 1024, false, 0);
    k_rmsnorm<<<Mb, 256, 0, stream>>>(n.PROJ + OFF_QL, D_IN, q_a_norm, n.QLN, 384, 384);
    k_rmsnorm<<<Mb, 256, 0, stream>>>(n.PROJ + OFF_KV, D_IN, kv_a_norm, n.CKN, 256, 256);
    gemm(stream, n.QLN, 384, w_q_b, 1536, n.QR, 1536, Mb, 1536, 384, false, 0);
    gemm(stream, n.CKN, 256, w_kv_b, 2048, n.KVR, 2048, Mb, 2048, 256, false, 0);
    k_qkprep<<<dim3(Mb, NH), 192, 0, stream>>>(n.QR, n.KVR, n.PROJ, pb, q_norm, k_norm, n.Qh, n.Kh, n.Vh, Mb);
    for (int h = 0; h < NH; ++h) {
        gemm(stream, n.Qh + (size_t)h * Mb * 192, 192, n.Kh + (size_t)h * Mb * 192, 192, n.S, Mb, Mb, Mb, 192, true, 1);
        k_softmax<<<Mb, 256, 0, stream>>>(n.S, Mb, scale);
        gemm(stream, n.S, Mb, n.Vh + (size_t)h * Mb * 128, 128, n.ATT + h * 128, 1024, Mb, 128, Mb, false, 2);
    }
    k_ssm<<<SSM_G, 64, 0, stream>>>(n.PROJ, a_re, a_im, log_dt, b_re, b_im, c_re, c_im, dsk, n.Y, Mb);
    const size_t n512 = (size_t)Mb * 512, n1024 = (size_t)Mb * 1024, n4096 = (size_t)Mb * 4096;
    k_gelu<<<(unsigned)(n512 / 256), 256, 0, stream>>>(n.Y, n.Z, n512);
    gemm(stream, n.Z, 512, w_glu, 512, n.G, 512, Mb, 512, 512, false, 0);
    k_glu<<<(unsigned)(n512 / 256), 256, 0, stream>>>(n.Z, n.G, b_glu, n.Z2, n512);
    gemm(stream, n.Z2, 512, w_o_ssm, 1024, n.YS, 1024, Mb, 1024, 512, false, 0);
    gemm(stream, n.ATT, 1024, w_o_mla, 1024, n.YM, 1024, Mb, 1024, 1024, false, 0);
    k_mix<<<(unsigned)(n1024 / 256), 256, 0, stream>>>(n.PROJ, n.YS, n.YM, n.MIX, n1024);
    gemm(stream, n.MIX, 1024, w_out, 1024, n.T, 1024, Mb, 1024, 1024, false, 0);
    k_add<<<(unsigned)(n1024 / 256), 256, 0, stream>>>(xb, n.T, n.H, n1024);
    k_rmsnorm<<<Mb, 256, 0, stream>>>(n.H, 1024, norm_mlp, n.HN, 1024, 1024);
    gemm(stream, n.HN, 1024, w_up, 4096, n.S, 4096, Mb, 4096, 1024, false, 0);
    k_relu2<<<(unsigned)(n4096 / 256), 256, 0, stream>>>(n.S, n4096);
    gemm(stream, n.S, 4096, w_down, 1024, n.DN, 1024, Mb, 1024, 4096, false, 0);
    k_add<<<(unsigned)(n1024 / 256), 256, 0, stream>>>(n.H, n.DN, ob, n1024);
}
__device__ __forceinline__ float bfv(const bf16_t* p, size_t i) { return __uint_as_float((unsigned)p[i] << 16); }
__global__ void __launch_bounds__(256) k_check(int id, size_t n, Params p, NaiveBufs nb, const float* nout, const float* oout, float* res) {
    __shared__ float red[4];
    const int Mb = TOK; float sd = 0.f, sr = 0.f;
    for (size_t i = (size_t)blockIdx.x * 256 + threadIdx.x; i < n; i += (size_t)gridDim.x * 256) {
        float a = 0.f, r = 0.f;
        switch (id) {
            case 1: { const size_t rr = i / 512, c = i % 512; a = bfv(p.U, i); r = nb.PROJ[rr * D_IN + c]; } break;
            case 2: { const size_t rr = i / 384, c = i % 384; a = bfv(p.QL, i); r = nb.PROJ[rr * D_IN + 512 + c]; } break;
            case 3: { const size_t rr = i / 256, c = i % 256; a = bfv(p.CKV, i); r = nb.PROJ[rr * D_IN + 896 + c]; } break;
            case 4: { const size_t rr = i / 1024, c = i % 1024; a = bfv(p.SGS, i); r = sigmoidf_(nb.PROJ[rr * D_IN + OFF_GS + c]); } break;
            case 5: { const size_t rr = i / 1024, c = i % 1024; a = bfv(p.SGM, i); r = sigmoidf_(nb.PROJ[rr * D_IN + OFF_GM + c]); } break;
            case 6: case 7: { const size_t h = i / ((size_t)Mb * 192), l = (i / 192) % Mb, s = i % 192; const size_t d = s < 128 ? s : 128 + dperm((int)s - 128);
                if (id == 6) { a = bfv(p.Q, i); r = nb.Qh[(h * Mb + l) * 192 + d] * QSCALE; }
                else { a = bfv(p.K, ((h * 64 + l / 64) * 24 + s / 8) * 512 + (l % 64) * 8 + s % 8); r = nb.Kh[(h * Mb + l) * 192 + d]; } } break;
            case 8: { const size_t h = i / ((size_t)Mb * 128), l = (i / 128) % Mb, d = i % 128; a = bfv(p.V, ((h * 64 + l / 64) * 4 + d / 32) * 2048 + (l % 64) * 32 + d % 32); r = nb.Vh[(h * Mb + l) * 128 + d]; } break;
            case 9: a = bfv(p.ATT, i); r = nb.ATT[i]; break;
            case 10: a = bfv(p.Z, i); r = nb.Z[i]; break;
            case 11: a = bfv(p.Z2, i); r = nb.Z2[i]; break;
            case 12: a = bfv(p.T1, i); r = nb.MIX[i]; break;
            case 13: a = bfv(p.HB, i); r = nb.H[i]; break;
            case 14: a = bfv(p.HID, i); r = nb.S[i]; break;
            case 15: a = oout[i]; r = nout[i]; break;
        }
        const float d = a - r; sd += d * d; sr += r * r;
    }
    sd = block_sum256(sd, red); sr = block_sum256(sr, red);
    if (threadIdx.x == 0) { atomicAdd(res + 2 * id, sd); atomicAdd(res + 2 * id + 1, sr); }
}
__global__ void k_final(const float* res, float* out, int nchk, int first) {
    float code = 9900.f;
    for (int id = first; id <= nchk; ++id) { const float rvr = res[2 * id] / res[2 * id + 1];
        if (!(rvr < 2e-4f)) { const int sev = !(rvr < 0.1f) ? 0 : (rvr >= 1e-2f) ? 1 : (rvr >= 1e-3f) ? 2 : 3; code = 100.f * id + 10.f * sev; break; } }
    out[0] = code;
}
#ifndef MK_FIRST_CHECK
#define MK_FIRST_CHECK 1
#endif
extern "C" void kernel_launch(void* const* d_in, const int* in_sizes, int n_in, void* d_out, int out_size, void* d_ws, size_t ws_size, hipStream_t stream) {
    unsigned char* ws = (unsigned char*)d_ws; float* out = (float*)d_out;
    const size_t MiB = 1u << 20; const int Mb = TOK;
    float* w = (float*)(ws + 150 * MiB); size_t off = 0;
    auto take = [&](size_t n) { float* q = w + off; off += n; return q; };
    const size_t slot = (size_t)Mb * 1024;
    NaiveBufs n;
    n.PROJ = take((size_t)Mb * D_IN); n.Qh = take((size_t)Mb * 1536); n.Kh = take((size_t)Mb * 1536); n.Vh = take((size_t)Mb * 1024);
    n.S = take((size_t)Mb * 4096); n.Y = take((size_t)Mb * 512); n.Z = take((size_t)Mb * 512);
    n.G = take((size_t)Mb * 512); n.Z2 = take((size_t)Mb * 512);
    float* scratch = take((size_t)Mb * 5248);
    n.XN = scratch; n.QLN = scratch + (size_t)Mb * 1024; n.CKN = n.QLN + (size_t)Mb * 384; n.QR = n.CKN + (size_t)Mb * 256; n.KVR = n.QR + (size_t)Mb * 1536;
    n.YS = scratch; n.YM = scratch + (size_t)Mb * 1024; n.T = scratch + (size_t)Mb * 2048; n.HN = scratch + (size_t)Mb * 3072; n.DN = scratch + (size_t)Mb * 4096;
    float* res = take(64);
    float* out2 = out + slot; unsigned char* gates = (unsigned char*)(out + 2 * slot); n.ATT = out + 3 * slot; n.MIX = out + 4 * slot; n.H = out + 5 * slot;
    hipMemsetAsync(ws, 0, 1 << 20, stream); hipMemsetAsync(res, 0, 64 * 4, stream);
    hipMemsetAsync(out, 0, (size_t)out_size * 4, stream);
    naive_batch(d_in, 0, out, n, stream);
    Params p = make_params(d_in, out2, ws, 1, 0, false, gates);
    for (int ph = 0; ph < N_PHASES; ++ph) mk_launch_phases(p, ph, ph + 1, false, stream);
    const size_t cnt[16] = {0, (size_t)Mb * 512, (size_t)Mb * 384, (size_t)Mb * 256, (size_t)Mb * 1024, (size_t)Mb * 1024, (size_t)Mb * 1536, (size_t)Mb * 1536, (size_t)Mb * 1024,
                            (size_t)Mb * 1024, (size_t)Mb * 512, (size_t)Mb * 512, (size_t)Mb * 1024, (size_t)Mb * 1024, (size_t)Mb * 4096, (size_t)Mb * 1024};
    for (int id = 1; id <= 15; ++id) k_check<<<1024, 256, 0, stream>>>(id, cnt[id], p, n, out, out2, res);
    k_final<<<1, 1, 0, stream>>>(res, out, 15, MK_FIRST_CHECK);
}
#else
extern "C" void kernel_launch(void* const* d_in, const int* in_sizes, int n_in, void* d_out, int out_size, void* d_ws, size_t ws_size, hipStream_t stream) {
    Params p = make_params(d_in, (float*)d_out, (unsigned char*)d_ws, 8, 0, true, nullptr);
    hipMemsetAsync(d_ws, 0, 65536, stream);
#if MK_MODE == 0
    mk_launch_phases(p, 0, N_PHASES, true, stream);
#else
    for (int ph = 0; ph < N_PHASES; ++ph) mk_launch_phases(p, ph, ph + 1, false, stream);
#endif
}
#endif
```

```cpp
#include <hip/hip_runtime.h>
#include <hip/hip_cooperative_groups.h>
#include <cstdint>
#include <cstdio>
#include <cmath>
#define MK_MODE 0
#define MK_QFRAG 1
#define MK_ROPEFRAG 1
#define MK_UFRAG 1
#define MK_ATT_OSTAGE 1
#define MK_ATT_EARLY_DMA 1
#define MK_MIXPAIR 1
#define MK_DOWNPAIR 1
#define MK_GLUPAIR 1
#define MK_OUTPAIR 1
#define MK_XPAIR 1
#define MK_ZFRAG 1
#define MK_HIDSUB 1
#define MK_HBSUB 1
#define MK_T1SUB 1
#define MK_FIRST_CHECK 1
#define LAS __attribute__((address_space(3)))
#ifdef MK_ROPEFRAG
#define ROPE_IDX(row, i) ((size_t)((row) >> 5) * 1024 + (size_t)(((i) >> 2) * 128 + ((row) & 31) * 4 + ((i) & 3)))
#else
#define ROPE_IDX(row, i) ((size_t)(row) * 32 + (i))
#endif
typedef unsigned short bf16_t;
typedef short bf16x8 __attribute__((ext_vector_type(8)));
typedef short s16x4 __attribute__((ext_vector_type(4)));
typedef float f32x4 __attribute__((ext_vector_type(4)));
typedef float f32x16 __attribute__((ext_vector_type(16)));
typedef unsigned u32x4 __attribute__((ext_vector_type(4)));
typedef unsigned u32x2 __attribute__((ext_vector_type(2)));

constexpr int TOK = 4096;
constexpr float LOG2E = 1.4426950408889634f;
constexpr float QSCALE = 0.07216878364870322f * LOG2E;

struct Params {
    const float* in[26];
    float* out;
    unsigned* ctl;
    float *ssq_q, *ssq_kv, *ssq_kpe, *ssq_h, *inv_x;
    float* sloc;
    float *rcos, *rsin;
    bf16_t* kpe;
    bf16_t *W1t, *Wqt, *Wkvt, *Wglut, *Wost, *Womt, *Woutt, *Wupt, *Wdnt;
    bf16_t *XB, *U, *QL, *CKV, *Q, *K, *V, *ATT, *Z, *Z2, *T1, *HB, *HID, *SGS, *SGM;
    const float* x; const int* pos;
    int NB, ph_lo, ph_hi, pad;
    float inv_freq[32];
};

typedef float f32x2_t __attribute__((ext_vector_type(2))); typedef __bf16 bf16x2_t __attribute__((ext_vector_type(2)));
__device__ __forceinline__ unsigned cvt_pk_bf16(float lo, float hi) { f32x2_t v = {lo, hi}; bf16x2_t b = __builtin_convertvector(v, bf16x2_t); return __builtin_bit_cast(unsigned, b); }
__device__ __forceinline__ u32x4 pack8(const f32x4 a, const f32x4 b) { u32x4 w; w.x = cvt_pk_bf16(a[0], a[1]); w.y = cvt_pk_bf16(a[2], a[3]); w.z = cvt_pk_bf16(b[0], b[1]); w.w = cvt_pk_bf16(b[2], b[3]); return w; }
__device__ __forceinline__ float bf_lo(unsigned w) { return __uint_as_float(w << 16); }
__device__ __forceinline__ float bf_hi(unsigned w) { return __uint_as_float(w & 0xffff0000u); }
__device__ __forceinline__ void unpack8(const u32x4 w, f32x4& a, f32x4& b) { a = (f32x4){bf_lo(w.x), bf_hi(w.x), bf_lo(w.y), bf_hi(w.y)}; b = (f32x4){bf_lo(w.z), bf_hi(w.z), bf_lo(w.w), bf_hi(w.w)}; }
__device__ __forceinline__ float fast_sigmoid(float v) { return __builtin_amdgcn_rcpf(1.f + __builtin_amdgcn_exp2f(-v * LOG2E)); }
__device__ __forceinline__ float fast_tanh(float v) { const float e = __builtin_amdgcn_exp2f(-2.f * LOG2E * fabsf(v)); const float t = (1.f - e) * __builtin_amdgcn_rcpf(1.f + e); return v < 0.f ? -t : t; }
__device__ __forceinline__ float gelu_t(float x) { return 0.5f * x * (1.f + fast_tanh(0.7978845608028654f * (x + 0.044715f * x * x * x))); }
__host__ __device__ __forceinline__ int dperm(int s) { const int wc = s >> 5, fq = (s >> 3) & 3, n = (s >> 2) & 1, j = s & 3; return 32 * n + 16 * wc + 4 * fq + j; }

namespace pg8 {
constexpr int BM = 256, BK = 64, HALF = 128, HTB = HALF * BK * 2, STAGE_BYTES = 8 * HTB, NXCD = 8, WGM = 8;
__host__ __device__ __forceinline__ int lds_byte(int r, int c) { const int st = (r >> 4) * 2 + (c >> 5), rr = r & 15, cc = c & 31, ob = rr * 64 + cc * 2; return st * 1024 + (ob ^ (((ob >> 9) & 1) << 5)); }
__host__ __device__ __forceinline__ void stage_rc(int b, int& R, int& C) { const int st = b / 1024, sb = b % 1024, swz = sb ^ (((sb >> 9) & 1) << 5); R = (st >> 1) * 16 + swz / 64; C = (st & 1) * 32 + (swz % 64) / 2; }
__host__ __device__ __forceinline__ int perm32(int rho) { const int n = rho >> 4, i = rho & 15; return 8 * (i >> 2) + 4 * n + (i & 3); }
struct Unit { int pm, pn; };
struct Gemm { const bf16_t* A; int lda; const bf16_t* Bt; int ldb; int M, N, K; };
struct StaticOrder {
    int nM, nN, nwg, G, c;
    __device__ void init(int M, int N, int G_, int c_) { nM = M / BM; nN = N / BM; nwg = nM * nN; G = G_; c = c_; }
    __device__ bool next(int i, Unit& u) const {
        const long L = (long)i * G + c; if (L >= nwg) return false;
        int wgid = (int)L; { const int q = nwg / NXCD, r = nwg % NXCD, xcd = wgid % NXCD, off = wgid / NXCD; wgid = (xcd < r ? xcd * (q + 1) : r * (q + 1) + (xcd - r) * q) + off; }
        const int nig = WGM * nN, gid = wgid / nig, fm = gid * WGM, gsz = (nM - fm) < WGM ? (nM - fm) : WGM;
        u.pm = fm + ((wgid % nig) % gsz); u.pn = (wgid % nig) / gsz; return true;
    }
};
typedef f32x4 Acc[2][2][4][2];

template <class Epi>
__device__ __forceinline__ void gemm_phase(LAS unsigned char* lds, LAS unsigned char* aux, const Gemm g, const StaticOrder& S, const Epi& E, unsigned* gprobe = nullptr) {
    int tid = threadIdx.x; asm volatile("" : "+v"(tid));
    const int wid = __builtin_amdgcn_readfirstlane(tid >> 6), lane = tid & 63, wr = wid >> 2, wc = wid & 3, fr = lane & 15, fq = lane >> 4;
    const int K = g.K, nt = K / BK;
    unsigned voffA[2], voffB[2];
#pragma unroll
    for (int i = 0; i < 2; ++i) { int R, C; stage_rc(tid * 16 + i * 8192, R, C); const int Rb = (Epi::CM ? (R >> 5) * 64 : (R & ~31)) + perm32(R & 31);
        voffA[i] = (int)Epi::GA == 2 ? (unsigned)((((R >> 4) * (g.K >> 5) + (C >> 5)) * 512 + (R & 15) * 32 + (C & 31)) * 2)
                 : (int)Epi::GA == 1 ? (unsigned)(((C >> 4) * TOK * 16 + R * 16 + (C & 15)) * 2) : (unsigned)(R * g.lda + C) * 2u; voffB[i] = (unsigned)(Rb * g.ldb + C) * 2u; }
    const size_t kstep = (size_t)(BK * 2), kstepA = (int)Epi::GA == 2 ? (size_t)2048 : (int)Epi::GA == 1 ? (size_t)4 * TOK * 16 * 2 : (size_t)(BK * 2);
    const size_t hstepA = (int)Epi::GA == 2 ? (size_t)(HALF / 16) * (g.K >> 5) * 1024 : (int)Epi::GA == 1 ? (size_t)HALF * 16 * 2 : (size_t)HALF * g.lda * 2, hstepB = (size_t)(Epi::CM ? 32 : HALF) * g.ldb * 2;
    const size_t tstepA = 2 * hstepA, tstepB = (size_t)BM * g.ldb * 2;
#define PG8_ABASE(pm) ((const char*)g.A + ((int)Epi::GA == 1 ? ((size_t)((pm) >> 4) * 32 * TOK * 16 + (size_t)((pm) & 15) * 256 * 16) * 2 : (size_t)(pm) * tstepA))
    const unsigned ldsw = (unsigned)wid * 1024u;
    const int aoff = lds_byte(wr * 64 + fr, fq * 8), boff = lds_byte(wc * 32 + fr, fq * 8);
#define PG8_SA(b, h) (((b) * 2 + (h)) * HTB)
#define PG8_SB(b, h) ((4 + (b) * 2 + (h)) * HTB)
#define PG8_STAGE(bufoff, gbase, voff) do { _Pragma("unroll") for (int _i = 0; _i < 2; ++_i) \
        __builtin_amdgcn_global_load_lds((const unsigned*)((const char*)(gbase) + (voff)[_i]), (LAS unsigned*)(lds + (bufoff) + ldsw + _i * 8192), 16, 0, 0); } while (0)
#define PG8_LDA(dst, b, h) do { _Pragma("unroll") for (int m = 0; m < 4; ++m) _Pragma("unroll") for (int k = 0; k < 2; ++k) dst[m][k] = *(const LAS bf16x8*)(lds + PG8_SA(b, h) + aoff + m * 2048 + k * 1024); } while (0)
#define PG8_LDB(dst, b, h) do { _Pragma("unroll") for (int n = 0; n < 2; ++n) _Pragma("unroll") for (int k = 0; k < 2; ++k) dst[n][k] = *(const LAS bf16x8*)(lds + PG8_SB(b, h) + boff + n * 2048 + k * 1024); } while (0)
#define PG8_MMA(ai, bj, At, Bt) do { __builtin_amdgcn_s_setprio(1); _Pragma("unroll") for (int m = 0; m < 4; ++m) _Pragma("unroll") for (int n = 0; n < 2; ++n) _Pragma("unroll") for (int k = 0; k < 2; ++k) \
        acc[ai][bj][m][n] = __builtin_amdgcn_mfma_f32_16x16x32_bf16(Bt[n][k], At[m][k], acc[ai][bj][m][n], 0, 0, 0); __builtin_amdgcn_s_setprio(0); } while (0)
#define PG8_WAIT_V(n) asm volatile("s_waitcnt vmcnt(" #n ")" ::: "memory")
#define PG8_WAIT_VN(n) asm volatile("s_waitcnt vmcnt(%0)" :: "n"(n) : "memory")
#define PG8_WAIT_L(n) asm volatile("s_waitcnt lgkmcnt(" #n ")" ::: "memory")
#define PG8_BAR __builtin_amdgcn_s_barrier()
#define PG8_SCHED __builtin_amdgcn_sched_barrier(0)
    Unit cur, nxt; int ui = 0;
#ifdef MK_GPROBE
    unsigned long long gacc[4] = {0, 0, 0, 0};
    const unsigned long long gck0 = __builtin_amdgcn_s_memtime(), grt0 = __builtin_amdgcn_s_memrealtime();
#endif
    if (!S.next(0, cur)) return;
    Acc acc;
#pragma unroll
    for (int a = 0; a < 2; ++a)
#pragma unroll
        for (int b = 0; b < 2; ++b)
#pragma unroll
            for (int m = 0; m < 4; ++m)
#pragma unroll
                for (int n = 0; n < 2; ++n) acc[a][b][m][n] = (f32x4){0.f, 0.f, 0.f, 0.f};
    bf16x8 At[4][2], B0[2][2], B1[2][2];
    const char* cA = PG8_ABASE(cur.pm); const char* cB = (const char*)g.Bt + (size_t)cur.pn * tstepB;
    PG8_STAGE(PG8_SB(0, 0), cB, voffB); PG8_STAGE(PG8_SB(0, 1), cB + hstepB, voffB); PG8_STAGE(PG8_SA(0, 0), cA, voffA); PG8_STAGE(PG8_SA(0, 1), cA + hstepA, voffA);
    if (wr == 1) PG8_BAR;
    PG8_WAIT_V(2); PG8_BAR;
    PG8_STAGE(PG8_SB(1, 0), cB + kstep, voffB); PG8_STAGE(PG8_SA(1, 0), cA + kstepA, voffA); PG8_STAGE(PG8_SB(1, 1), cB + hstepB + kstep, voffB);
    PG8_WAIT_V(6); PG8_BAR;
    for (;;) {
        const bool has_next = S.next(ui + 1, nxt);
        const char* nA = has_next ? PG8_ABASE(nxt.pm) : cA; const char* nB = has_next ? (const char*)g.Bt + (size_t)nxt.pn * tstepB : cB;
#ifdef MK_GPROBE
        unsigned long long g_t0 = __builtin_amdgcn_s_memtime();
#endif
#pragma unroll 1
        for (int t = 0; t < nt; t += 2) {
#ifdef MK_GPROBE
            if (t == 2) { const unsigned long long n_ = __builtin_amdgcn_s_memtime(); gacc[0] += n_ - g_t0; g_t0 = n_; }
#endif
            const bool last = (t == nt - 2);
            const char* a1 = cA + (size_t)(t + 1) * kstepA;
            const char* a2 = last ? nA : cA + (size_t)(t + 2) * kstepA; const char* b2 = last ? nB : cB + (size_t)(t + 2) * kstep;
            const char* a3 = a2 + kstepA; const char* b3 = b2 + kstep;
            PG8_LDB(B0, 0, 0); PG8_LDB(B1, 0, 1); PG8_SCHED; PG8_LDA(At, 0, 0); PG8_STAGE(PG8_SA(1, 1), a1 + hstepA, voffA);
            if (t == 0 && ui > 0) PG8_WAIT_VN(8 + Epi::NVM); else PG8_WAIT_V(8);
            PG8_WAIT_L(0); PG8_BAR; PG8_MMA(0, 0, At, B0); PG8_MMA(0, 1, At, B1); PG8_BAR; PG8_SCHED;
            PG8_LDA(At, 0, 1); PG8_STAGE(PG8_SB(0, 0), b2, voffB); PG8_STAGE(PG8_SB(0, 1), b2 + hstepB, voffB); PG8_STAGE(PG8_SA(0, 0), a2, voffA);
            if (t == 0 && ui > 0) PG8_WAIT_VN(8 + Epi::NVM); else PG8_WAIT_V(8);
            PG8_WAIT_L(0); PG8_BAR; PG8_MMA(1, 0, At, B0); PG8_MMA(1, 1, At, B1); PG8_BAR; PG8_SCHED;
            PG8_LDB(B0, 1, 0); PG8_LDB(B1, 1, 1); PG8_SCHED; PG8_LDA(At, 1, 0); PG8_STAGE(PG8_SA(0, 1), a2 + hstepA, voffA);
            PG8_WAIT_V(8); PG8_WAIT_L(0); PG8_BAR; PG8_MMA(0, 0, At, B0); PG8_MMA(0, 1, At, B1); PG8_BAR; PG8_SCHED;
            PG8_LDA(At, 1, 1); PG8_STAGE(PG8_SB(1, 0), b3, voffB); PG8_STAGE(PG8_SB(1, 1), b3 + hstepB, voffB); PG8_STAGE(PG8_SA(1, 0), a3, voffA);
            PG8_WAIT_V(8); PG8_WAIT_L(0); PG8_BAR; PG8_MMA(1, 0, At, B0); PG8_MMA(1, 1, At, B1); PG8_BAR; PG8_SCHED;
        }
#ifdef MK_GPROBE
        { const unsigned long long n_ = __builtin_amdgcn_s_memtime(); gacc[1] += n_ - g_t0; g_t0 = n_; }
#endif
        if (wr == 0) PG8_BAR;
        E(acc, cur, wr, wc, fr, fq, aux, wid, lane);
#ifdef MK_GPROBE
        { const unsigned long long n_ = __builtin_amdgcn_s_memtime(); gacc[2] += n_ - g_t0; ++gacc[3]; }
#endif
        if (!has_next) break;
#pragma unroll
        for (int a = 0; a < 2; ++a)
#pragma unroll
            for (int b = 0; b < 2; ++b)
#pragma unroll
                for (int m = 0; m < 4; ++m)
#pragma unroll
                    for (int n = 0; n < 2; ++n) acc[a][b][m][n] = (f32x4){0.f, 0.f, 0.f, 0.f};
        cur = nxt; cA = nA; cB = nB; ++ui;
        if (wr == 1) PG8_BAR;
    }
    PG8_WAIT_V(0);
    PG8_BAR;
#ifdef MK_GPROBE
    if (g.N == MK_GPROBE_N && g.K == MK_GPROBE_K && blockIdx.x == 0 && tid == MK_GPROBE_TID) { float* tp = (float*)gprobe;
        tp[0] = (float)gacc[0] / (float)gacc[3]; tp[1] = (float)gacc[1] / (float)gacc[3]; tp[2] = (float)gacc[2] / (float)gacc[3];
        tp[3] = (float)(__builtin_amdgcn_s_memtime() - gck0) / (float)(__builtin_amdgcn_s_memrealtime() - grt0) * 100.f; tp[4] = (float)(__builtin_amdgcn_s_memrealtime() - grt0) * 0.01f; }
#endif
#undef PG8_ABASE
#undef PG8_SA
#undef PG8_SB
#undef PG8_STAGE
#undef PG8_LDA
#undef PG8_LDB
#undef PG8_MMA
#undef PG8_SCHED
}
}
using pg8::Acc; using pg8::Unit;

#define EPI_ARGS const Acc& acc, const Unit& u, int wr, int wc, int fr_, int fq_, LAS unsigned char* aux, int wid, int lane
#define EPI_OPAQUE int fr = fr_, fq = fq_; asm volatile("" : "+v"(fr), "+v"(fq));
#define ROWLOOP for (int ai = 0; ai < 2; ++ai) _Pragma("unroll") for (int m = 0; m < 4; ++m)

#ifndef MK_SWAP_REDUCE
__device__ __forceinline__ float fq_sum(float s) { s += __shfl_xor(s, 16); s += __shfl_xor(s, 32); return s; }
#else
__device__ __forceinline__ float fq_sum(float s) {
    { auto a = __builtin_amdgcn_permlane16_swap(__float_as_uint(s), __float_as_uint(s), false, false); s = __uint_as_float(a[0]) + __uint_as_float(a[1]); }
    { auto b = __builtin_amdgcn_permlane32_swap(__float_as_uint(s), __float_as_uint(s), false, false); s = __uint_as_float(b[0]) + __uint_as_float(b[1]); }
    return s; }
#endif
__device__ __forceinline__ float sq4(const f32x4 v) { return (v[0] * v[0] + v[1] * v[1]) + (v[2] * v[2] + v[3] * v[3]); }

struct EpiG1 {
    static constexpr bool GA = false, CM = false; static constexpr int NVM = 0;
    bf16_t *U, *QL, *CKV, *KPE, *SGS, *SGM; float *ssq_q, *ssq_kv, *ssq_kpe; const float *rcos, *rsin; const float* k_norm; int dry;
    __device__ __forceinline__ void operator()(EPI_ARGS) const {
        EPI_OPAQUE
        const int pn = u.pn, cw = wc * 32 + 8 * fq;
#pragma unroll
        ROWLOOP {
            const int row = u.pm * 256 + ai * 128 + wr * 64 + m * 16 + fr;
            f32x4 v[2][2];
#pragma unroll
            for (int bj = 0; bj < 2; ++bj)
#pragma unroll
                for (int n = 0; n < 2; ++n) v[bj][n] = acc[ai][bj][m][n];
            if (pn < 2) {
#pragma unroll
#ifdef MK_UFRAG
                for (int bj = 0; bj < 2; ++bj) { const int c = pn * 256 + bj * 128 + cw, bb = row / TOK, l = row % TOK;
                    *(u32x4*)(U + ((size_t)(bb * 32 + (c >> 4)) * TOK + l) * 16 + (c & 15)) = pack8(v[bj][0], v[bj][1]); }
#else
                for (int bj = 0; bj < 2; ++bj) *(u32x4*)(U + (size_t)row * 512 + pn * 256 + bj * 128 + cw) = pack8(v[bj][0], v[bj][1]);
#endif
            } else if (pn == 2) {
#pragma unroll
                for (int bj = 0; bj < 2; ++bj) *(u32x4*)(QL + (size_t)row * 384 + bj * 128 + cw) = pack8(v[bj][0], v[bj][1]);
                const float q = fq_sum(sq4(v[0][0]) + sq4(v[0][1]) + sq4(v[1][0]) + sq4(v[1][1]));
                if (fq == 0 && !dry) atomicAdd(ssq_q + row, q);
            } else if (pn == 3) {
                *(u32x4*)(QL + (size_t)row * 384 + 256 + cw) = pack8(v[0][0], v[0][1]);
                *(u32x4*)(CKV + (size_t)row * 256 + cw) = pack8(v[1][0], v[1][1]);
                const float q = fq_sum(sq4(v[0][0]) + sq4(v[0][1])), k = fq_sum(sq4(v[1][0]) + sq4(v[1][1]));
                if (fq == 0 && !dry) { atomicAdd(ssq_q + row, q); atomicAdd(ssq_kv + row, k); }
            } else if (pn == 4) {
                *(u32x4*)(CKV + (size_t)row * 256 + 128 + cw) = pack8(v[0][0], v[0][1]);
                const float k = fq_sum(sq4(v[0][0]) + sq4(v[0][1]));
                if (fq == 0 && !dry) atomicAdd(ssq_kv + row, k);
                if (wc < 2) {
                    const int i0 = 16 * wc + 4 * fq;
                    const f32x4 c = *(const f32x4*)(rcos + ROPE_IDX(row, i0)), sn = *(const f32x4*)(rsin + ROPE_IDX(row, i0));
                    const f32x4 g1 = *(const f32x4*)(k_norm + 128 + i0), g2 = *(const f32x4*)(k_norm + 160 + i0);
                    const f32x4 x1 = v[1][0] * g1, x2 = v[1][1] * g2;
                    const f32x4 r1 = x1 * c - x2 * sn, r2 = x2 * c + x1 * sn;
                    *(u32x4*)(KPE + (size_t)row * 64 + cw) = pack8(r1, r2);
                    const float p = fq_sum(sq4(v[1][0]) + sq4(v[1][1]));
                    if (fq == 0 && !dry) atomicAdd(ssq_kpe + row, p);
                }
            } else {
                bf16_t* G = (pn < 9) ? SGS : SGM; const int c0 = ((pn < 9) ? (pn - 5) : (pn - 9)) * 256;
#pragma unroll
                for (int bj = 0; bj < 2; ++bj) { f32x4 a, b;
#pragma unroll
                    for (int j = 0; j < 4; ++j) { a[j] = fast_sigmoid(v[bj][0][j]); b[j] = fast_sigmoid(v[bj][1][j]); }
                    *(u32x4*)(G + (size_t)row * 1024 + c0 + bj * 128 + cw) = pack8(a, b); }
            }
        }
    }
};

__device__ __forceinline__ void row_reduce4(const float (&part)[2][4], float (&tot)[2][4], int wr, int wc, int fr, int fq, LAS unsigned char* aux) {
    LAS float* red = (LAS float*)aux;
#pragma unroll
    ROWLOOP { const float s = fq_sum(part[ai][m]); if (fq == 0) red[(ai * 128 + wr * 64 + m * 16 + fr) * 4 + wc] = s; }
    asm volatile("s_waitcnt lgkmcnt(0)" ::: "memory"); __builtin_amdgcn_s_barrier(); asm volatile("" ::: "memory");
#pragma unroll
    ROWLOOP { const f32x4 t = *(const LAS f32x4*)(red + (ai * 128 + wr * 64 + m * 16 + fr) * 4); tot[ai][m] = (t[0] + t[1]) + (t[2] + t[3]); }
    asm volatile("s_waitcnt lgkmcnt(0)" ::: "memory"); __builtin_amdgcn_s_barrier(); asm volatile("" ::: "memory");
}

__device__ __forceinline__ void row_reduce4h(const float (&part)[4], float (&tot)[4], int ai, int wr, int wc, int fr, int fq, LAS unsigned char* aux) {
    LAS float* red = (LAS float*)aux;
#pragma unroll
    for (int m = 0; m < 4; ++m) { const float s = fq_sum(part[m]); if (fq == 0) red[(ai * 128 + wr * 64 + m * 16 + fr) * 4 + wc] = s; }
    asm volatile("s_waitcnt lgkmcnt(0)" ::: "memory"); __builtin_amdgcn_s_barrier(); asm volatile("" ::: "memory");
#pragma unroll
    for (int m = 0; m < 4; ++m) { const f32x4 t = *(const LAS f32x4*)(red + (ai * 128 + wr * 64 + m * 16 + fr) * 4); tot[m] = (t[0] + t[1]) + (t[2] + t[3]); }
    asm volatile("s_waitcnt lgkmcnt(0)" ::: "memory"); __builtin_amdgcn_s_barrier(); asm volatile("" ::: "memory");
}
struct EpiQ {
    static constexpr bool GA = false, CM = false; static constexpr int NVM = 0;
    const float* ssq_q; const float *rcos, *rsin; const float* q_norm; bf16_t* Q;
    __device__ __forceinline__ void operator()(EPI_ARGS) const {
        EPI_OPAQUE
        const int h = u.pn, cw = wc * 32 + 8 * fq;
        float part[2][4], tot[2][4], rs[2][4];
#pragma unroll
        ROWLOOP { const int row = u.pm * 256 + ai * 128 + wr * 64 + m * 16 + fr; const float s = __builtin_amdgcn_rsqf(ssq_q[row] * (1.f / 384.f) + 1e-6f); rs[ai][m] = s;
            part[ai][m] = (sq4(acc[ai][0][m][0]) + sq4(acc[ai][0][m][1]) + sq4(acc[ai][1][m][0]) + sq4(acc[ai][1][m][1])) * s * s; }
        row_reduce4(part, tot, wr, wc, fr, fq, aux);
        const f32x4 g0 = *(const f32x4*)(q_norm + cw), g1 = *(const f32x4*)(q_norm + cw + 4);
        const int i0 = 16 * (wc & 1) + 4 * fq;
        const f32x4 gr1 = *(const f32x4*)(q_norm + 128 + i0), gr2 = *(const f32x4*)(q_norm + 160 + i0);
#pragma unroll
        ROWLOOP { const int row = u.pm * 256 + ai * 128 + wr * 64 + m * 16 + fr;
            const float f = rs[ai][m] * __builtin_amdgcn_rsqf(tot[ai][m] * (1.f / 192.f) + 1e-6f) * QSCALE;
            const int b = row / TOK, l = row % TOK;
#ifdef MK_QFRAG
            bf16_t* qblk = Q + ((size_t)(b * 8 + h) * TOK + (l & ~31)) * 192 + (l & 31) * 16 + (fq & 1) * 8;
            *(u32x4*)(qblk + (2 * wc + (fq >> 1)) * 512) = pack8(acc[ai][0][m][0] * f * g0, acc[ai][0][m][1] * f * g1);
            if (wc < 2) *(u32x4*)(qblk + (8 + 2 * wc + (fq >> 1)) * 512) = pack8(acc[ai][1][m][0] * f * gr1, acc[ai][1][m][1] * f * gr2);
#else
            bf16_t* qrow = Q + ((size_t)(b * 8 + h) * TOK + l) * 192;
            *(u32x4*)(qrow + cw) = pack8(acc[ai][0][m][0] * f * g0, acc[ai][0][m][1] * f * g1);
            if (wc < 2) *(u32x4*)(qrow + 128 + cw) = pack8(acc[ai][1][m][0] * f * gr1, acc[ai][1][m][1] * f * gr2);
#endif
        }
    }
};

struct EpiKV {
    static constexpr bool GA = false, CM = false; static constexpr int NVM = 0;
    const float *ssq_kv, *ssq_kpe; const float* k_norm; const bf16_t* KPE; bf16_t *K, *V;
    __device__ __forceinline__ void operator()(EPI_ARGS) const {
        EPI_OPAQUE
        const int h = u.pn, cw = wc * 32 + 8 * fq;
        float part[2][4], tot[2][4], rs[2][4], skpe[2][4];
#pragma unroll
        ROWLOOP { const int row = u.pm * 256 + ai * 128 + wr * 64 + m * 16 + fr; const float s = __builtin_amdgcn_rsqf(ssq_kv[row] * (1.f / 256.f) + 1e-6f); rs[ai][m] = s;
            skpe[ai][m] = ssq_kpe[row];
            part[ai][m] = (sq4(acc[ai][0][m][0]) + sq4(acc[ai][0][m][1])) * s * s; }
        row_reduce4(part, tot, wr, wc, fr, fq, aux);
        const f32x4 g0 = *(const f32x4*)(k_norm + cw), g1 = *(const f32x4*)(k_norm + cw + 4);
#pragma unroll
        for (int ai = 0; ai < 2; ++ai) {
            u32x4 kp[4];
            if (wc < 2) {
#pragma unroll
                for (int m = 0; m < 4; ++m) kp[m] = *(const u32x4*)(KPE + (size_t)(u.pm * 256 + ai * 128 + wr * 64 + m * 16 + fr) * 64 + cw); }
#pragma unroll
            for (int m = 0; m < 4; ++m) { const int row = u.pm * 256 + ai * 128 + wr * 64 + m * 16 + fr;
                const float ik = __builtin_amdgcn_rsqf((tot[ai][m] + skpe[ai][m]) * (1.f / 192.f) + 1e-6f), f = rs[ai][m] * ik;
                const int b = row / TOK, l = row % TOK; const size_t tl = (size_t)(b * 8 + h) * 64 + (l >> 6); const int kv = l & 63;
                bf16_t* kt = K + tl * 12288 + kv * 8;
                *(u32x4*)(kt + (4 * wc + fq) * 512) = pack8(acc[ai][0][m][0] * f * g0, acc[ai][0][m][1] * f * g1);
                if (wc < 2) { f32x4 a, cc; unpack8(kp[m], a, cc);
                    *(u32x4*)(kt + (16 + 4 * wc + fq) * 512) = pack8(a * ik, cc * ik); }
                *(u32x4*)(V + tl * 8192 + wc * 2048 + kv * 32 + fq * 8) = pack8(acc[ai][1][m][0] * rs[ai][m], acc[ai][1][m][1] * rs[ai][m]);
            }
            asm volatile("" ::: "memory");
        }
    }
};

#ifdef MK_MIXPAIR
__device__ __forceinline__ u32x4 xor1(u32x4 v);
__device__ __forceinline__ void load_pair_lines(const bf16_t* base, size_t ld, int row, int col0, int fr, u32x4& w0, u32x4& w1);
__device__ __forceinline__ void store_pair_lines(bf16_t* base, size_t ld, int row, int col0, int fr, u32x4 w0, u32x4 w1);
#endif
#if defined(MK_MIXPAIR) && defined(MK_GLUPAIR)
struct EpiGlu {
#ifdef MK_ZFRAG
    static constexpr bool GA = true, CM = true; static constexpr int NVM = 0;
#else
    static constexpr bool GA = false, CM = true; static constexpr int NVM = 0;
#endif
    const bf16_t* Z; const float* bias; bf16_t* Z2;
    __device__ __forceinline__ void operator()(EPI_ARGS) const {
        EPI_OPAQUE
        const int col0 = u.pn * 256 + wc * 64 + 8 * fq;
        f32x4 bb[2][2];
#pragma unroll
        for (int bj = 0; bj < 2; ++bj) { bb[bj][0] = *(const f32x4*)(bias + col0 + bj * 32); bb[bj][1] = *(const f32x4*)(bias + col0 + bj * 32 + 4); }
#pragma unroll
        for (int ai = 0; ai < 2; ++ai) {
            u32x4 zz[2][4];
#pragma unroll
#ifdef MK_ZFRAG
            for (int m = 0; m < 4; ++m) { const int row = u.pm * 256 + ai * 128 + wr * 64 + m * 16 + fr, bb_ = row / TOK, l = row % TOK;
#pragma unroll
                for (int bj = 0; bj < 2; ++bj) { const int c = col0 + bj * 32; zz[bj][m] = *(const u32x4*)(Z + ((size_t)(bb_ * 32 + (c >> 4)) * TOK + l) * 16 + (c & 15)); } }
#else
            for (int m = 0; m < 4; ++m) load_pair_lines(Z, 512, u.pm * 256 + ai * 128 + wr * 64 + m * 16 + fr, col0, fr, zz[0][m], zz[1][m]);
#endif
#pragma unroll
            for (int m = 0; m < 4; ++m) { const int row = u.pm * 256 + ai * 128 + wr * 64 + m * 16 + fr; u32x4 w[2];
#pragma unroll
                for (int bj = 0; bj < 2; ++bj) { f32x4 z0, z1; unpack8(zz[bj][m], z0, z1); f32x4 o0, o1;
#pragma unroll
                    for (int j = 0; j < 4; ++j) { o0[j] = z0[j] * fast_sigmoid(acc[ai][bj][m][0][j] + bb[bj][0][j]); o1[j] = z1[j] * fast_sigmoid(acc[ai][bj][m][1][j] + bb[bj][1][j]); }
                    w[bj] = pack8(o0, o1); }
#ifdef MK_T1SUB
#pragma unroll
                for (int bj = 0; bj < 2; ++bj) *(u32x4*)(Z2 + ((size_t)(row >> 4) * 16 + (u.pn * 8 + wc * 2 + bj)) * 512 + (row & 15) * 32 + 8 * fq) = w[bj]; }
#else
                store_pair_lines(Z2, 512, row, col0, fr, w[0], w[1]); }
#endif
            asm volatile("" ::: "memory");
        }
    }
};
#else
struct EpiGlu {
    static constexpr bool GA = false, CM = false; static constexpr int NVM = 0;
    const bf16_t* Z; const float* bias; bf16_t* Z2;
    __device__ __forceinline__ void operator()(EPI_ARGS) const {
        EPI_OPAQUE
        u32x4 zz[2][2][4];
#pragma unroll
        for (int bj = 0; bj < 2; ++bj) { const int col = u.pn * 256 + bj * 128 + wc * 32 + 8 * fq;
#pragma unroll
            ROWLOOP zz[bj][ai][m] = *(const u32x4*)(Z + (size_t)(u.pm * 256 + ai * 128 + wr * 64 + m * 16 + fr) * 512 + col); }
#pragma unroll
        for (int bj = 0; bj < 2; ++bj) { const int col = u.pn * 256 + bj * 128 + wc * 32 + 8 * fq;
            const f32x4 b0 = *(const f32x4*)(bias + col), b1 = *(const f32x4*)(bias + col + 4);
#pragma unroll
            ROWLOOP { const int row = u.pm * 256 + ai * 128 + wr * 64 + m * 16 + fr;
                f32x4 z0, z1; unpack8(zz[bj][ai][m], z0, z1);
                f32x4 o0, o1;
#pragma unroll
                for (int j = 0; j < 4; ++j) { o0[j] = z0[j] * fast_sigmoid(acc[ai][bj][m][0][j] + b0[j]); o1[j] = z1[j] * fast_sigmoid(acc[ai][bj][m][1][j] + b1[j]); }
                *(u32x4*)(Z2 + (size_t)row * 512 + col) = pack8(o0, o1); }
        }
    }
};
#endif
#ifdef MK_MIXPAIR
template <bool SECOND> struct EpiMix {
#ifdef MK_T1SUB
    static constexpr int GA = SECOND ? 0 : 2; static constexpr bool CM = true; static constexpr int NVM = 0;
#else
    static constexpr bool GA = false, CM = true; static constexpr int NVM = 0;
#endif
    const bf16_t* SG; bf16_t* T1;
    __device__ __forceinline__ void operator()(EPI_ARGS) const {
        EPI_OPAQUE
        const int col0 = u.pn * 256 + wc * 64 + 8 * fq;
#pragma unroll
        for (int ai = 0; ai < 2; ++ai) {
            u32x4 sg[2][4], tt[2][4];
#pragma unroll
            for (int m = 0; m < 4; ++m) { const int row = u.pm * 256 + ai * 128 + wr * 64 + m * 16 + fr;
                load_pair_lines(SG, 1024, row, col0, fr, sg[0][m], sg[1][m]);
#ifdef MK_T1SUB
                if (SECOND) { _Pragma("unroll") for (int bj = 0; bj < 2; ++bj) tt[bj][m] = *(const u32x4*)(T1 + ((size_t)(row >> 4) * 32 + (u.pn * 8 + wc * 2 + bj)) * 512 + (row & 15) * 32 + 8 * fq); }
#else
                if (SECOND) load_pair_lines(T1, 1024, row, col0, fr, tt[0][m], tt[1][m]);
#endif
            }
#pragma unroll
            for (int m = 0; m < 4; ++m) { const int row = u.pm * 256 + ai * 128 + wr * 64 + m * 16 + fr;
                u32x4 w[2];
#pragma unroll
                for (int bj = 0; bj < 2; ++bj) { f32x4 s0, s1; unpack8(sg[bj][m], s0, s1);
                    f32x4 r0 = s0 * acc[ai][bj][m][0], r1 = s1 * acc[ai][bj][m][1];
                    if (SECOND) { f32x4 t0, t1; unpack8(tt[bj][m], t0, t1); r0 += t0; r1 += t1; }
                    w[bj] = pack8(r0, r1); }
#ifdef MK_T1SUB
#pragma unroll
                for (int bj = 0; bj < 2; ++bj) *(u32x4*)(T1 + ((size_t)(row >> 4) * 32 + (u.pn * 8 + wc * 2 + bj)) * 512 + (row & 15) * 32 + 8 * fq) = w[bj]; }
#else
                store_pair_lines(T1, 1024, row, col0, fr, w[0], w[1]); }
#endif
            asm volatile("" ::: "memory");
        }
    }
};
#else
template <bool SECOND> struct EpiMix {
    static constexpr bool GA = false, CM = false; static constexpr int NVM = 0;
    const bf16_t* SG; bf16_t* T1;
    __device__ __forceinline__ void operator()(EPI_ARGS) const {
        EPI_OPAQUE
#pragma unroll
        for (int ai = 0; ai < 2; ++ai) {
            u32x4 sg[2][4], tt[2][4];
#pragma unroll
            for (int bj = 0; bj < 2; ++bj)
#pragma unroll
                for (int m = 0; m < 4; ++m) { const size_t o = (size_t)(u.pm * 256 + ai * 128 + wr * 64 + m * 16 + fr) * 1024 + u.pn * 256 + bj * 128 + wc * 32 + 8 * fq;
                    sg[bj][m] = *(const u32x4*)(SG + o); if (SECOND) tt[bj][m] = *(const u32x4*)(T1 + o); }
#pragma unroll
            for (int bj = 0; bj < 2; ++bj)
#pragma unroll
                for (int m = 0; m < 4; ++m) { const size_t o = (size_t)(u.pm * 256 + ai * 128 + wr * 64 + m * 16 + fr) * 1024 + u.pn * 256 + bj * 128 + wc * 32 + 8 * fq;
                    f32x4 s0, s1; unpack8(sg[bj][m], s0, s1);
                    f32x4 r0 = s0 * acc[ai][bj][m][0], r1 = s1 * acc[ai][bj][m][1];
                    if (SECOND) { f32x4 t0, t1; unpack8(tt[bj][m], t0, t1); r0 += t0; r1 += t1; }
                    *(u32x4*)(T1 + o) = pack8(r0, r1); }
            asm volatile("" ::: "memory");
        }
    }
};
#endif
#if defined(MK_MIXPAIR) && defined(MK_OUTPAIR)
struct EpiOut {
#ifdef MK_T1SUB
    static constexpr int GA = 2; static constexpr bool CM = true; static constexpr int NVM = 0;
#else
    static constexpr bool GA = false, CM = true; static constexpr int NVM = 0;
#endif
    const float* x; float* out; bf16_t* HB; float* ssq_h; int dry;
    __device__ __forceinline__ void operator()(EPI_ARGS) const {
        EPI_OPAQUE
        const int col0 = u.pn * 256 + wc * 64 + 8 * fq;
#ifdef MK_XPAIR
        constexpr int MB = 2;
#else
        constexpr int MB = 4;
#endif
#pragma unroll
        for (int ai = 0; ai < 2; ++ai)
#pragma unroll
          for (int m0 = 0; m0 < 4; m0 += MB) {
            f32x4 xv[MB][2][2];
#pragma unroll
            for (int mi = 0; mi < MB; ++mi)
#pragma unroll
                for (int bj = 0; bj < 2; ++bj) { const int row = u.pm * 256 + ai * 128 + wr * 64 + (m0 + mi) * 16 + fr;
#ifdef MK_XPAIR
                    const bool even = (fr & 1) == 0;
                    const float* px = x + (size_t)(row - (fr & 1)) * 1024 + col0 + bj * 32 + (even ? 0 : 4);
                    const f32x4 a = *(const f32x4*)px, b2 = *(const f32x4*)(px + 1024);
                    const f32x4 r = __builtin_bit_cast(f32x4, xor1(__builtin_bit_cast(u32x4, even ? b2 : a)));
                    xv[mi][bj][0] = even ? a : r; xv[mi][bj][1] = even ? r : b2;
#else
                    const size_t o = (size_t)row * 1024 + col0 + bj * 32;
                    xv[mi][bj][0] = *(const f32x4*)(x + o); xv[mi][bj][1] = *(const f32x4*)(x + o + 4);
#endif
                }
#pragma unroll
            for (int mi = 0; mi < MB; ++mi) { const int m = m0 + mi; const int row = u.pm * 256 + ai * 128 + wr * 64 + m * 16 + fr; float q = 0.f; u32x4 w[2];
#pragma unroll
                for (int bj = 0; bj < 2; ++bj) { const f32x4 h0 = xv[mi][bj][0] + acc[ai][bj][m][0], h1 = xv[mi][bj][1] + acc[ai][bj][m][1];
                    w[bj] = pack8(h0, h1); q += sq4(h0) + sq4(h1); }
#ifdef MK_HBSUB
#pragma unroll
                for (int bj = 0; bj < 2; ++bj) *(u32x4*)(HB + ((size_t)(row >> 4) * 32 + (u.pn * 8 + wc * 2 + bj)) * 512 + (row & 15) * 32 + 8 * fq) = w[bj];
#else
                store_pair_lines(HB, 1024, row, col0, fr, w[0], w[1]);
#endif
                q = fq_sum(q); if (fq == 0 && !dry) atomicAdd(ssq_h + row, q); }
            asm volatile("" ::: "memory");
          }
    }
};
#else
struct EpiOut {
    static constexpr bool GA = false, CM = false; static constexpr int NVM = 0;
    const float* x; float* out; bf16_t* HB; float* ssq_h; int dry;
    __device__ __forceinline__ void operator()(EPI_ARGS) const {
        EPI_OPAQUE
#pragma unroll
        for (int ai = 0; ai < 2; ++ai) {
            f32x4 xv[4][2][2];
#pragma unroll
            for (int m = 0; m < 4; ++m)
#pragma unroll
                for (int bj = 0; bj < 2; ++bj) { const size_t o = (size_t)(u.pm * 256 + ai * 128 + wr * 64 + m * 16 + fr) * 1024 + u.pn * 256 + bj * 128 + wc * 32 + 8 * fq;
                    xv[m][bj][0] = *(const f32x4*)(x + o); xv[m][bj][1] = *(const f32x4*)(x + o + 4); }
#pragma unroll
            for (int m = 0; m < 4; ++m) { const int row = u.pm * 256 + ai * 128 + wr * 64 + m * 16 + fr; float q = 0.f;
#pragma unroll
                for (int bj = 0; bj < 2; ++bj) { const size_t o = (size_t)row * 1024 + u.pn * 256 + bj * 128 + wc * 32 + 8 * fq;
                    const f32x4 h0 = xv[m][bj][0] + acc[ai][bj][m][0], h1 = xv[m][bj][1] + acc[ai][bj][m][1];
                    *(u32x4*)(HB + o) = pack8(h0, h1); q += sq4(h0) + sq4(h1); }
                q = fq_sum(q); if (fq == 0 && !dry) atomicAdd(ssq_h + row, q); }
            asm volatile("" ::: "memory");
        }
    }
};
#endif
__device__ __forceinline__ unsigned xor1(unsigned v) { return (unsigned)__builtin_amdgcn_mov_dpp((int)v, 0xB1, 0xF, 0xF, true); }
__device__ __forceinline__ u32x4 xor1(u32x4 v) { return (u32x4){xor1(v.x), xor1(v.y), xor1(v.z), xor1(v.w)}; }
__device__ __forceinline__ void store_pair_lines(bf16_t* base, size_t ld, int row, int col0, int fr, u32x4 w0, u32x4 w1) {
    const bool even = (fr & 1) == 0;
    const u32x4 r = xor1(even ? w1 : w0);
    bf16_t* p = base + (size_t)(row - (fr & 1)) * ld + col0 + (even ? 0 : 32);
    *(u32x4*)p = even ? w0 : r;
    *(u32x4*)(p + ld) = even ? r : w1;
}
#ifdef MK_MIXPAIR
__device__ __forceinline__ void load_pair_lines(const bf16_t* base, size_t ld, int row, int col0, int fr, u32x4& w0, u32x4& w1) {
    const bool even = (fr & 1) == 0;
    const bf16_t* p = base + (size_t)(row - (fr & 1)) * ld + col0 + (even ? 0 : 32);
    const u32x4 a = *(const u32x4*)p, b = *(const u32x4*)(p + ld);
    const u32x4 r = xor1(even ? b : a);
    w0 = even ? a : r; w1 = even ? r : b;
}
#endif
struct EpiUp {

#ifdef MK_HBSUB
    static constexpr int GA = 2; static constexpr bool CM = true;
#else
    static constexpr bool GA = false, CM = true;
#endif
    static constexpr int NVM = 0;
    bf16_t* HID;
    __device__ __forceinline__ void operator()(EPI_ARGS) const {
        EPI_OPAQUE
#pragma unroll
        ROWLOOP { const int row = u.pm * 256 + ai * 128 + wr * 64 + m * 16 + fr;
            u32x4 w[2];
#pragma unroll
            for (int bj = 0; bj < 2; ++bj) { f32x4 a, b;
#pragma unroll
                for (int j = 0; j < 4; ++j) { const float p = fmaxf(acc[ai][bj][m][0][j], 0.f), q = fmaxf(acc[ai][bj][m][1][j], 0.f); a[j] = p * p; b[j] = q * q; }
                w[bj] = pack8(a, b); }
#ifdef MK_HIDSUB
#pragma unroll
            for (int bj = 0; bj < 2; ++bj) *(u32x4*)(HID + ((size_t)(row >> 4) * 128 + (u.pn * 8 + wc * 2 + bj)) * 512 + (row & 15) * 32 + 8 * fq) = w[bj]; }
#else
            store_pair_lines(HID, 4096, row, u.pn * 256 + wc * 64 + 8 * fq, fr, w[0], w[1]); }
#endif
    }
};
#if defined(MK_MIXPAIR) && defined(MK_DOWNPAIR)
struct EpiDown {
#ifdef MK_HIDSUB
    static constexpr int GA = 2; static constexpr bool CM = true; static constexpr int NVM = 0;
#else
    static constexpr bool GA = false, CM = true; static constexpr int NVM = 0;
#endif
    const bf16_t* HB; const float* ssq_h; float* out;
    __device__ __forceinline__ void operator()(EPI_ARGS) const {
        EPI_OPAQUE
        const int col0 = u.pn * 256 + wc * 64 + 8 * fq;
        u32x4 hb[2][4][2]; float sq[2][4];
#pragma unroll
        ROWLOOP { const int row = u.pm * 256 + ai * 128 + wr * 64 + m * 16 + fr; sq[ai][m] = ssq_h[row];
#ifdef MK_HBSUB
#pragma unroll
            for (int bj = 0; bj < 2; ++bj) hb[ai][m][bj] = *(const u32x4*)(HB + ((size_t)(row >> 4) * 32 + (u.pn * 8 + wc * 2 + bj)) * 512 + (row & 15) * 32 + 8 * fq); }
#else
            load_pair_lines(HB, 1024, row, col0, fr, hb[ai][m][0], hb[ai][m][1]); }
#endif
#pragma unroll
        ROWLOOP { const int row = u.pm * 256 + ai * 128 + wr * 64 + m * 16 + fr; const float s2 = __builtin_amdgcn_rcpf(sq[ai][m] * (1.f / 1024.f) + 1e-6f);
#pragma unroll
            for (int bj = 0; bj < 2; ++bj) { const size_t o = (size_t)row * 1024 + col0 + bj * 32;
                f32x4 h0, h1; unpack8(hb[ai][m][bj], h0, h1);
                *(f32x4*)(out + o) = h0 + acc[ai][bj][m][0] * s2; *(f32x4*)(out + o + 4) = h1 + acc[ai][bj][m][1] * s2; } }
    }
};
#else
struct EpiDown {
    static constexpr bool GA = false, CM = false; static constexpr int NVM = 0;
    const bf16_t* HB; const float* ssq_h; float* out;
    __device__ __forceinline__ void operator()(EPI_ARGS) const {
        EPI_OPAQUE
        u32x4 hb[2][4][2]; float sq[2][4];
#pragma unroll
        ROWLOOP { const int row = u.pm * 256 + ai * 128 + wr * 64 + m * 16 + fr; sq[ai][m] = ssq_h[row];
#pragma unroll
            for (int bj = 0; bj < 2; ++bj) hb[ai][m][bj] = *(const u32x4*)(HB + (size_t)row * 1024 + u.pn * 256 + bj * 128 + wc * 32 + 8 * fq); }
#pragma unroll
        ROWLOOP { const int row = u.pm * 256 + ai * 128 + wr * 64 + m * 16 + fr; const float s2 = __builtin_amdgcn_rcpf(sq[ai][m] * (1.f / 1024.f) + 1e-6f);
#pragma unroll
            for (int bj = 0; bj < 2; ++bj) { const size_t o = (size_t)row * 1024 + u.pn * 256 + bj * 128 + wc * 32 + 8 * fq;
                f32x4 h0, h1; unpack8(hb[ai][m][bj], h0, h1);
                *(f32x4*)(out + o) = h0 + acc[ai][bj][m][0] * s2; *(f32x4*)(out + o + 4) = h1 + acc[ai][bj][m][1] * s2; } }
    }
};
#endif
#define XB_TMO      128
#define XB_XCNT(j)  (256  + 64 * (j))
#define XB_XSUB(j)  (1280 + 64 * (j))
#define XB_XGEN(j)  (2304 + 64 * (j))
#define XB_TOP      3328
#define XB_TOPGEN   3392
#define XCD_BAR_WORDS 3456
#define XB_SPIN_CAP (1u << 18)
__device__ __forceinline__ unsigned xb_ld(unsigned* p)              { return __hip_atomic_load(p, __ATOMIC_RELAXED, __HIP_MEMORY_SCOPE_AGENT); }
__device__ __forceinline__ unsigned xb_add(unsigned* p, unsigned v) { return __hip_atomic_fetch_add(p, v, __ATOMIC_RELAXED, __HIP_MEMORY_SCOPE_AGENT); }
__device__ __forceinline__ unsigned xb_xcc_id() { return (unsigned)__builtin_amdgcn_s_getreg((3 << 11) | 20) & 0xFu; }
#define XB_SPIN(cond, bar) do { unsigned _sp = 0; while (cond) { __builtin_amdgcn_s_sleep(1); \
    if ((++_sp & 255u) == 0u) { if (xb_ld(&(bar)[XB_TMO])) break; if (_sp > XB_SPIN_CAP) { atomicAdd(&(bar)[XB_TMO], 1u); break; } } } } while (0)
struct XcdBarrier { unsigned* bar; unsigned x; volatile LAS unsigned* st; };
__device__ __forceinline__ XcdBarrier xcd_barrier_post(unsigned* bar, volatile LAS unsigned* st) {
    XcdBarrier b; b.bar = bar; b.x = xb_xcc_id(); b.st = st;
    if (threadIdx.x == 0) (void)xb_add(&bar[XB_XCNT(b.x)], 1u);
    return b;
}
__device__ __forceinline__ void xcd_barrier_complete(unsigned* bar, unsigned x, unsigned& nloc, unsigned& nx) {
    const unsigned G = gridDim.x * gridDim.y * gridDim.z;
    unsigned sum, cnt, mine, sp = 0u;
    for (;;) {
        sum = 0u; cnt = 0u; mine = 0u;
#pragma unroll
        for (unsigned j = 0; j < 16; ++j) { const unsigned c = xb_ld(&bar[XB_XCNT(j)]); sum += c; cnt += (c > 0u) ? 1u : 0u; mine = (j == x) ? c : mine; }
        if (sum == G) break;
        __builtin_amdgcn_s_sleep(1);
        if ((++sp & 255u) == 0u) { if (xb_ld(&bar[XB_TMO])) break; if (sp > XB_SPIN_CAP) { atomicAdd(&bar[XB_TMO], 1u); break; } }
    }
    nloc = mine > 0u ? mine : 1u; nx = cnt > 0u ? cnt : 1u;
}
__device__ __forceinline__ void xcd_barrier(const XcdBarrier& b) {
    asm volatile("s_waitcnt vmcnt(0)" ::: "memory");
    __syncthreads();
    if (threadIdx.x == 0) {
        unsigned* bar = b.bar;
        __builtin_amdgcn_s_waitcnt(0);
        unsigned nloc = b.st[0], nx = b.st[1];
        if (nloc == 0u) { xcd_barrier_complete(bar, b.x, nloc, nx); b.st[0] = nloc; b.st[1] = nx; }
        const unsigned old = xb_add(&bar[XB_XSUB(b.x)], 1u);
        const unsigned gen = old / nloc;
        if (old + 1u == (gen + 1u) * nloc) {
            __builtin_amdgcn_fence(__ATOMIC_RELEASE, "agent");
            asm volatile("s_waitcnt vmcnt(0)" ::: "memory");
            const unsigned og = xb_add(&bar[XB_TOP], 1u);
            const unsigned tg = og / nx;
            if (og + 1u == (tg + 1u) * nx) xb_add(&bar[XB_TOPGEN], 1u);
            else XB_SPIN(xb_ld(&bar[XB_TOPGEN]) == tg, bar);
            __builtin_amdgcn_fence(__ATOMIC_ACQUIRE, "agent");
            xb_add(&bar[XB_XGEN(b.x)], 1u);
            asm volatile("s_waitcnt vmcnt(0)" ::: "memory");
        } else {
            XB_SPIN(xb_ld(&bar[XB_XGEN(b.x)]) == gen, bar);
            __builtin_amdgcn_fence(__ATOMIC_ACQUIRE, "agent");
            asm volatile("s_waitcnt vmcnt(0)" ::: "memory");
        }
    }
    __syncthreads();
}

__device__ __forceinline__ void ctr_barrier(unsigned* ctr, unsigned* tmo, unsigned& epoch) {
    __threadfence();
    __syncthreads();
    ++epoch;
    if (threadIdx.x == 0) {
        const unsigned target = epoch * gridDim.x;
        xb_add(ctr, 1u);
        unsigned sp = 0;
        while (xb_ld(ctr) < target) { __builtin_amdgcn_s_sleep(1); if ((++sp & 1023u) == 0u) { if (sp > (1u << 22)) { atomicAdd(tmo, 1u); break; } } }
    }
    __syncthreads();
    __threadfence();
}
#ifndef MK_ATT_EAGER
#define MK_ATT_LAZY 1
#endif
#ifdef MK_QFRAG
#define QF_ROW(r) ((r) * 16)
#define QF_D0 1024
#else
#define QF_ROW(r) ((r) * 192)
#define QF_D0 32
#endif
#ifdef MK_ROPEFRAG
#define ROPE_BASE(row, hi) ((size_t)((row) >> 5) * 1024 + (unsigned)(((row) & 31) * 4 + (hi) * 128))
#define ROPE_D0 256
#else
#define ROPE_BASE(row, hi) ((size_t)(row) * 32 + (unsigned)((hi) * 4))
#define ROPE_D0 8
#endif
namespace att {
constexpr int KSLOT = 24576, VSLOT = 16384, NSLOT = 3;
constexpr int LDS_K = 0, LDS_V = NSLOT * KSLOT, LDS_WS = LDS_V + NSLOT * VSLOT, LDS_END = LDS_WS + 8 * 256;
__device__ __forceinline__ int crow(int r, int hi) { return (r & 3) + 8 * (r >> 2) + 4 * hi; }
__device__ __forceinline__ s16x4 vtr(const LAS unsigned char* p) { typedef short v4i16_t __attribute__((ext_vector_type(4))); return __builtin_bit_cast(s16x4, __builtin_amdgcn_ds_read_tr16_b64_v4i16((LAS v4i16_t*)p)); }
#ifndef ATT_THR
#ifdef MK_ATT_LAZY
#define ATT_THR 24.0f
#else
#define ATT_THR 6.0f
#endif
#endif
#define ATT_WAIT_V(n) asm volatile("s_waitcnt vmcnt(" #n ")" ::: "memory")
#define ATT_WAIT_VK() asm volatile("s_waitcnt vmcnt(%0)" :: "n"(ATT_KPIECES) : "memory")
__device__ __forceinline__ void glds_run4(const void* sbase, unsigned voff, unsigned lds_dst) { unsigned keep;
    asm volatile("s_mov_b32 %0, m0\n\ts_mov_b32 m0, %3\n\ts_nop 0\n\tglobal_load_lds_dwordx4 %1, %2\n\tglobal_load_lds_dwordx4 %1, %2 offset:1024\n\tglobal_load_lds_dwordx4 %1, %2 offset:2048\n\tglobal_load_lds_dwordx4 %1, %2 offset:3072\n\ts_mov_b32 m0, %0"
                 : "=&s"(keep) : "v"(voff), "s"(sbase), "s"(lds_dst) : "memory"); }
__device__ __forceinline__ void glds_run4c(int cond, const void* sbase, unsigned voff, unsigned lds_dst) { unsigned keep;
    asm volatile("s_cmp_eq_u32 %4, 0\n\ts_cbranch_scc1 1f\n\ts_mov_b32 %0, m0\n\ts_mov_b32 m0, %3\n\ts_nop 0\n\tglobal_load_lds_dwordx4 %1, %2\n\tglobal_load_lds_dwordx4 %1, %2 offset:1024\n\tglobal_load_lds_dwordx4 %1, %2 offset:2048\n\tglobal_load_lds_dwordx4 %1, %2 offset:3072\n\ts_mov_b32 m0, %0\n1:"
                 : "=&s"(keep) : "v"(voff), "s"(sbase), "s"(lds_dst), "s"(cond) : "memory", "scc"); }
__device__ __forceinline__ void glds_run2c(int cond, const void* sbase, unsigned voff, unsigned lds_dst) { unsigned keep;
    asm volatile("s_cmp_eq_u32 %4, 0\n\ts_cbranch_scc1 1f\n\ts_mov_b32 %0, m0\n\ts_mov_b32 m0, %3\n\ts_nop 0\n\tglobal_load_lds_dwordx4 %1, %2\n\tglobal_load_lds_dwordx4 %1, %2 offset:1024\n\ts_mov_b32 m0, %0\n1:"
                 : "=&s"(keep) : "v"(voff), "s"(sbase), "s"(lds_dst), "s"(cond) : "memory", "scc"); }
__device__ __forceinline__ void glds_run1(const void* sbase, unsigned voff, unsigned lds_dst) { unsigned keep;
    asm volatile("s_mov_b32 %0, m0\n\ts_mov_b32 m0, %3\n\ts_nop 0\n\tglobal_load_lds_dwordx4 %1, %2\n\ts_mov_b32 m0, %0" : "=&s"(keep) : "v"(voff), "s"(sbase), "s"(lds_dst) : "memory"); }
__device__ __forceinline__ void glds_run2(const void* sbase, unsigned voff, unsigned lds_dst) { unsigned keep;
    asm volatile("s_mov_b32 %0, m0\n\ts_mov_b32 m0, %3\n\ts_nop 0\n\tglobal_load_lds_dwordx4 %1, %2\n\tglobal_load_lds_dwordx4 %1, %2 offset:1024\n\ts_mov_b32 m0, %0"
                 : "=&s"(keep) : "v"(voff), "s"(sbase), "s"(lds_dst) : "memory"); }

#ifdef MK_ATT_NEXT
__device__ __forceinline__ void attn_unit(int bh, int qb, const bf16_t* Qg, const bf16_t* Kg, const bf16_t* Vg, bf16_t* Og, const float* rcos, const float* rsin, LAS unsigned char* lds, float* tprobe,
                                          bf16x8 (&qf)[12], int nbh, int nqb, bool hnx) {
#else
__device__ __forceinline__ void attn_unit(int bh, int qb, const bf16_t* Qg, const bf16_t* Kg, const bf16_t* Vg, bf16_t* Og, const float* rcos, const float* rsin, LAS unsigned char* lds, float* tprobe) {
#endif
    int tid = threadIdx.x; asm volatile("" : "+v"(tid));
    const int lane = tid & 63, r32 = lane & 31, hi = lane >> 5; const int wid = __builtin_amdgcn_readfirstlane(tid >> 6);
    const int b = bh >> 3, h = bh & 7;
    const int NT = 4 * (qb + 1);
    const char* kbase = (const char*)Kg + (size_t)bh * 64 * KSLOT;
    const char* vbase = (const char*)Vg + (size_t)bh * 64 * VSLOT;
    const unsigned loff = (unsigned)lane * 16u;
    LAS float* wsf = (LAS float*)(lds + LDS_WS) + wid * 64;
    const unsigned lds0 = (unsigned)(uintptr_t)lds;
#ifdef MK_ATT_DMA4
#define ATT_ISSUE_K(t, slot) do { const int _w = wid & 3; const char* _g = kbase + (size_t)(t) * KSLOT + _w * 6144; const unsigned _l = (unsigned)__builtin_amdgcn_readfirstlane(lds0 + LDS_K + (slot) * KSLOT + _w * 6144); \
        glds_run4c(__builtin_amdgcn_readfirstlane((int)(wid < 4)), _g, loff, _l); glds_run2c(__builtin_amdgcn_readfirstlane((int)(wid < 4)), _g + 4096, loff, _l + 4096); } while (0)
#define ATT_ISSUE_V(t, slot) do { const int _w = wid & 3; glds_run4c(__builtin_amdgcn_readfirstlane((int)(wid < 4)), vbase + (size_t)(t) * VSLOT + _w * 4096, loff, (unsigned)__builtin_amdgcn_readfirstlane(lds0 + LDS_V + (slot) * VSLOT + _w * 4096)); } while (0)
#define ATT_KPIECES 6
#else
#define ATT_ISSUE_K(t, slot) do { const char* _g = kbase + (size_t)(t) * KSLOT + wid * 3072; const unsigned _l = (unsigned)__builtin_amdgcn_readfirstlane(lds0 + LDS_K + (slot) * KSLOT + wid * 3072); \
        glds_run2(_g, loff, _l); glds_run1(_g + 2048, loff, _l + 2048); } while (0)
#define ATT_ISSUE_V(t, slot) do { glds_run2(vbase + (size_t)(t) * VSLOT + wid * 2048, loff, (unsigned)__builtin_amdgcn_readfirstlane(lds0 + LDS_V + (slot) * VSLOT + wid * 2048)); } while (0)
#define ATT_KPIECES 3
#endif
#ifdef MK_ATT_NEXT
    const unsigned qoff = (unsigned)(QF_ROW(r32) + hi * 8) * 2u;
#define ATT_ISSUE_KB(base, t, slot) do { const char* _g = (base) + (size_t)(t) * KSLOT + wid * 3072; const unsigned _l = (unsigned)__builtin_amdgcn_readfirstlane(lds0 + LDS_K + (slot) * KSLOT + wid * 3072); \
        glds_run2(_g, loff, _l); glds_run1(_g + 2048, loff, _l + 2048); } while (0)
#define ATT_ISSUE_VB(base, t, slot) do { glds_run2((base) + (size_t)(t) * VSLOT + wid * 2048, loff, (unsigned)__builtin_amdgcn_readfirstlane(lds0 + LDS_V + (slot) * VSLOT + wid * 2048)); } while (0)
    ATT_ISSUE_K(1, 1);
#else
#ifdef MK_ATT_EARLY_DMA
    ATT_ISSUE_K(0, 0); ATT_ISSUE_V(0, 0); ATT_ISSUE_K(1, 1);
#endif
    const char* qbase = (const char*)(Qg + ((size_t)bh * TOK + qb * 256 + wid * 32) * 192);
    const unsigned qoff = (unsigned)(QF_ROW(r32) + hi * 8) * 2u;
    bf16x8 qf[12];
#pragma unroll
    for (int d0 = 0; d0 < 12; ++d0) qf[d0] = *(const bf16x8*)(qbase + qoff + d0 * QF_D0);
    { const size_t trow = (size_t)b * TOK + qb * 256 + wid * 32 + r32;
#pragma unroll
      for (int d0 = 8; d0 < 12; ++d0) { const int i0 = 4 * (2 * (d0 - 8) + hi);
          const f32x4 cs = *(const f32x4*)(rcos + (ROPE_BASE(trow, hi) + (d0 - 8) * ROPE_D0)), sn = *(const f32x4*)(rsin + (ROPE_BASE(trow, hi) + (d0 - 8) * ROPE_D0));
          f32x4 x1, x2; unpack8(__builtin_bit_cast(u32x4, qf[d0]), x1, x2);
          qf[d0] = __builtin_bit_cast(bf16x8, pack8(x1 * cs - x2 * sn, x2 * cs + x1 * sn)); } }
#ifndef MK_ATT_EARLY_DMA
    ATT_ISSUE_K(0, 0); ATT_ISSUE_V(0, 0); ATT_ISSUE_K(1, 1);
#endif
#endif
    float mrow = -1e30f, lsum = 0.f, alpha = 1.f;
#ifdef MK_ATT_LAZY
    bool zref = false; float rmf = 0.f;
#endif
    f32x16 o[4];
#pragma unroll
    for (int d = 0; d < 4; ++d) o[d] = (f32x16){0.f, 0.f, 0.f, 0.f, 0.f, 0.f, 0.f, 0.f, 0.f, 0.f, 0.f, 0.f, 0.f, 0.f, 0.f, 0.f};
    const int qrel = wid * 32 + r32;
    u32x4 pw[2] = {(u32x4){0u, 0u, 0u, 0u}, (u32x4){0u, 0u, 0u, 0u}};
    f32x16 pA = o[0], pB = o[0];
    bool need = false;
    const LAS unsigned char* vp0 = lds + LDS_V + ((lane >> 4) & 1) * 32 + (lane & 3) * 8 + (4 * hi + ((lane & 15) >> 2)) * 64;
#define SBAR() __builtin_amdgcn_sched_barrier(0)
#ifndef ATT_HEADG
#define ATT_HEADG 0
#endif
#define XBAR() __builtin_amdgcn_sched_barrier(0x406)
#define ATT_LDK(buf, g) do { _Pragma("unroll") for (int _i = 0; _i < 3; ++_i) kf[buf][_i] = *(const LAS bf16x8*)(kp + (3 * (g) + _i) * 2048); } while (0)
#define ATT_QK(P, ks, hh) do { const LAS unsigned char* kp = lds + LDS_K + (ks) * KSLOT + hi * 1024 + r32 * 16 + (hh) * 512; bf16x8 kf[2][3]; \
        P = (f32x16){0.f, 0.f, 0.f, 0.f, 0.f, 0.f, 0.f, 0.f, 0.f, 0.f, 0.f, 0.f, 0.f, 0.f, 0.f, 0.f}; \
        ATT_LDK(0, 0); \
        _Pragma("unroll") for (int g = 0; g < 4; ++g) { \
            if (g < 3) ATT_LDK((g + 1) & 1, g + 1); \
            XBAR(); \
            _Pragma("unroll") for (int _i = 0; _i < 3; ++_i) P = __builtin_amdgcn_mfma_f32_32x32x16_bf16(kf[g & 1][_i], qf[3 * g + _i], P, 0, 0, 0); \
            if (g < ATT_HEADG) SBAR(); else XBAR(); } } while (0)
#ifdef MK_ATT_LAZY
#define ATT_START(P, jbs) do { \
        if ((jbs) >= 0) { const int kb = 32 * (jbs) + 4 * hi; \
            _Pragma("unroll") for (int r = 0; r < 16; ++r) { const int kv = kb + (r & 3) + 8 * (r >> 2); if (kv > qrel) P[r] = -INFINITY; } } \
        float rm = fmaxf(fmaxf(P[0], P[1]), P[2]); \
        _Pragma("unroll") for (int r = 3; r < 15; r += 2) rm = fmaxf(fmaxf(rm, P[r]), P[r + 1]); \
        rm = fmaxf(rm, P[15]); \
        { auto rr = __builtin_amdgcn_permlane32_swap(__float_as_uint(rm), __float_as_uint(rm), false, false); rm = fmaxf(__uint_as_float(rr[0]), __uint_as_float(rr[1])); } \
        rmf = rm; need = __any(rm > mrow + ATT_THR); } while (0)
#define ATT_RESC(P) do { if (__builtin_expect(need || !zref, 0)) { \
          if (need) { const float mnew = fmaxf(mrow, rmf); alpha = __builtin_amdgcn_exp2f(mrow - mnew); mrow = mnew; \
            lsum *= alpha; if (hi == 0) wsf[r32] = alpha; asm volatile("s_waitcnt lgkmcnt(0)" ::: "memory"); \
            _Pragma("unroll") for (int r = 0; r < 16; ++r) { const float a_ = wsf[crow(r, hi)]; _Pragma("unroll") for (int d = 0; d < 4; ++d) o[d][r] *= a_; } need = false; zref = false; } \
          _Pragma("unroll") for (int r = 0; r < 16; ++r) P[r] -= mrow; } } while (0)
#else
#define ATT_START(P, jbs) do { \
        if ((jbs) >= 0) { const int kb = 32 * (jbs) + 4 * hi; \
            _Pragma("unroll") for (int r = 0; r < 16; ++r) { const int kv = kb + (r & 3) + 8 * (r >> 2); if (kv > qrel) P[r] = -INFINITY; } } \
        float rm = fmaxf(P[0], P[1]); \
        _Pragma("unroll") for (int r = 2; r < 16; ++r) rm = fmaxf(rm, P[r]); \
        { auto rr = __builtin_amdgcn_permlane32_swap(__float_as_uint(rm), __float_as_uint(rm), false, false); rm = fmaxf(__uint_as_float(rr[0]), __uint_as_float(rr[1])); } \
        need = __any(rm > mrow + ATT_THR);                       \
        const float mnew = need ? fmaxf(mrow, rm) : mrow; alpha = __builtin_amdgcn_exp2f(mrow - mnew); mrow = mnew; \
        _Pragma("unroll") for (int r = 0; r < 16; ++r) P[r] -= mnew; } while (0)
#define ATT_RESC(P) do { if (need) { lsum *= alpha; if (hi == 0) wsf[r32] = alpha; asm volatile("s_waitcnt lgkmcnt(0)" ::: "memory"); \
            _Pragma("unroll") for (int r = 0; r < 16; ++r) { const float a_ = wsf[crow(r, hi)]; _Pragma("unroll") for (int d = 0; d < 4; ++d) o[d][r] *= a_; } need = false; } } while (0)
#endif
#define ATT_FIN(P) do { float ps = 0.f; \
        _Pragma("unroll") for (int r = 0; r < 16; ++r) { P[r] = __builtin_amdgcn_exp2f(P[r]); ps += P[r]; } \
        lsum += ps; \
        _Pragma("unroll") for (int k = 0; k < 2; ++k) \
            pw[k] = (u32x4){cvt_pk_bf16(P[8 * k], P[8 * k + 1]), cvt_pk_bf16(P[8 * k + 2], P[8 * k + 3]), cvt_pk_bf16(P[8 * k + 4], P[8 * k + 5]), cvt_pk_bf16(P[8 * k + 6], P[8 * k + 7])}; } while (0)
#define ATT_LDV(buf, d, hh) do { _Pragma("unroll") for (int ks = 0; ks < 2; ++ks) { vlo[buf][ks] = vtr(vp + (d) * 4096 + (2 * (hh) + ks) * 1024); vhi[buf][ks] = vtr(vp + (d) * 4096 + (2 * (hh) + ks) * 1024 + 512); } } while (0)
#define ATT_PV(vslot, hh) do { const LAS unsigned char* vp = vp0 + (vslot) * VSLOT; s16x4 vlo[2][2], vhi[2][2]; \
        ATT_LDV(0, 0, hh); \
        _Pragma("unroll") for (int d = 0; d < 4; ++d) { \
            if (d < 3) ATT_LDV((d + 1) & 1, d + 1, hh); \
            XBAR(); \
            _Pragma("unroll") for (int ks = 0; ks < 2; ++ks) { const s16x4 lo = vlo[d & 1][ks], hv = vhi[d & 1][ks]; \
                const bf16x8 vf = (bf16x8){lo[0], lo[1], lo[2], lo[3], hv[0], hv[1], hv[2], hv[3]}; \
                o[d] = __builtin_amdgcn_mfma_f32_32x32x16_bf16(__builtin_bit_cast(bf16x8, pw[ks]), vf, o[d], 0, 0, 0); } \
            XBAR(); } } while (0)
    int s0 = 0, sm1 = 2;
#if defined(MK_ATT_PRIO) && MK_ATT_PRIO == 2
#define ATT_YOUNG_PRIO(v) do { if (wid >= 4) __builtin_amdgcn_s_setprio(v); } while (0)
#else
#define ATT_YOUNG_PRIO(v) do { } while (0)
#endif
#define ATT_STEP(t, hh, PC, PP, pvs, MASKED) do { \
        const int jbs = (MASKED) ? (2 * (t) + (hh) - 2 * (NT - 4)) : -1; \
        if (!(MASKED) || jbs <= wid) {                         \
            SBAR(); ATT_QK(PC, s0, hh); ATT_FIN(PP); SBAR(); \
            ATT_PV(pvs, 1 - (hh)); ATT_START(PC, jbs); SBAR(); \
            ATT_RESC(PC); \
        } else {                                               \
            ATT_FIN(PP); ATT_PV(pvs, 1 - (hh)); \
            _Pragma("unroll") for (int r = 0; r < 16; ++r) PC[r] = -INFINITY; \
        } } while (0)
#define ATT_SYNC(t) do { \
        if ((t) + 1 < NT) ATT_WAIT_VK(); else ATT_WAIT_V(0); \
        __builtin_amdgcn_s_barrier(); asm volatile("" ::: "memory"); \
        if ((t) + 1 < NT) ATT_ISSUE_V((t) + 1, (s0 == 2) ? 0 : s0 + 1); \
        if ((t) + 2 < NT) ATT_ISSUE_K((t) + 2, sm1); } while (0)
#define ATT_ROT() do { sm1 = s0; s0 = (s0 == 2) ? 0 : s0 + 1; } while (0)
#ifdef MK_ATT_NEXT
    asm volatile("s_waitcnt vmcnt(11)" ::: "memory");
    __builtin_amdgcn_s_barrier(); asm volatile("" ::: "memory");
    ATT_ISSUE_V(1, 1); ATT_ISSUE_K(2, 2);
#else
    ATT_SYNC(0);
#endif
    { const int jb0 = (NT == 4) ? 0 : -1;
      ATT_QK(pA, s0, 0);
#ifdef MK_ATT_LAZY
      { float r0 = fabsf(pA[0]);
#pragma unroll
        for (int r = 1; r < 16; ++r) r0 = fmaxf(r0, fabsf(pA[r]));
        zref = !__any(r0 > ATT_THR); mrow = zref ? 0.f : -1e30f; }
#endif
      ATT_START(pA, jb0); ATT_RESC(pA);
      if (NT == 4) ATT_STEP(0, 1, pB, pA, s0, true); else ATT_STEP(0, 1, pB, pA, s0, false); }
    ATT_ROT();
    int t = 1;
#ifdef MK_TPROBE
    const unsigned long long tp0 = __builtin_amdgcn_s_memtime(), tr0 = __builtin_amdgcn_s_memrealtime();
    unsigned long long tseg[6] = {0, 0, 0, 0, 0, 0}, tlast = tp0; int nint = 0;
#define TSEG(i) do { __builtin_amdgcn_sched_barrier(0); const unsigned long long _n = __builtin_amdgcn_s_memtime(); tseg[i] += _n - tlast; tlast = _n; __builtin_amdgcn_sched_barrier(0); } while (0)
#else
#define TSEG(i) do { } while (0)
#endif
    for (; t < NT - 4; ++t) {
        if ((t) + 1 < NT) ATT_WAIT_VK(); else ATT_WAIT_V(0);
        __builtin_amdgcn_s_barrier(); asm volatile("" ::: "memory");
        TSEG(0);
        if ((t) + 1 < NT) ATT_ISSUE_V((t) + 1, (s0 == 2) ? 0 : s0 + 1);
        if ((t) + 2 < NT) ATT_ISSUE_K((t) + 2, sm1);
        TSEG(1);
        ATT_YOUNG_PRIO(1);
        ATT_STEP(t, 0, pA, pB, sm1, false);
        ATT_YOUNG_PRIO(0);
        TSEG(2);
        ATT_STEP(t, 1, pB, pA, s0, false);
        TSEG(3);
        ATT_ROT();
#ifdef MK_TPROBE
        ++nint;
#endif
    }
#ifdef MK_TPROBE
    { const unsigned long long tp1 = __builtin_amdgcn_s_memtime(), tr1 = __builtin_amdgcn_s_memrealtime();
      if (bh == MK_TPROBE_BH && qb == 15 && tid == MK_TPROBE_TID) { tprobe[0] = (float)(tp1 - tp0) / (float)nint; tprobe[1] = (float)(tp1 - tp0) / (float)(tr1 - tr0) * 100.f;
        for (int i = 0; i < 6; ++i) tprobe[2 + i] = (float)tseg[i] / (float)nint; } }
#endif
    for (; t < NT; ++t) {
        ATT_SYNC(t);
        ATT_STEP(t, 0, pA, pB, sm1, true);
        ATT_STEP(t, 1, pB, pA, s0, true);
        ATT_ROT();
    }
    ATT_SYNC(NT);
#ifdef MK_ATT_NEXT
    if (hnx) ATT_ISSUE_KB((const char*)Kg + (size_t)nbh * 64 * KSLOT, 0, 0);
    ATT_FIN(pB); ATT_PV(sm1, 1);
    asm volatile("s_waitcnt lgkmcnt(0)" ::: "memory"); __builtin_amdgcn_s_barrier(); asm volatile("" ::: "memory");
    f32x4 ncs[4], nsn[4];
    if (hnx) ATT_ISSUE_VB((const char*)Vg + (size_t)nbh * 64 * VSLOT, 0, 0);
    {   const char* qb2 = (const char*)(Qg + ((size_t)nbh * TOK + nqb * 256 + wid * 32) * 192);
#pragma unroll
        for (int d0 = 0; d0 < 12; ++d0) qf[d0] = *(const bf16x8*)(qb2 + qoff + d0 * QF_D0);
    }
#else
    ATT_FIN(pB); ATT_PV(sm1, 1);
#endif
#undef ATT_SYNC
#undef ATT_ROT
#undef ATT_STEP
#undef ATT_QK
#undef ATT_START
#undef ATT_RESC
#undef ATT_FIN
    { auto rr = __builtin_amdgcn_permlane32_swap(__float_as_uint(lsum), __float_as_uint(lsum), false, false); lsum = __uint_as_float(rr[0]) + __uint_as_float(rr[1]); }
    if (hi == 0) wsf[32 + r32] = lsum;
    asm volatile("s_waitcnt lgkmcnt(0)" ::: "memory");
#ifdef MK_ATT_NEXT
    { LAS unsigned char* st = wid < 5 ? lds + LDS_K + KSLOT + wid * (32 * 272) : lds + LDS_V + VSLOT + (wid - 5) * (32 * 272);
#pragma unroll
      for (int r = 0; r < 16; ++r) { const int q = crow(r, hi); const float il = __builtin_amdgcn_rcpf(wsf[32 + q]);
#pragma unroll
          for (int d = 0; d < 4; ++d) { const unsigned w = cvt_pk_bf16(o[d][r] * il, 0.f); *(LAS unsigned short*)(st + q * 272 + (d * 32 + r32) * 2) = (unsigned short)(w & 0xffffu); } }
      asm volatile("s_waitcnt lgkmcnt(0)" ::: "memory");
      { const size_t trow2 = (size_t)(nbh >> 3) * TOK + nqb * 256 + wid * 32 + r32;
#pragma unroll
        for (int d0 = 8; d0 < 12; ++d0) { ncs[d0 - 8] = *(const f32x4*)(rcos + (ROPE_BASE(trow2, hi) + (d0 - 8) * ROPE_D0)); nsn[d0 - 8] = *(const f32x4*)(rsin + (ROPE_BASE(trow2, hi) + (d0 - 8) * ROPE_D0)); } }
      {
#pragma unroll
          for (int d0 = 8; d0 < 12; ++d0) { f32x4 x1, x2; unpack8(__builtin_bit_cast(u32x4, qf[d0]), x1, x2);
              qf[d0] = __builtin_bit_cast(bf16x8, pack8(x1 * ncs[d0 - 8] - x2 * nsn[d0 - 8], x2 * ncs[d0 - 8] + x1 * nsn[d0 - 8])); } }
      bf16_t* ob = Og + ((size_t)b * TOK + qb * 256 + wid * 32) * 1024 + h * 128 + (lane & 15) * 8;
#pragma unroll
      for (int j = 0; j < 8; ++j) *(u32x4*)(ob + (size_t)(4 * j + (lane >> 4)) * 1024) = *(const LAS u32x4*)(st + (4 * j + (lane >> 4)) * 272 + (lane & 15) * 16); }
#else
#ifdef MK_ATT_OSTAGE
    { LAS unsigned char* st = lds + LDS_K + wid * (32 * 272);
#pragma unroll
      for (int r = 0; r < 16; ++r) { const int q = crow(r, hi); const float il = __builtin_amdgcn_rcpf(wsf[32 + q]);
#pragma unroll
          for (int d = 0; d < 4; ++d) { const unsigned w = cvt_pk_bf16(o[d][r] * il, 0.f); *(LAS unsigned short*)(st + q * 272 + (d * 32 + r32) * 2) = (unsigned short)(w & 0xffffu); } }
      asm volatile("s_waitcnt lgkmcnt(0)" ::: "memory");
      bf16_t* ob = Og + ((size_t)b * TOK + qb * 256 + wid * 32) * 1024 + h * 128 + (lane & 15) * 8;
#pragma unroll
      for (int j = 0; j < 8; ++j) *(u32x4*)(ob + (size_t)(4 * j + (lane >> 4)) * 1024) = *(const LAS u32x4*)(st + (4 * j + (lane >> 4)) * 272 + (lane & 15) * 16); }
#else
    bf16_t* orow = Og + ((size_t)b * TOK + qb * 256 + wid * 32) * 1024 + h * 128 + r32;
#pragma unroll
    for (int r = 0; r < 16; ++r) { const int q = crow(r, hi); const float il = __builtin_amdgcn_rcpf(wsf[32 + q]);
#pragma unroll
        for (int d = 0; d < 4; ++d) { const unsigned w = cvt_pk_bf16(o[d][r] * il, 0.f); orow[(size_t)q * 1024 + d * 32] = (bf16_t)(w & 0xffffu); } }
#endif
#endif
    asm volatile("s_waitcnt lgkmcnt(0)" ::: "memory"); __builtin_amdgcn_s_barrier(); asm volatile("" ::: "memory");
#undef ATT_ISSUE_K
#undef ATT_ISSUE_V
#ifdef MK_ATT_NEXT
#undef ATT_ISSUE_KB
#undef ATT_ISSUE_VB
#endif
#undef ATT_PV
#undef ATT_LDV
#undef ATT_LDK
#undef XBAR
#undef SBAR
}

__device__ __forceinline__ void attn_phase(const Params& p, LAS unsigned char* lds, int vcu, int G) {
    const int nitems = p.NB * 8 * 8;
#if defined(MK_ATT_PRIO) && MK_ATT_PRIO == 1
    if (__builtin_amdgcn_readfirstlane(threadIdx.x) >= 256) __builtin_amdgcn_s_setprio(1);
#endif
#ifdef MK_ATT_NEXT
    bf16x8 qf[12];
    if (vcu < nitems) {
        int tid = threadIdx.x; asm volatile("" : "+v"(tid));
        const int lane = tid & 63, r32 = lane & 31, hi = lane >> 5; const int wid = __builtin_amdgcn_readfirstlane(tid >> 6);
        const int bh = vcu >> 3, qb = vcu & 7, b = bh >> 3;
        const unsigned loff = (unsigned)lane * 16u, lds0 = (unsigned)(uintptr_t)lds;
        { const char* _g = (const char*)p.K + (size_t)bh * 64 * KSLOT + wid * 3072; const unsigned _l = (unsigned)__builtin_amdgcn_readfirstlane(lds0 + LDS_K + wid * 3072); glds_run2(_g, loff, _l); glds_run1(_g + 2048, loff, _l + 2048); }
        glds_run2((const char*)p.V + (size_t)bh * 64 * VSLOT + wid * 2048, loff, (unsigned)__builtin_amdgcn_readfirstlane(lds0 + LDS_V + wid * 2048));
        const char* qbase = (const char*)(p.Q + ((size_t)bh * TOK + qb * 256 + wid * 32) * 192); const unsigned qoff = (unsigned)(QF_ROW(r32) + hi * 8) * 2u;
#pragma unroll
        for (int d0 = 0; d0 < 12; ++d0) qf[d0] = *(const bf16x8*)(qbase + qoff + d0 * QF_D0);
        const size_t trow = (size_t)b * TOK + qb * 256 + wid * 32 + r32;
#pragma unroll
        for (int d0 = 8; d0 < 12; ++d0) { const int i0 = 4 * (2 * (d0 - 8) + hi);
            const f32x4 cs = *(const f32x4*)(p.rcos + (ROPE_BASE(trow, hi) + (d0 - 8) * ROPE_D0)), sn = *(const f32x4*)(p.rsin + (ROPE_BASE(trow, hi) + (d0 - 8) * ROPE_D0));
            f32x4 x1, x2; unpack8(__builtin_bit_cast(u32x4, qf[d0]), x1, x2);
            qf[d0] = __builtin_bit_cast(bf16x8, pack8(x1 * cs - x2 * sn, x2 * cs + x1 * sn)); }
    }
    for (int it = vcu; it < nitems; it += G) {
        const int bh = it >> 3, s = it & 7; const int itn = it + G; const bool hn = itn < nitems;
        attn_unit(bh, s, p.Q, p.K, p.V, p.ATT, p.rcos, p.rsin, lds, (float*)(p.ctl + 2048), qf, bh, 15 - s, true);
        attn_unit(bh, 15 - s, p.Q, p.K, p.V, p.ATT, p.rcos, p.rsin, lds, (float*)(p.ctl + 2048), qf, hn ? (itn >> 3) : bh, hn ? (itn & 7) : 15 - s, hn);
    }
#else
    for (int it = vcu; it < nitems; it += G) {
        const int bh = it >> 3, s = it & 7;
        attn_unit(bh, s, p.Q, p.K, p.V, p.ATT, p.rcos, p.rsin, lds, (float*)(p.ctl + 2048));
        attn_unit(bh, 15 - s, p.Q, p.K, p.V, p.ATT, p.rcos, p.rsin, lds, (float*)(p.ctl + 2048));
    }
#endif
#if defined(MK_ATT_PRIO) && MK_ATT_PRIO == 1
    __builtin_amdgcn_s_setprio(0);
#endif
}
}
namespace ssm {
constexpr int CH = 256, NCH = TOK / CH, XROW = 272;
struct Cplx { float r, i; };
__device__ __forceinline__ Cplx cmul(Cplx a, Cplx b) { return {a.r * b.r - a.i * b.i, a.r * b.i + a.i * b.r}; }

template <bool OUT>
__device__ __forceinline__ void ssm_item(const Params& p, int item, LAS unsigned char* xt  ) {
    int lane = threadIdx.x & 63; asm volatile("" : "+v"(lane));
    const int j = lane & 31, hi = lane >> 5;
    const int cp = item & 7, g = (item >> 3) & 31, b = item >> 8;
    const int chunk = 2 * cp + hi;
    const float* a_re = p.in[11]; const float* a_im = p.in[12]; const float* log_dt = p.in[13];
    const float* b_re = p.in[14]; const float* b_im = p.in[15]; const float* c_re = p.in[16]; const float* c_im = p.in[17]; const float* dsk = p.in[18];
    const float dt = expf(log_dt[g]);
    Cplx lam[2], fac[2];
#pragma unroll
    for (int k = 0; k < 2; ++k) { const int pp = g * 64 + 32 * k + j; const float ar = a_re[pp], ai = a_im[pp];
        const float mag = expf(ar * dt); lam[k] = {mag * cosf(ai * dt), mag * sinf(ai * dt)};
        const float nr = lam[k].r - 1.f, ni = lam[k].i, den = ar * ar + ai * ai; fac[k] = {(nr * ar + ni * ai) / den, (ni * ar - nr * ai) / den}; }
    bf16x8 bfr[4];
#pragma unroll
    for (int k = 0; k < 2; ++k) { const int pp = g * 64 + 32 * k + j; float br[8], bi[8];
        const f32x4 r0 = *(const f32x4*)(b_re + pp * 16 + 8 * hi), r1 = *(const f32x4*)(b_re + pp * 16 + 8 * hi + 4);
        const f32x4 i0 = *(const f32x4*)(b_im + pp * 16 + 8 * hi), i1 = *(const f32x4*)(b_im + pp * 16 + 8 * hi + 4);
#pragma unroll
        for (int q = 0; q < 4; ++q) { br[q] = r0[q]; br[4 + q] = r1[q]; bi[q] = i0[q]; bi[4 + q] = i1[q]; }
        u32x4 wr_, wi_;
#pragma unroll
        for (int q = 0; q < 4; ++q) { const float ar0 = fac[k].r * br[2 * q] - fac[k].i * bi[2 * q], ar1 = fac[k].r * br[2 * q + 1] - fac[k].i * bi[2 * q + 1];
            const float ai0 = fac[k].r * bi[2 * q] + fac[k].i * br[2 * q], ai1 = fac[k].r * bi[2 * q + 1] + fac[k].i * br[2 * q + 1];
            wr_[q] = cvt_pk_bf16(ar0, ar1); wi_[q] = cvt_pk_bf16(ai0, ai1); }
        bfr[2 * k] = __builtin_bit_cast(bf16x8, wr_); bfr[2 * k + 1] = __builtin_bit_cast(bf16x8, wi_); }
    const int hA = (j >> 2) & 1, rA = (j & 3) + 4 * (j >> 3);
    const size_t rowA0 = (size_t)b * TOK + (size_t)(2 * cp + hA) * CH + rA;
#ifdef MK_UFRAG
#define U_TSTRIDE 16
    const bf16_t* ua = p.U + ((size_t)(b * 32 + g) * TOK + (size_t)(2 * cp + hA) * CH + rA) * 16 + 8 * hi;
#else
#define U_TSTRIDE 512
    const bf16_t* ua = p.U + rowA0 * 512 + g * 16 + 8 * hi;
#endif
    Cplx x[2] = {{0.f, 0.f}, {0.f, 0.f}};
    bf16x8 cfr[8]; float dv[8];
    if (OUT) {
        Cplx l256[2];
#pragma unroll
        for (int k = 0; k < 2; ++k) { Cplx t = lam[k];
#pragma unroll
            for (int s = 0; s < 8; ++s) t = cmul(t, t);
            l256[k] = t; }
        const float* sl = p.sloc + ((size_t)(b * 32 + g) * NCH) * 128;
        float2 sv[NCH - 1][2];
#pragma unroll
        for (int c = 0; c < NCH - 1; ++c)
#pragma unroll
            for (int k = 0; k < 2; ++k) sv[c][k] = (c < chunk) ? *(const float2*)(sl + (size_t)c * 128 + (32 * k + j) * 2) : make_float2(0.f, 0.f);
#pragma unroll
        for (int c = 0; c < NCH - 1; ++c) { if (c < chunk) {
#pragma unroll
            for (int k = 0; k < 2; ++k) { const Cplx t = cmul(l256[k], x[k]); x[k] = {t.r + sv[c][k].x, t.i + sv[c][k].y}; } } }
#pragma unroll
        for (int ks = 0; ks < 8; ++ks) { u32x4 w = (u32x4){0u, 0u, 0u, 0u};
            if (j < 16) { const f32x4 cr = *(const f32x4*)(c_re + (g * 16 + j) * 64 + 8 * ks + 4 * hi), ci = *(const f32x4*)(c_im + (g * 16 + j) * 64 + 8 * ks + 4 * hi);
#pragma unroll
                for (int q = 0; q < 4; ++q) w[q] = cvt_pk_bf16(cr[q], -ci[q]); }
            cfr[ks] = __builtin_bit_cast(bf16x8, w); }
#pragma unroll
        for (int q = 0; q < 8; ++q) dv[q] = dsk[g * 16 + 4 * hi + (q & 3) + 8 * (q >> 2)];
    }
    const int hn = j >> 4, rn = j & 15;
    const size_t rowO0 = (size_t)b * TOK + (size_t)(2 * cp + hn) * CH + rn;
#ifdef MK_UFRAG
    const bf16_t* uo = p.U + ((size_t)(b * 32 + g) * TOK + (size_t)(2 * cp + hn) * CH + rn) * 16 + 4 * hi;
#else
    const bf16_t* uo = p.U + rowO0 * 512 + g * 16 + 4 * hi;
#endif
    bf16x8 af_n = *(const bf16x8*)ua;
    u32x2 uw_n[2] = {(u32x2){0u, 0u}, (u32x2){0u, 0u}};
    if (OUT) { uw_n[0] = *(const u32x2*)uo; uw_n[1] = *(const u32x2*)(uo + 8); }
    for (int tile = 0; tile < CH / 16; ++tile) {
        const bf16x8 af = af_n; const u32x2 uw0 = uw_n[0], uw1 = uw_n[1];
        if (tile + 1 < CH / 16) { af_n = *(const bf16x8*)(ua + (size_t)(tile + 1) * 16 * U_TSTRIDE);
            if (OUT) { uw_n[0] = *(const u32x2*)(uo + (size_t)(tile + 1) * 16 * U_TSTRIDE); uw_n[1] = *(const u32x2*)(uo + (size_t)(tile + 1) * 16 * U_TSTRIDE + 8); } }
        f32x16 bu[4];
#pragma unroll
        for (int q = 0; q < 4; ++q) bu[q] = __builtin_amdgcn_mfma_f32_32x32x16_bf16(af, bfr[q], (f32x16){0.f, 0.f, 0.f, 0.f, 0.f, 0.f, 0.f, 0.f, 0.f, 0.f, 0.f, 0.f, 0.f, 0.f, 0.f, 0.f}, 0, 0, 0);
#pragma unroll
        for (int r = 0; r < 16; ++r) {
#pragma unroll
            for (int k = 0; k < 2; ++k) { const float nr = fmaf(lam[k].r, x[k].r, fmaf(-lam[k].i, x[k].i, bu[2 * k][r])), ni = fmaf(lam[k].r, x[k].i, fmaf(lam[k].i, x[k].r, bu[2 * k + 1][r]));
                x[k] = {nr, ni}; if (OUT) { bu[2 * k][r] = nr; bu[2 * k + 1][r] = ni; } }
        }
        if (OUT) {
#pragma unroll
            for (int r = 0; r < 16; ++r) { LAS unsigned* rowp = (LAS unsigned*)(xt + (16 * hi + r) * XROW);
                rowp[j] = cvt_pk_bf16(bu[0][r], bu[1][r]); rowp[32 + j] = cvt_pk_bf16(bu[2][r], bu[3][r]); }
            asm volatile("s_waitcnt lgkmcnt(0)" ::: "memory");
            f32x16 y = (f32x16){0.f, 0.f, 0.f, 0.f, 0.f, 0.f, 0.f, 0.f, 0.f, 0.f, 0.f, 0.f, 0.f, 0.f, 0.f, 0.f};
#pragma unroll
            for (int ks = 0; ks < 8; ++ks) { const bf16x8 xf = *(const LAS bf16x8*)(xt + j * XROW + (16 * ks + 8 * hi) * 2);
                y = __builtin_amdgcn_mfma_f32_32x32x16_bf16(cfr[ks], xf, y, 0, 0, 0); }
            const size_t row = rowO0 + tile * 16;
#pragma unroll
            for (int q2 = 0; q2 < 2; ++q2) { const int c0 = 4 * hi + 8 * q2;
                const u32x2 uw = q2 ? uw1 : uw0;
                const float u0 = bf_lo(uw.x), u1 = bf_hi(uw.x), u2 = bf_lo(uw.y), u3 = bf_hi(uw.y);
                const float z0 = gelu_t(y[4 * q2 + 0] + dv[4 * q2 + 0] * u0), z1 = gelu_t(y[4 * q2 + 1] + dv[4 * q2 + 1] * u1);
                const float z2 = gelu_t(y[4 * q2 + 2] + dv[4 * q2 + 2] * u2), z3 = gelu_t(y[4 * q2 + 3] + dv[4 * q2 + 3] * u3);
#ifdef MK_ZFRAG
                *(u32x2*)(p.Z + ((size_t)(b * 32 + g) * TOK + (row - (size_t)b * TOK)) * 16 + c0) = (u32x2){cvt_pk_bf16(z0, z1), cvt_pk_bf16(z2, z3)}; }
#else
                *(u32x2*)(p.Z + row * 512 + g * 16 + c0) = (u32x2){cvt_pk_bf16(z0, z1), cvt_pk_bf16(z2, z3)}; }
#endif
            asm volatile("s_waitcnt lgkmcnt(0)" ::: "memory");
        }
    }
    if (!OUT) {
        float* sl = p.sloc + (((size_t)(b * 32 + g) * NCH + chunk) * 64) * 2;
#pragma unroll
        for (int k = 0; k < 2; ++k) *(float2*)(sl + (32 * k + j) * 2) = make_float2(x[k].r, x[k].i);
    }
}
template <bool OUT>
__device__ __forceinline__ void ssm_phase(const Params& p, LAS unsigned char* lds, int vcu, int G) {
    const int wid = __builtin_amdgcn_readfirstlane(threadIdx.x >> 6);
    const int nitems = p.NB * 32 * 8;
    for (int it = vcu * 8 + wid; it < nitems; it += G * 8) ssm_item<OUT>(p, it, lds + wid * (32 * XROW));
}
}
__device__ __forceinline__ int src_col(int mode, int n) {
    if (mode == 0) return n;
    if (mode == 1) { if (n < 1152) return n; if (n < 1216) return 1152 + dperm(n - 1152); if (n < 1280) return -1; if (n < 2304) return 1216 + (n - 1280); return 2240 + (n - 2304); }
    const int h = n >> 8, c = n & 255; if (c < 128) return 192 * h + c; if (c < 192) return 192 * h + 128 + dperm(c - 128); return -1;
}
__device__ __forceinline__ unsigned f2bf(float f) { unsigned u = __builtin_bit_cast(unsigned, f); return (u + 0x7fffu + ((u >> 16) & 1u)) >> 16; }
__device__ __forceinline__ unsigned pk2(float lo, float hi) { return f2bf(lo) | (f2bf(hi) << 16); }
__device__ __forceinline__ void p0_item(const float* W, int K, int Nsrc, const float* gain, bf16_t* WT, int nblk, int mode, LAS float* scr, int item, int lane) {
    const int kb = item / nblk, nb = item % nblk, k0 = 64 * kb, n0 = 32 * nb;
    const int sc = src_col(mode, n0 + (lane & 31));
    float v[32], gn[32];
    const int scc = sc >= 0 ? sc : 0;
#pragma unroll
    for (int i = 0; i < 32; ++i) { const int kk = 2 * i + (lane >> 5); v[i] = W[(size_t)(k0 + kk) * Nsrc + scc]; gn[i] = gain ? gain[k0 + kk] : 1.f; }
#pragma unroll
    for (int i = 0; i < 32; ++i) { const int kk = 2 * i + (lane >> 5); scr[kk * 33 + (lane & 31)] = sc >= 0 ? v[i] * gn[i] : 0.f; }
    asm volatile("s_waitcnt lgkmcnt(0)" ::: "memory");
    const int c = lane & 7;
#pragma unroll
    for (int jj = 0; jj < 4; ++jj) { const int n = (lane >> 3) + 8 * jj; const LAS float* s = scr + (8 * c) * 33 + n;
        u32x4 o; o.x = pk2(s[0 * 33], s[1 * 33]); o.y = pk2(s[2 * 33], s[3 * 33]); o.z = pk2(s[4 * 33], s[5 * 33]); o.w = pk2(s[6 * 33], s[7 * 33]);
        *(u32x4*)(WT + (size_t)(n0 + n) * K + k0 + 8 * c) = o; }
    asm volatile("s_waitcnt lgkmcnt(0)" ::: "memory");
}
__device__ __forceinline__ void rope_sincos(float a, float& s, float& c) {
#if !defined(MK_FAST_ROPE) && !defined(MK_P0_FAST)
    s = sinf(a); c = cosf(a);
#else
    const float n = rintf(a * 0.15915494309189535f);
    float r = fmaf(-n, 6.2831854820251465f, a);
    r = fmaf(n, 1.7484555e-7f, r);
    const float t = r * 0.15915494309189535f;
    s = __builtin_amdgcn_sinf(t); c = __builtin_amdgcn_cosf(t);
#endif
}
#ifdef MK_P0_FAST
__device__ __forceinline__ float wave_sum(float v) {
#define WS_DPP(ctrl) v += __builtin_bit_cast(float, __builtin_amdgcn_mov_dpp(__builtin_bit_cast(int, v), ctrl, 0xF, 0xF, true))
    WS_DPP(0xB1); WS_DPP(0x4E); WS_DPP(0x141); WS_DPP(0x140);
#undef WS_DPP
    { auto a = __builtin_amdgcn_permlane16_swap(__float_as_uint(v), __float_as_uint(v), false, false); v = __uint_as_float(a[0]) + __uint_as_float(a[1]); }
    { auto b = __builtin_amdgcn_permlane32_swap(__float_as_uint(v), __float_as_uint(v), false, false); v = __uint_as_float(b[0]) + __uint_as_float(b[1]); }
    return v;
}
#else
__device__ __forceinline__ float wave_sum(float v) {
#pragma unroll
    for (int o = 1; o < 64; o <<= 1) v += __shfl_xor(v, o);
    return v;
}
#endif
__device__ __forceinline__ void p0_prologue(const Params& p, LAS unsigned char* lds, int vcu, int G) {
    const int lane = threadIdx.x & 63, wid = __builtin_amdgcn_readfirstlane(threadIdx.x >> 6);
    LAS float* scr = (LAS float*)(lds + wid * 16384);
    const int gw = vcu * 8 + wid, NGW = G * 8;
    constexpr int I1 = 16 * 104, IQ = 6 * 64, IKV = 4 * 64;
    constexpr int NITEMS = I1 + IQ + IKV;
    for (int it = gw; it < NITEMS; it += NGW) {
        int r = it;
        if (r < I1) { p0_item(p.in[3], 1024, 3264, p.in[2], p.W1t, 104, 1, scr, r, lane); continue; } r -= I1;
        if (r < IQ) { p0_item(p.in[6], 384, 1536, p.in[4], p.Wqt, 64, 2, scr, r, lane); continue; } r -= IQ;
        p0_item(p.in[7], 256, 2048, p.in[5], p.Wkvt, 64, 0, scr, r, lane);
    }
    const int M = p.NB * TOK;
#ifdef MK_P0_FAST
#define XLOAD(V, mbase) do { _Pragma("unroll") for (int r = 0; r < 4; ++r) { const f32x4* xr = (const f32x4*)(p.x + (size_t)((mbase) + r) * 1024) + lane; \
            _Pragma("unroll") for (int jj = 0; jj < 4; ++jj) V[r][jj] = xr[64 * jj]; } } while (0)
#define XPROC(v, m0) do { float s[4]; \
        _Pragma("unroll") for (int r = 0; r < 4; ++r) { s[r] = 0.f; \
            _Pragma("unroll") for (int jj = 0; jj < 4; ++jj) s[r] += sq4(v[r][jj]); \
            s[r] = wave_sum(s[r]); \
            const float iv = rsqrtf(s[r] * (1.f / 1024.f) + 1e-6f); \
            u32x2* o8 = (u32x2*)(p.XB + (size_t)((m0) + r) * 1024) + lane; \
            _Pragma("unroll") for (int jj = 0; jj < 4; ++jj) o8[64 * jj] = (u32x2){cvt_pk_bf16(v[r][jj][0] * iv, v[r][jj][1] * iv), cvt_pk_bf16(v[r][jj][2] * iv, v[r][jj][3] * iv)}; } \
        if (lane < 4) { const int mm = (m0) + lane; const float sv = lane == 0 ? s[0] : lane == 1 ? s[1] : lane == 2 ? s[2] : s[3]; \
            p.inv_x[mm] = rsqrtf(sv * (1.f / 1024.f) + 1e-6f); p.ssq_q[mm] = 0.f; p.ssq_kv[mm] = 0.f; p.ssq_kpe[mm] = 0.f; p.ssq_h[mm] = 0.f; } \
        { const int mm = (m0) + (lane >> 5) * 2, i = lane & 31; \
          _Pragma("unroll") for (int r = 0; r < 2; ++r) { const float ang = (float)p.pos[mm + r] * p.inv_freq[i]; float cs_, sn_; rope_sincos(ang, sn_, cs_); p.rcos[ROPE_IDX(mm + r, i)] = cs_; p.rsin[ROPE_IDX(mm + r, i)] = sn_; } } } while (0)
    { int m0 = gw * 4; const int step = NGW * 4;
      if (m0 < M) { f32x4 va[4][4], vb[4][4]; XLOAD(va, m0);
        for (;;) { const int m1 = m0 + step; if (m1 < M) XLOAD(vb, m1); XPROC(va, m0); if (m1 >= M) break;
                   const int m2 = m1 + step; if (m2 < M) XLOAD(va, m2); XPROC(vb, m1); if (m2 >= M) break; m0 = m2; } } }
#undef XLOAD
#undef XPROC
#else
    for (int m0 = gw * 4; m0 < M; m0 += NGW * 4) {
        f32x4 v[4][4]; float s[4];
#pragma unroll
        for (int r = 0; r < 4; ++r) { const f32x4* xr = (const f32x4*)(p.x + (size_t)(m0 + r) * 1024) + lane;
#pragma unroll
            for (int jj = 0; jj < 4; ++jj) v[r][jj] = xr[64 * jj]; }
#pragma unroll
        for (int r = 0; r < 4; ++r) { s[r] = 0.f;
#pragma unroll
            for (int jj = 0; jj < 4; ++jj) s[r] += sq4(v[r][jj]);
            s[r] = wave_sum(s[r]);
            const float iv = rsqrtf(s[r] * (1.f / 1024.f) + 1e-6f);
            u32x2* o8 = (u32x2*)(p.XB + (size_t)(m0 + r) * 1024) + lane;
#pragma unroll
            for (int jj = 0; jj < 4; ++jj) o8[64 * jj] = (u32x2){cvt_pk_bf16(v[r][jj][0] * iv, v[r][jj][1] * iv), cvt_pk_bf16(v[r][jj][2] * iv, v[r][jj][3] * iv)}; }
        if (lane < 4) { const int mm = m0 + lane; const float sv = lane == 0 ? s[0] : lane == 1 ? s[1] : lane == 2 ? s[2] : s[3];
            p.inv_x[mm] = rsqrtf(sv * (1.f / 1024.f) + 1e-6f); p.ssq_q[mm] = 0.f; p.ssq_kv[mm] = 0.f; p.ssq_kpe[mm] = 0.f; p.ssq_h[mm] = 0.f; }
        { const int mm = m0 + (lane >> 5) * 2, i = lane & 31;
#pragma unroll
          for (int r = 0; r < 2; ++r) { const float ang = (float)p.pos[mm + r] * p.inv_freq[i]; float cs_, sn_; rope_sincos(ang, sn_, cs_); p.rcos[ROPE_IDX(mm + r, i)] = cs_; p.rsin[ROPE_IDX(mm + r, i)] = sn_; } }
    }
#endif
}

__device__ __forceinline__ void late_weights(const Params& p, LAS unsigned char* lds, int gw, int NGW) {
    const int lane = threadIdx.x & 63, wid = __builtin_amdgcn_readfirstlane(threadIdx.x >> 6);
    LAS float* scr = (LAS float*)(lds + wid * 16384);
    constexpr int IGL = 8 * 16, IOS = 8 * 32, IOM = 16 * 32, IOU = 16 * 32, IUP = 16 * 128, IDN = 64 * 32;
    constexpr int NITEMS = IGL + IOS + IOM + IOU + IUP + IDN;
    for (int it = gw; it < NITEMS; it += NGW) {
        int r = it;
        if (r < IGL) { p0_item(p.in[19], 512, 512, nullptr, p.Wglut, 16, 0, scr, r, lane); continue; } r -= IGL;
        if (r < IOS) { p0_item(p.in[21], 512, 1024, nullptr, p.Wost, 32, 0, scr, r, lane); continue; } r -= IOS;
        if (r < IOM) { p0_item(p.in[10], 1024, 1024, nullptr, p.Womt, 32, 0, scr, r, lane); continue; } r -= IOM;
        if (r < IOU) { p0_item(p.in[22], 1024, 1024, nullptr, p.Woutt, 32, 0, scr, r, lane); continue; } r -= IOU;
        if (r < IUP) { p0_item(p.in[24], 1024, 4096, p.in[23], p.Wupt, 128, 0, scr, r, lane); continue; } r -= IUP;
        p0_item(p.in[25], 4096, 1024, nullptr, p.Wdnt, 32, 0, scr, r, lane);
    }
}
constexpr int LDS_RING = 131072, LDS_AUX = LDS_RING, LDS_BYTES = LDS_RING + 4096 + 256;
#ifndef MK_MODE
#define MK_MODE 0
#endif
namespace cg = cooperative_groups;
template <int K>
__device__ __forceinline__ void run_phase(const Params& p, LAS unsigned char* lds, LAS unsigned char* aux, int vcu, int G, int bx, int dry) {
    const int M = p.NB * TOK;
#ifdef MK_STAGGER_T
    if ((MK_STAGGER_MASK >> K) & 1) { const int g_ = vcu & (MK_STAGGER_G - 1);
        if (g_) { const unsigned long long t0 = __builtin_amdgcn_s_memrealtime(); while (__builtin_amdgcn_s_memrealtime() - t0 < (unsigned long long)(g_ * MK_STAGGER_T)) __builtin_amdgcn_s_sleep(2); } }
#endif
#ifdef MK_IDLE_T
    if (K == 7) { const unsigned long long t0 = __builtin_amdgcn_s_memrealtime(); while (__builtin_amdgcn_s_memrealtime() - t0 < (unsigned long long)(MK_IDLE_T)) __builtin_amdgcn_s_sleep(8); }
#endif
    if (K == 0) { p0_prologue(p, lds, vcu, G); __syncthreads(); }
    if (K == 1) {
        pg8::Gemm g{p.XB, 1024, p.W1t, 1024, M, 3328, 1024}; pg8::StaticOrder S; S.init(M, 3328, G, bx);
        EpiG1 E{p.U, p.QL, p.CKV, p.kpe, p.SGS, p.SGM, p.ssq_q, p.ssq_kv, p.ssq_kpe, p.rcos, p.rsin, p.in[9], dry};
        pg8::gemm_phase(lds, aux, g, S, E, p.ctl + 2048);
        { const int nunits = (M / 256) * 13, rem = nunits % G;
          if (rem == 0) late_weights(p, lds, bx * 8 + __builtin_amdgcn_readfirstlane(threadIdx.x >> 6), G * 8);
          else if (bx >= rem) late_weights(p, lds, (bx - rem) * 8 + __builtin_amdgcn_readfirstlane(threadIdx.x >> 6), (G - rem) * 8);
          __syncthreads(); }
    }
#ifndef MK_DUPSUB
#define MK_DUPSUB 7
#endif
#ifndef MK_P2SUB
#define MK_P2SUB 7
#endif
#define SUBON(b) ((!dry || (MK_DUPSUB & (b))) && (MK_P2SUB & (b)))
    if (K == 2) {
        if (SUBON(4) && (vcu & 1)) { ssm::ssm_phase<false>(p, lds, vcu, G); __syncthreads(); }
        if (SUBON(1)) { pg8::Gemm g{p.QL, 384, p.Wqt, 384, M, 2048, 384}; pg8::StaticOrder S; S.init(M, 2048, G, bx);
          EpiQ E{p.ssq_q, p.rcos, p.rsin, p.in[8], p.Q}; pg8::gemm_phase(lds, aux, g, S, E, p.ctl + 2048); }
        if (SUBON(2)) { pg8::Gemm g{p.CKV, 256, p.Wkvt, 256, M, 2048, 256}; pg8::StaticOrder S; S.init(M, 2048, G, bx);
          EpiKV E{p.ssq_kv, p.ssq_kpe, p.in[9], p.kpe, p.K, p.V}; pg8::gemm_phase(lds, aux, g, S, E, p.ctl + 2048); }
        if (SUBON(4) && !(vcu & 1)) ssm::ssm_phase<false>(p, lds, vcu, G);
        __syncthreads();
    }
    if (K == 3) {
#ifdef MK_P3_MIX
        if (SUBON(2) && (vcu & 1)) { ssm::ssm_phase<true>(p, lds, vcu, G); __syncthreads(); }
        if (SUBON(1)) att::attn_phase(p, lds, vcu, G);
        if (SUBON(2) && !(vcu & 1)) { __syncthreads(); ssm::ssm_phase<true>(p, lds, vcu, G); }
#else
        if (SUBON(1)) att::attn_phase(p, lds, vcu, G);
        if (SUBON(2)) ssm::ssm_phase<true>(p, lds, vcu, G);
#endif
        __syncthreads();
    }
    if (K == 4) {
        pg8::Gemm g{p.Z, 512, p.Wglut, 512, M, 512, 512}; pg8::StaticOrder S; S.init(M, 512, G, bx);
        EpiGlu E{p.Z, p.in[20], p.Z2}; pg8::gemm_phase(lds, aux, g, S, E, p.ctl + 2048);
    }
    if (K == 5) {
        { pg8::Gemm g{p.Z2, 512, p.Wost, 512, M, 1024, 512}; pg8::StaticOrder S; S.init(M, 1024, G, bx);
          EpiMix<false> E{p.SGS, p.T1}; pg8::gemm_phase(lds, aux, g, S, E, p.ctl + 2048); }
        { pg8::Gemm g{p.ATT, 1024, p.Womt, 1024, M, 1024, 1024}; pg8::StaticOrder S; S.init(M, 1024, G, bx);
          EpiMix<true> E{p.SGM, p.T1}; pg8::gemm_phase(lds, aux, g, S, E, p.ctl + 2048); }
    }
    if (K == 6) {
        pg8::Gemm g{p.T1, 1024, p.Woutt, 1024, M, 1024, 1024}; pg8::StaticOrder S; S.init(M, 1024, G, bx);
        EpiOut E{p.x, p.out, p.HB, p.ssq_h, dry}; pg8::gemm_phase(lds, aux, g, S, E, p.ctl + 2048);
    }
    if (K == 7) {
#ifdef MK_STAGGER_US
        if (vcu & 1) { const unsigned long long t0 = __builtin_amdgcn_s_memrealtime(); while (__builtin_amdgcn_s_memrealtime() - t0 < (unsigned long long)(MK_STAGGER_US * 100)) __builtin_amdgcn_s_sleep(8); }
#endif
        pg8::Gemm g{p.HB, 1024, p.Wupt, 1024, M, 4096, 1024}; pg8::StaticOrder S; S.init(M, 4096, G, bx);
        EpiUp E{p.HID}; pg8::gemm_phase(lds, aux, g, S, E, p.ctl + 2048);
    }
    if (K == 8) {
        pg8::Gemm g{p.HID, 4096, p.Wdnt, 4096, M, 1024, 4096}; pg8::StaticOrder S; S.init(M, 1024, G, bx);
        EpiDown E{p.HB, p.ssq_h, p.out}; pg8::gemm_phase(lds, aux, g, S, E, p.ctl + 2048);
    }
}
__global__ void __launch_bounds__(512, 2) mk_kernel(Params p) {
    extern __shared__ __attribute__((aligned(16))) unsigned char lds_raw[];
    LAS unsigned char* lds = (LAS unsigned char*)lds_raw;
    LAS unsigned char* aux = lds + LDS_AUX;
    const int G = gridDim.x, bx = blockIdx.x;
    const int vcu = (G % 8 == 0) ? (bx % 8) * (G / 8) + bx / 8 : bx;
#ifndef MK_PHMASK
#define MK_PHMASK 0x1ff
#endif
#define IN(k) (((MK_PHMASK >> (k)) & 1) && p.ph_lo <= (k) && (k) < p.ph_hi)
#if MK_MODE == 0
#ifndef MK_CGSYNC
#define MK_CGSYNC 0
#endif
    volatile LAS unsigned* bst = (volatile LAS unsigned*)(lds + LDS_AUX + 4096);
    if (threadIdx.x < 2) bst[threadIdx.x] = 0u;
    __syncthreads();
    XcdBarrier xbar = xcd_barrier_post(p.ctl + 4096, bst);
#ifndef MK_PLAIN_LAUNCH
    if (p.NB < 0) cg::this_grid().sync();
#endif
#ifndef MK_BAR
#define MK_BAR 2
#endif
    unsigned bar_epoch = 0;
#define SEAMX() do { if (MK_CGSYNC) cg::this_grid().sync(); else if (MK_BAR == 1) ctr_barrier(p.ctl + 1024, p.ctl + 1088, bar_epoch); else xcd_barrier(xbar); } while (0)
#define SEAM(k) do { if (IN(k) && IN((k) + 1)) SEAMX(); } while (0)
#else
#define SEAMX() do { } while (0)
#define SEAM(k) do { } while (0)
#endif
#ifndef MK_DUP
#define MK_DUP -1
#endif
#ifdef MK_PHPROBE
#define PHSTAMP(k) do { if (blockIdx.x == 0 && threadIdx.x == 0) { const unsigned long long n_ = __builtin_amdgcn_s_memrealtime(); ((float*)(p.ctl + 2048))[16 + (k)] = (float)(n_ - ph_t0) * 0.01f; ph_t0 = n_; } } while (0)
    unsigned long long ph_t0 = __builtin_amdgcn_s_memrealtime();
#else
#define PHSTAMP(k) do { } while (0)
#endif
#define PHASE(k) do { if (IN(k)) { run_phase<k>(p, lds, aux, vcu, G, bx, 0); if (MK_DUP == (k)) { SEAMX(); run_phase<k>(p, lds, aux, vcu, G, bx, 1); } } SEAM(k); PHSTAMP(k); } while (0)
    PHASE(0); PHASE(1); PHASE(2); PHASE(3); PHASE(4); PHASE(5); PHASE(6); PHASE(7); PHASE(8);
#ifdef MK_TPROBE
    SEAMX();
    if (blockIdx.x == 0 && threadIdx.x == 0) p.out[0] += 12.f * logf(((const float*)(p.ctl + 2048))[MK_TPROBE] * MK_TPROBE_SCALE);
#endif
#undef IN
#undef SEAM
}
constexpr int N_PHASES = 9;

static size_t al(size_t v) { return (v + 255) & ~(size_t)255; }
static Params make_params(void* const* d_in, float* out, unsigned char* ws, int NB, int b0, bool alias, unsigned char* gates) {
    Params p{};
    for (int i = 0; i < 26; ++i) p.in[i] = (const float*)d_in[i];
    p.out = out; p.NB = NB; p.ph_lo = 0; p.ph_hi = N_PHASES; p.pad = 0;
    p.x = (const float*)d_in[0] + (size_t)b0 * TOK * 1024; p.pos = (const int*)d_in[1] + (size_t)b0 * TOK;
    for (int i = 0; i < 32; ++i) p.inv_freq[i] = powf(10000.0f, -(float)i / 32.0f);
    const size_t M = (size_t)NB * TOK; size_t off = 0;
    auto take = [&](size_t bytes) { unsigned char* q = ws + off; off += al(bytes); return q; };
    p.ctl = (unsigned*)take(1 << 20);
    p.ssq_q = (float*)take(M * 4); p.ssq_kv = (float*)take(M * 4); p.ssq_kpe = (float*)take(M * 4); p.ssq_h = (float*)take(M * 4); p.inv_x = (float*)take(M * 4);
    p.sloc = (float*)take((size_t)NB * 32 * 16 * 128 * 4);
    p.rcos = (float*)take(M * 32 * 4); p.rsin = (float*)take(M * 32 * 4);
    p.kpe = (bf16_t*)take(M * 64 * 2);
    p.W1t = (bf16_t*)take((size_t)3328 * 1024 * 2); p.Wqt = (bf16_t*)take((size_t)2048 * 384 * 2); p.Wkvt = (bf16_t*)take((size_t)2048 * 256 * 2);
    p.Wglut = (bf16_t*)take((size_t)512 * 512 * 2); p.Wost = (bf16_t*)take((size_t)1024 * 512 * 2); p.Womt = (bf16_t*)take((size_t)1024 * 1024 * 2);
    p.Woutt = (bf16_t*)take((size_t)1024 * 1024 * 2); p.Wupt = (bf16_t*)take((size_t)4096 * 1024 * 2); p.Wdnt = (bf16_t*)take((size_t)1024 * 4096 * 2);
    if (alias) {
        unsigned char* rXB = take(M * 2048); unsigned char* rU = take(M * 1024); unsigned char* rQL = take(M * 1280); unsigned char* rQKV = take(M * 8192); unsigned char* rT1 = take(M * 2048);
        p.XB = (bf16_t*)rXB; p.ATT = (bf16_t*)rXB; p.HB = (bf16_t*)rXB;
        p.U = (bf16_t*)rU; p.Z2 = (bf16_t*)rU;
        p.QL = (bf16_t*)rQL; p.CKV = (bf16_t*)(rQL + M * 768); p.Z = (bf16_t*)rQL;
        p.Q = (bf16_t*)rQKV; p.K = (bf16_t*)(rQKV + M * 3072); p.V = (bf16_t*)(rQKV + M * 6144); p.HID = (bf16_t*)rQKV;
        p.T1 = (bf16_t*)rT1;
        p.SGS = (bf16_t*)out; p.SGM = (bf16_t*)((unsigned char*)out + M * 2048);
    } else {
        p.XB = (bf16_t*)take(M * 2048); p.ATT = (bf16_t*)take(M * 2048); p.HB = (bf16_t*)take(M * 2048);
        p.U = (bf16_t*)take(M * 1024); p.Z2 = (bf16_t*)take(M * 1024); p.Z = (bf16_t*)take(M * 1024);
        p.QL = (bf16_t*)take(M * 768); p.CKV = (bf16_t*)take(M * 512);
        p.Q = (bf16_t*)take(M * 3072); p.K = (bf16_t*)take(M * 3072); p.V = (bf16_t*)take(M * 2048); p.HID = (bf16_t*)take(M * 8192);
        p.T1 = (bf16_t*)take(M * 2048);
        p.SGS = (bf16_t*)gates; p.SGM = (bf16_t*)(gates + M * 2048);
    }
    return p;
}
static int g_grid = 0;
static int mk_grid() {
    if (g_grid == 0) {
        int dev = 0, cus = 0, per_cu = 0;
        hipGetDevice(&dev); hipDeviceGetAttribute(&cus, hipDeviceAttributeMultiprocessorCount, dev);
        hipFuncSetAttribute((const void*)mk_kernel, hipFuncAttributeMaxDynamicSharedMemorySize, LDS_BYTES);
        hipOccupancyMaxActiveBlocksPerMultiprocessor(&per_cu, (const void*)mk_kernel, 512, LDS_BYTES);
        (void)hipGetLastError();
        g_grid = (per_cu >= 1) ? cus : -1;
        if (g_grid < 0) fprintf(stderr, "mk: occupancy query reports %d blocks per CU\n", per_cu);
    }
    return g_grid;
}
static void mk_launch_phases(Params p, int lo, int hi, bool coop, hipStream_t stream) {
    const int grid = mk_grid(); if (grid <= 0) return;
    p.ph_lo = lo; p.ph_hi = hi;
    if (coop) { void* args[] = {&p}; hipError_t e = hipLaunchCooperativeKernel((const void*)mk_kernel, dim3(grid), dim3(512), args, LDS_BYTES, stream);
        if (e != hipSuccess) fprintf(stderr, "mk: cooperative launch failed: %s\n", hipGetErrorString(e)); }
    else hipLaunchKernelGGL(mk_kernel, dim3(grid), dim3(512), LDS_BYTES, stream, p);
}
extern "C" void kernel_launch(void* const* d_in, const int* in_sizes, int n_in, void* d_out, int out_size, void* d_ws, size_t ws_size, hipStream_t stream) {
    Params p = make_params(d_in, (float*)d_out, (unsigned char*)d_ws, 8, 0, true, nullptr);
    hipMemsetAsync(d_ws, 0, 65536, stream);
#if MK_MODE == 0
#ifndef MK_PLAIN_LAUNCH
    mk_launch_phases(p, 0, N_PHASES, true, stream);
#else
    mk_launch_phases(p, 0, N_PHASES, false, stream);
#endif
#else
    for (int ph = 0; ph < N_PHASES; ++ph) mk_launch_phases(p, ph, ph + 1, false, stream);
#endif
}
```

```cpp
#include <hip/hip_runtime.h>
#include <hip/hip_cooperative_groups.h>
#include <cstdint>
#include <cstdio>
#include <cmath>
#define MK_MODE 0
#define MK_QFRAG 1
#define MK_ROPEFRAG 1
#define MK_UFRAG 1
#define MK_ATT_OSTAGE 1
#define MK_ATT_EARLY_DMA 1
#define MK_MIXPAIR 1
#define MK_DOWNPAIR 1
#define MK_GLUPAIR 1
#define MK_OUTPAIR 1
#define MK_XPAIR 1
#define MK_ZFRAG 1
#define MK_HIDSUB 1
#define MK_HBSUB 1
#define MK_GATESUB 1
#define MK_FIRST_CHECK 1
#define LAS __attribute__((address_space(3)))
#ifdef MK_ROPEFRAG
#define ROPE_IDX(row, i) ((size_t)((row) >> 5) * 1024 + (size_t)(((i) >> 2) * 128 + ((row) & 31) * 4 + ((i) & 3)))
#else
#define ROPE_IDX(row, i) ((size_t)(row) * 32 + (i))
#endif
typedef unsigned short bf16_t;
typedef short bf16x8 __attribute__((ext_vector_type(8)));
typedef short s16x4 __attribute__((ext_vector_type(4)));
typedef float f32x4 __attribute__((ext_vector_type(4)));
typedef float f32x16 __attribute__((ext_vector_type(16)));
typedef unsigned u32x4 __attribute__((ext_vector_type(4)));
typedef unsigned u32x2 __attribute__((ext_vector_type(2)));

constexpr int TOK = 4096;
constexpr float LOG2E = 1.4426950408889634f;
constexpr float QSCALE = 0.07216878364870322f * LOG2E;

struct Params {
    const float* in[26];
    float* out;
    unsigned* ctl;
    float *ssq_q, *ssq_kv, *ssq_kpe, *ssq_h, *inv_x;
    float* sloc;
    float *rcos, *rsin;
    bf16_t* kpe;
    bf16_t *W1t, *Wqt, *Wkvt, *Wglut, *Wost, *Womt, *Woutt, *Wupt, *Wdnt;
    bf16_t *XB, *U, *QL, *CKV, *Q, *K, *V, *ATT, *Z, *Z2, *T1, *HB, *HID, *SGS, *SGM;
    const float* x; const int* pos;
    int NB, ph_lo, ph_hi, pad;
    float inv_freq[32];
};

typedef float f32x2_t __attribute__((ext_vector_type(2))); typedef __bf16 bf16x2_t __attribute__((ext_vector_type(2)));
__device__ __forceinline__ unsigned cvt_pk_bf16(float lo, float hi) { f32x2_t v = {lo, hi}; bf16x2_t b = __builtin_convertvector(v, bf16x2_t); return __builtin_bit_cast(unsigned, b); }
__device__ __forceinline__ u32x4 pack8(const f32x4 a, const f32x4 b) { u32x4 w; w.x = cvt_pk_bf16(a[0], a[1]); w.y = cvt_pk_bf16(a[2], a[3]); w.z = cvt_pk_bf16(b[0], b[1]); w.w = cvt_pk_bf16(b[2], b[3]); return w; }
__device__ __forceinline__ float bf_lo(unsigned w) { return __uint_as_float(w << 16); }
__device__ __forceinline__ float bf_hi(unsigned w) { return __uint_as_float(w & 0xffff0000u); }
__device__ __forceinline__ void unpack8(const u32x4 w, f32x4& a, f32x4& b) { a = (f32x4){bf_lo(w.x), bf_hi(w.x), bf_lo(w.y), bf_hi(w.y)}; b = (f32x4){bf_lo(w.z), bf_hi(w.z), bf_lo(w.w), bf_hi(w.w)}; }
__device__ __forceinline__ float fast_sigmoid(float v) { return __builtin_amdgcn_rcpf(1.f + __builtin_amdgcn_exp2f(-v * LOG2E)); }
__device__ __forceinline__ float fast_tanh(float v) { const float e = __builtin_amdgcn_exp2f(-2.f * LOG2E * fabsf(v)); const float t = (1.f - e) * __builtin_amdgcn_rcpf(1.f + e); return v < 0.f ? -t : t; }
__device__ __forceinline__ float gelu_t(float x) { return 0.5f * x * (1.f + fast_tanh(0.7978845608028654f * (x + 0.044715f * x * x * x))); }
__host__ __device__ __forceinline__ int dperm(int s) { const int wc = s >> 5, fq = (s >> 3) & 3, n = (s >> 2) & 1, j = s & 3; return 32 * n + 16 * wc + 4 * fq + j; }

namespace pg8 {
constexpr int BM = 256, BK = 64, HALF = 128, HTB = HALF * BK * 2, STAGE_BYTES = 8 * HTB, NXCD = 8, WGM = 8;
__host__ __device__ __forceinline__ int lds_byte(int r, int c) { const int st = (r >> 4) * 2 + (c >> 5), rr = r & 15, cc = c & 31, ob = rr * 64 + cc * 2; return st * 1024 + (ob ^ (((ob >> 9) & 1) << 5)); }
__host__ __device__ __forceinline__ void stage_rc(int b, int& R, int& C) { const int st = b / 1024, sb = b % 1024, swz = sb ^ (((sb >> 9) & 1) << 5); R = (st >> 1) * 16 + swz / 64; C = (st & 1) * 32 + (swz % 64) / 2; }
__host__ __device__ __forceinline__ int perm32(int rho) { const int n = rho >> 4, i = rho & 15; return 8 * (i >> 2) + 4 * n + (i & 3); }
struct Unit { int pm, pn; };
struct Gemm { const bf16_t* A; int lda; const bf16_t* Bt; int ldb; int M, N, K; };
struct StaticOrder {
    int nM, nN, nwg, G, c;
    __device__ void init(int M, int N, int G_, int c_) { nM = M / BM; nN = N / BM; nwg = nM * nN; G = G_; c = c_; }
    __device__ bool next(int i, Unit& u) const {
        const long L = (long)i * G + c; if (L >= nwg) return false;
        int wgid = (int)L; { const int q = nwg / NXCD, r = nwg % NXCD, xcd = wgid % NXCD, off = wgid / NXCD; wgid = (xcd < r ? xcd * (q + 1) : r * (q + 1) + (xcd - r) * q) + off; }
        const int nig = WGM * nN, gid = wgid / nig, fm = gid * WGM, gsz = (nM - fm) < WGM ? (nM - fm) : WGM;
        u.pm = fm + ((wgid % nig) % gsz); u.pn = (wgid % nig) / gsz; return true;
    }
};
typedef f32x4 Acc[2][2][4][2];

template <class Epi>
__device__ __forceinline__ void gemm_phase(LAS unsigned char* lds, LAS unsigned char* aux, const Gemm g, const StaticOrder& S, const Epi& E, unsigned* gprobe = nullptr) {
    int tid = threadIdx.x; asm volatile("" : "+v"(tid));
    const int wid = __builtin_amdgcn_readfirstlane(tid >> 6), lane = tid & 63, wr = wid >> 2, wc = wid & 3, fr = lane & 15, fq = lane >> 4;
    const int K = g.K, nt = K / BK;
    unsigned voffA[2], voffB[2];
#pragma unroll
    for (int i = 0; i < 2; ++i) { int R, C; stage_rc(tid * 16 + i * 8192, R, C); const int Rb = (Epi::CM ? (R >> 5) * 64 : (R & ~31)) + perm32(R & 31);
        voffA[i] = (int)Epi::GA == 2 ? (unsigned)((((R >> 4) * (g.K >> 5) + (C >> 5)) * 512 + (R & 15) * 32 + (C & 31)) * 2)
                 : (int)Epi::GA == 1 ? (unsigned)(((C >> 4) * TOK * 16 + R * 16 + (C & 15)) * 2) : (unsigned)(R * g.lda + C) * 2u; voffB[i] = (unsigned)(Rb * g.ldb + C) * 2u; }
    const size_t kstep = (size_t)(BK * 2), kstepA = (int)Epi::GA == 2 ? (size_t)2048 : (int)Epi::GA == 1 ? (size_t)4 * TOK * 16 * 2 : (size_t)(BK * 2);
    const size_t hstepA = (int)Epi::GA == 2 ? (size_t)(HALF / 16) * (g.K >> 5) * 1024 : (int)Epi::GA == 1 ? (size_t)HALF * 16 * 2 : (size_t)HALF * g.lda * 2, hstepB = (size_t)(Epi::CM ? 32 : HALF) * g.ldb * 2;
    const size_t tstepA = 2 * hstepA, tstepB = (size_t)BM * g.ldb * 2;
#define PG8_ABASE(pm) ((const char*)g.A + ((int)Epi::GA == 1 ? ((size_t)((pm) >> 4) * 32 * TOK * 16 + (size_t)((pm) & 15) * 256 * 16) * 2 : (size_t)(pm) * tstepA))
    const unsigned ldsw = (unsigned)wid * 1024u;
    const int aoff = lds_byte(wr * 64 + fr, fq * 8), boff = lds_byte(wc * 32 + fr, fq * 8);
#define PG8_SA(b, h) (((b) * 2 + (h)) * HTB)
#define PG8_SB(b, h) ((4 + (b) * 2 + (h)) * HTB)
#define PG8_STAGE(bufoff, gbase, voff) do { _Pragma("unroll") for (int _i = 0; _i < 2; ++_i) \
        __builtin_amdgcn_global_load_lds((const unsigned*)((const char*)(gbase) + (voff)[_i]), (LAS unsigned*)(lds + (bufoff) + ldsw + _i * 8192), 16, 0, 0); } while (0)
#define PG8_LDA(dst, b, h) do { _Pragma("unroll") for (int m = 0; m < 4; ++m) _Pragma("unroll") for (int k = 0; k < 2; ++k) dst[m][k] = *(const LAS bf16x8*)(lds + PG8_SA(b, h) + aoff + m * 2048 + k * 1024); } while (0)
#define PG8_LDB(dst, b, h) do { _Pragma("unroll") for (int n = 0; n < 2; ++n) _Pragma("unroll") for (int k = 0; k < 2; ++k) dst[n][k] = *(const LAS bf16x8*)(lds + PG8_SB(b, h) + boff + n * 2048 + k * 1024); } while (0)
#define PG8_MMA(ai, bj, At, Bt) do { __builtin_amdgcn_s_setprio(1); _Pragma("unroll") for (int m = 0; m < 4; ++m) _Pragma("unroll") for (int n = 0; n < 2; ++n) _Pragma("unroll") for (int k = 0; k < 2; ++k) \
        acc[ai][bj][m][n] = __builtin_amdgcn_mfma_f32_16x16x32_bf16(Bt[n][k], At[m][k], acc[ai][bj][m][n], 0, 0, 0); __builtin_amdgcn_s_setprio(0); } while (0)
#define PG8_WAIT_V(n) asm volatile("s_waitcnt vmcnt(" #n ")" ::: "memory")
#define PG8_WAIT_VN(n) asm volatile("s_waitcnt vmcnt(%0)" :: "n"(n) : "memory")
#define PG8_WAIT_L(n) asm volatile("s_waitcnt lgkmcnt(" #n ")" ::: "memory")
#define PG8_BAR __builtin_amdgcn_s_barrier()
#define PG8_SCHED __builtin_amdgcn_sched_barrier(0)
    Unit cur, nxt; int ui = 0;
#ifdef MK_GPROBE
    unsigned long long gacc[4] = {0, 0, 0, 0};
    const unsigned long long gck0 = __builtin_amdgcn_s_memtime(), grt0 = __builtin_amdgcn_s_memrealtime();
#endif
    if (!S.next(0, cur)) return;
    Acc acc;
#pragma unroll
    for (int a = 0; a < 2; ++a)
#pragma unroll
        for (int b = 0; b < 2; ++b)
#pragma unroll
            for (int m = 0; m < 4; ++m)
#pragma unroll
                for (int n = 0; n < 2; ++n) acc[a][b][m][n] = (f32x4){0.f, 0.f, 0.f, 0.f};
    bf16x8 At[4][2], B0[2][2], B1[2][2];
    const char* cA = PG8_ABASE(cur.pm); const char* cB = (const char*)g.Bt + (size_t)cur.pn * tstepB;
    PG8_STAGE(PG8_SB(0, 0), cB, voffB); PG8_STAGE(PG8_SB(0, 1), cB + hstepB, voffB); PG8_STAGE(PG8_SA(0, 0), cA, voffA); PG8_STAGE(PG8_SA(0, 1), cA + hstepA, voffA);
    if (wr == 1) PG8_BAR;
    PG8_WAIT_V(2); PG8_BAR;
    PG8_STAGE(PG8_SB(1, 0), cB + kstep, voffB); PG8_STAGE(PG8_SA(1, 0), cA + kstepA, voffA); PG8_STAGE(PG8_SB(1, 1), cB + hstepB + kstep, voffB);
    PG8_WAIT_V(6); PG8_BAR;
    for (;;) {
        const bool has_next = S.next(ui + 1, nxt);
        const char* nA = has_next ? PG8_ABASE(nxt.pm) : cA; const char* nB = has_next ? (const char*)g.Bt + (size_t)nxt.pn * tstepB : cB;
#ifdef MK_GPROBE
        unsigned long long g_t0 = __builtin_amdgcn_s_memtime();
#endif
#pragma unroll 1
        for (int t = 0; t < nt; t += 2) {
#ifdef MK_GPROBE
            if (t == 2) { const unsigned long long n_ = __builtin_amdgcn_s_memtime(); gacc[0] += n_ - g_t0; g_t0 = n_; }
#endif
            const bool last = (t == nt - 2);
            const char* a1 = cA + (size_t)(t + 1) * kstepA;
            const char* a2 = last ? nA : cA + (size_t)(t + 2) * kstepA; const char* b2 = last ? nB : cB + (size_t)(t + 2) * kstep;
            const char* a3 = a2 + kstepA; const char* b3 = b2 + kstep;
            PG8_LDB(B0, 0, 0); PG8_LDB(B1, 0, 1); PG8_SCHED; PG8_LDA(At, 0, 0); PG8_STAGE(PG8_SA(1, 1), a1 + hstepA, voffA);
            if (t == 0 && ui > 0) PG8_WAIT_VN(8 + Epi::NVM); else PG8_WAIT_V(8);
            PG8_WAIT_L(0); PG8_BAR; PG8_MMA(0, 0, At, B0); PG8_MMA(0, 1, At, B1); PG8_BAR; PG8_SCHED;
            PG8_LDA(At, 0, 1); PG8_STAGE(PG8_SB(0, 0), b2, voffB); PG8_STAGE(PG8_SB(0, 1), b2 + hstepB, voffB); PG8_STAGE(PG8_SA(0, 0), a2, voffA);
            if (t == 0 && ui > 0) PG8_WAIT_VN(8 + Epi::NVM); else PG8_WAIT_V(8);
            PG8_WAIT_L(0); PG8_BAR; PG8_MMA(1, 0, At, B0); PG8_MMA(1, 1, At, B1); PG8_BAR; PG8_SCHED;
            PG8_LDB(B0, 1, 0); PG8_LDB(B1, 1, 1); PG8_SCHED; PG8_LDA(At, 1, 0); PG8_STAGE(PG8_SA(0, 1), a2 + hstepA, voffA);
            PG8_WAIT_V(8); PG8_WAIT_L(0); PG8_BAR; PG8_MMA(0, 0, At, B0); PG8_MMA(0, 1, At, B1); PG8_BAR; PG8_SCHED;
            PG8_LDA(At, 1, 1); PG8_STAGE(PG8_SB(1, 0), b3, voffB); PG8_STAGE(PG8_SB(1, 1), b3 + hstepB, voffB); PG8_STAGE(PG8_SA(1, 0), a3, voffA);
            PG8_WAIT_V(8); PG8_WAIT_L(0); PG8_BAR; PG8_MMA(1, 0, At, B0); PG8_MMA(1, 1, At, B1); PG8_BAR; PG8_SCHED;
        }
#ifdef MK_GPROBE
        { const unsigned long long n_ = __builtin_amdgcn_s_memtime(); gacc[1] += n_ - g_t0; g_t0 = n_; }
#endif
        if (wr == 0) PG8_BAR;
        E(acc, cur, wr, wc, fr, fq, aux, wid, lane);
#ifdef MK_GPROBE
        { const unsigned long long n_ = __builtin_amdgcn_s_memtime(); gacc[2] += n_ - g_t0; ++gacc[3]; }
#endif
        if (!has_next) break;
#pragma unroll
        for (int a = 0; a < 2; ++a)
#pragma unroll
            for (int b = 0; b < 2; ++b)
#pragma unroll
                for (int m = 0; m < 4; ++m)
#pragma unroll
                    for (int n = 0; n < 2; ++n) acc[a][b][m][n] = (f32x4){0.f, 0.f, 0.f, 0.f};
        cur = nxt; cA = nA; cB = nB; ++ui;
        if (wr == 1) PG8_BAR;
    }
    PG8_WAIT_V(0);
    PG8_BAR;
#ifdef MK_GPROBE
    if (g.N == MK_GPROBE_N && g.K == MK_GPROBE_K && blockIdx.x == 0 && tid == MK_GPROBE_TID) { float* tp = (float*)gprobe;
        tp[0] = (float)gacc[0] / (float)gacc[3]; tp[1] = (float)gacc[1] / (float)gacc[3]; tp[2] = (float)gacc[2] / (float)gacc[3];
        tp[3] = (float)(__builtin_amdgcn_s_memtime() - gck0) / (float)(__builtin_amdgcn_s_memrealtime() - grt0) * 100.f; tp[4] = (float)(__builtin_amdgcn_s_memrealtime() - grt0) * 0.01f; }
#endif
#undef PG8_ABASE
#undef PG8_SA
#undef PG8_SB
#undef PG8_STAGE
#undef PG8_LDA
#undef PG8_LDB
#undef PG8_MMA
#undef PG8_SCHED
}
}
using pg8::Acc; using pg8::Unit;

#define EPI_ARGS const Acc& acc, const Unit& u, int wr, int wc, int fr_, int fq_, LAS unsigned char* aux, int wid, int lane
#define EPI_OPAQUE int fr = fr_, fq = fq_; asm volatile("" : "+v"(fr), "+v"(fq));
#define ROWLOOP for (int ai = 0; ai < 2; ++ai) _Pragma("unroll") for (int m = 0; m < 4; ++m)

#ifndef MK_SWAP_REDUCE
__device__ __forceinline__ float fq_sum(float s) { s += __shfl_xor(s, 16); s += __shfl_xor(s, 32); return s; }
#else
__device__ __forceinline__ float fq_sum(float s) {
    { auto a = __builtin_amdgcn_permlane16_swap(__float_as_uint(s), __float_as_uint(s), false, false); s = __uint_as_float(a[0]) + __uint_as_float(a[1]); }
    { auto b = __builtin_amdgcn_permlane32_swap(__float_as_uint(s), __float_as_uint(s), false, false); s = __uint_as_float(b[0]) + __uint_as_float(b[1]); }
    return s; }
#endif
__device__ __forceinline__ float sq4(const f32x4 v) { return (v[0] * v[0] + v[1] * v[1]) + (v[2] * v[2] + v[3] * v[3]); }

struct EpiG1 {
    static constexpr bool GA = false, CM = false; static constexpr int NVM = 0;
    bf16_t *U, *QL, *CKV, *KPE, *SGS, *SGM; float *ssq_q, *ssq_kv, *ssq_kpe; const float *rcos, *rsin; const float* k_norm; int dry;
    __device__ __forceinline__ void operator()(EPI_ARGS) const {
        EPI_OPAQUE
        const int pn = u.pn, cw = wc * 32 + 8 * fq;
#pragma unroll
        ROWLOOP {
            const int row = u.pm * 256 + ai * 128 + wr * 64 + m * 16 + fr;
            f32x4 v[2][2];
#pragma unroll
            for (int bj = 0; bj < 2; ++bj)
#pragma unroll
                for (int n = 0; n < 2; ++n) v[bj][n] = acc[ai][bj][m][n];
            if (pn < 2) {
#pragma unroll
#ifdef MK_UFRAG
                for (int bj = 0; bj < 2; ++bj) { const int c = pn * 256 + bj * 128 + cw, bb = row / TOK, l = row % TOK;
                    *(u32x4*)(U + ((size_t)(bb * 32 + (c >> 4)) * TOK + l) * 16 + (c & 15)) = pack8(v[bj][0], v[bj][1]); }
#else
                for (int bj = 0; bj < 2; ++bj) *(u32x4*)(U + (size_t)row * 512 + pn * 256 + bj * 128 + cw) = pack8(v[bj][0], v[bj][1]);
#endif
            } else if (pn == 2) {
#pragma unroll
                for (int bj = 0; bj < 2; ++bj) *(u32x4*)(QL + (size_t)row * 384 + bj * 128 + cw) = pack8(v[bj][0], v[bj][1]);
                const float q = fq_sum(sq4(v[0][0]) + sq4(v[0][1]) + sq4(v[1][0]) + sq4(v[1][1]));
                if (fq == 0 && !dry) atomicAdd(ssq_q + row, q);
            } else if (pn == 3) {
                *(u32x4*)(QL + (size_t)row * 384 + 256 + cw) = pack8(v[0][0], v[0][1]);
                *(u32x4*)(CKV + (size_t)row * 256 + cw) = pack8(v[1][0], v[1][1]);
                const float q = fq_sum(sq4(v[0][0]) + sq4(v[0][1])), k = fq_sum(sq4(v[1][0]) + sq4(v[1][1]));
                if (fq == 0 && !dry) { atomicAdd(ssq_q + row, q); atomicAdd(ssq_kv + row, k); }
            } else if (pn == 4) {
                *(u32x4*)(CKV + (size_t)row * 256 + 128 + cw) = pack8(v[0][0], v[0][1]);
                const float k = fq_sum(sq4(v[0][0]) + sq4(v[0][1]));
                if (fq == 0 && !dry) atomicAdd(ssq_kv + row, k);
                if (wc < 2) {
                    const int i0 = 16 * wc + 4 * fq;
                    const f32x4 c = *(const f32x4*)(rcos + ROPE_IDX(row, i0)), sn = *(const f32x4*)(rsin + ROPE_IDX(row, i0));
                    const f32x4 g1 = *(const f32x4*)(k_norm + 128 + i0), g2 = *(const f32x4*)(k_norm + 160 + i0);
                    const f32x4 x1 = v[1][0] * g1, x2 = v[1][1] * g2;
                    const f32x4 r1 = x1 * c - x2 * sn, r2 = x2 * c + x1 * sn;
                    *(u32x4*)(KPE + (size_t)row * 64 + cw) = pack8(r1, r2);
                    const float p = fq_sum(sq4(v[1][0]) + sq4(v[1][1]));
                    if (fq == 0 && !dry) atomicAdd(ssq_kpe + row, p);
                }
            } else {
                bf16_t* G = (pn < 9) ? SGS : SGM; const int c0 = ((pn < 9) ? (pn - 5) : (pn - 9)) * 256;
#pragma unroll
                for (int bj = 0; bj < 2; ++bj) { f32x4 a, b;
#pragma unroll
                    for (int j = 0; j < 4; ++j) { a[j] = fast_sigmoid(v[bj][0][j]); b[j] = fast_sigmoid(v[bj][1][j]); }
#ifdef MK_GATESUB
                    { const int c = c0 + bj * 128 + cw; *(u32x4*)(G + ((size_t)(row >> 4) * 32 + (c >> 5)) * 512 + (row & 15) * 32 + (c & 31)) = pack8(a, b); } }
#else
                    *(u32x4*)(G + (size_t)row * 1024 + c0 + bj * 128 + cw) = pack8(a, b); }
#endif
            }
        }
    }
};

__device__ __forceinline__ void row_reduce4(const float (&part)[2][4], float (&tot)[2][4], int wr, int wc, int fr, int fq, LAS unsigned char* aux) {
    LAS float* red = (LAS float*)aux;
#pragma unroll
    ROWLOOP { const float s = fq_sum(part[ai][m]); if (fq == 0) red[(ai * 128 + wr * 64 + m * 16 + fr) * 4 + wc] = s; }
    asm volatile("s_waitcnt lgkmcnt(0)" ::: "memory"); __builtin_amdgcn_s_barrier(); asm volatile("" ::: "memory");
#pragma unroll
    ROWLOOP { const f32x4 t = *(const LAS f32x4*)(red + (ai * 128 + wr * 64 + m * 16 + fr) * 4); tot[ai][m] = (t[0] + t[1]) + (t[2] + t[3]); }
    asm volatile("s_waitcnt lgkmcnt(0)" ::: "memory"); __builtin_amdgcn_s_barrier(); asm volatile("" ::: "memory");
}

__device__ __forceinline__ void row_reduce4h(const float (&part)[4], float (&tot)[4], int ai, int wr, int wc, int fr, int fq, LAS unsigned char* aux) {
    LAS float* red = (LAS float*)aux;
#pragma unroll
    for (int m = 0; m < 4; ++m) { const float s = fq_sum(part[m]); if (fq == 0) red[(ai * 128 + wr * 64 + m * 16 + fr) * 4 + wc] = s; }
    asm volatile("s_waitcnt lgkmcnt(0)" ::: "memory"); __builtin_amdgcn_s_barrier(); asm volatile("" ::: "memory");
#pragma unroll
    for (int m = 0; m < 4; ++m) { const f32x4 t = *(const LAS f32x4*)(red + (ai * 128 + wr * 64 + m * 16 + fr) * 4); tot[m] = (t[0] + t[1]) + (t[2] + t[3]); }
    asm volatile("s_waitcnt lgkmcnt(0)" ::: "memory"); __builtin_amdgcn_s_barrier(); asm volatile("" ::: "memory");
}
struct EpiQ {
    static constexpr bool GA = false, CM = false; static constexpr int NVM = 0;
    const float* ssq_q; const float *rcos, *rsin; const float* q_norm; bf16_t* Q;
    __device__ __forceinline__ void operator()(EPI_ARGS) const {
        EPI_OPAQUE
        const int h = u.pn, cw = wc * 32 + 8 * fq;
        float part[2][4], tot[2][4], rs[2][4];
#pragma unroll
        ROWLOOP { const int row = u.pm * 256 + ai * 128 + wr * 64 + m * 16 + fr; const float s = __builtin_amdgcn_rsqf(ssq_q[row] * (1.f / 384.f) + 1e-6f); rs[ai][m] = s;
            part[ai][m] = (sq4(acc[ai][0][m][0]) + sq4(acc[ai][0][m][1]) + sq4(acc[ai][1][m][0]) + sq4(acc[ai][1][m][1])) * s * s; }
        row_reduce4(part, tot, wr, wc, fr, fq, aux);
        const f32x4 g0 = *(const f32x4*)(q_norm + cw), g1 = *(const f32x4*)(q_norm + cw + 4);
        const int i0 = 16 * (wc & 1) + 4 * fq;
        const f32x4 gr1 = *(const f32x4*)(q_norm + 128 + i0), gr2 = *(const f32x4*)(q_norm + 160 + i0);
#pragma unroll
        ROWLOOP { const int row = u.pm * 256 + ai * 128 + wr * 64 + m * 16 + fr;
            const float f = rs[ai][m] * __builtin_amdgcn_rsqf(tot[ai][m] * (1.f / 192.f) + 1e-6f) * QSCALE;
            const int b = row / TOK, l = row % TOK;
#ifdef MK_QFRAG
            bf16_t* qblk = Q + ((size_t)(b * 8 + h) * TOK + (l & ~31)) * 192 + (l & 31) * 16 + (fq & 1) * 8;
            *(u32x4*)(qblk + (2 * wc + (fq >> 1)) * 512) = pack8(acc[ai][0][m][0] * f * g0, acc[ai][0][m][1] * f * g1);
            if (wc < 2) *(u32x4*)(qblk + (8 + 2 * wc + (fq >> 1)) * 512) = pack8(acc[ai][1][m][0] * f * gr1, acc[ai][1][m][1] * f * gr2);
#else
            bf16_t* qrow = Q + ((size_t)(b * 8 + h) * TOK + l) * 192;
            *(u32x4*)(qrow + cw) = pack8(acc[ai][0][m][0] * f * g0, acc[ai][0][m][1] * f * g1);
            if (wc < 2) *(u32x4*)(qrow + 128 + cw) = pack8(acc[ai][1][m][0] * f * gr1, acc[ai][1][m][1] * f * gr2);
#endif
        }
    }
};

struct EpiKV {
    static constexpr bool GA = false, CM = false; static constexpr int NVM = 0;
    const float *ssq_kv, *ssq_kpe; const float* k_norm; const bf16_t* KPE; bf16_t *K, *V;
    __device__ __forceinline__ void operator()(EPI_ARGS) const {
        EPI_OPAQUE
        const int h = u.pn, cw = wc * 32 + 8 * fq;
        float part[2][4], tot[2][4], rs[2][4], skpe[2][4];
#pragma unroll
        ROWLOOP { const int row = u.pm * 256 + ai * 128 + wr * 64 + m * 16 + fr; const float s = __builtin_amdgcn_rsqf(ssq_kv[row] * (1.f / 256.f) + 1e-6f); rs[ai][m] = s;
            skpe[ai][m] = ssq_kpe[row];
            part[ai][m] = (sq4(acc[ai][0][m][0]) + sq4(acc[ai][0][m][1])) * s * s; }
        row_reduce4(part, tot, wr, wc, fr, fq, aux);
        const f32x4 g0 = *(const f32x4*)(k_norm + cw), g1 = *(const f32x4*)(k_norm + cw + 4);
#pragma unroll
        for (int ai = 0; ai < 2; ++ai) {
            u32x4 kp[4];
            if (wc < 2) {
#pragma unroll
                for (int m = 0; m < 4; ++m) kp[m] = *(const u32x4*)(KPE + (size_t)(u.pm * 256 + ai * 128 + wr * 64 + m * 16 + fr) * 64 + cw); }
#pragma unroll
            for (int m = 0; m < 4; ++m) { const int row = u.pm * 256 + ai * 128 + wr * 64 + m * 16 + fr;
                const float ik = __builtin_amdgcn_rsqf((tot[ai][m] + skpe[ai][m]) * (1.f / 192.f) + 1e-6f), f = rs[ai][m] * ik;
                const int b = row / TOK, l = row % TOK; const size_t tl = (size_t)(b * 8 + h) * 64 + (l >> 6); const int kv = l & 63;
                bf16_t* kt = K + tl * 12288 + kv * 8;
                *(u32x4*)(kt + (4 * wc + fq) * 512) = pack8(acc[ai][0][m][0] * f * g0, acc[ai][0][m][1] * f * g1);
                if (wc < 2) { f32x4 a, cc; unpack8(kp[m], a, cc);
                    *(u32x4*)(kt + (16 + 4 * wc + fq) * 512) = pack8(a * ik, cc * ik); }
                *(u32x4*)(V + tl * 8192 + wc * 2048 + kv * 32 + fq * 8) = pack8(acc[ai][1][m][0] * rs[ai][m], acc[ai][1][m][1] * rs[ai][m]);
            }
            asm volatile("" ::: "memory");
        }
    }
};

#ifdef MK_MIXPAIR
__device__ __forceinline__ u32x4 xor1(u32x4 v);
__device__ __forceinline__ void load_pair_lines(const bf16_t* base, size_t ld, int row, int col0, int fr, u32x4& w0, u32x4& w1);
__device__ __forceinline__ void store_pair_lines(bf16_t* base, size_t ld, int row, int col0, int fr, u32x4 w0, u32x4 w1);
#endif
#if defined(MK_MIXPAIR) && defined(MK_GLUPAIR)
struct EpiGlu {
#ifdef MK_ZFRAG
    static constexpr bool GA = true, CM = true; static constexpr int NVM = 0;
#else
    static constexpr bool GA = false, CM = true; static constexpr int NVM = 0;
#endif
    const bf16_t* Z; const float* bias; bf16_t* Z2;
    __device__ __forceinline__ void operator()(EPI_ARGS) const {
        EPI_OPAQUE
        const int col0 = u.pn * 256 + wc * 64 + 8 * fq;
        f32x4 bb[2][2];
#pragma unroll
        for (int bj = 0; bj < 2; ++bj) { bb[bj][0] = *(const f32x4*)(bias + col0 + bj * 32); bb[bj][1] = *(const f32x4*)(bias + col0 + bj * 32 + 4); }
#pragma unroll
        for (int ai = 0; ai < 2; ++ai) {
            u32x4 zz[2][4];
#pragma unroll
#ifdef MK_ZFRAG
            for (int m = 0; m < 4; ++m) { const int row = u.pm * 256 + ai * 128 + wr * 64 + m * 16 + fr, bb_ = row / TOK, l = row % TOK;
#pragma unroll
                for (int bj = 0; bj < 2; ++bj) { const int c = col0 + bj * 32; zz[bj][m] = *(const u32x4*)(Z + ((size_t)(bb_ * 32 + (c >> 4)) * TOK + l) * 16 + (c & 15)); } }
#else
            for (int m = 0; m < 4; ++m) load_pair_lines(Z, 512, u.pm * 256 + ai * 128 + wr * 64 + m * 16 + fr, col0, fr, zz[0][m], zz[1][m]);
#endif
#pragma unroll
            for (int m = 0; m < 4; ++m) { const int row = u.pm * 256 + ai * 128 + wr * 64 + m * 16 + fr; u32x4 w[2];
#pragma unroll
                for (int bj = 0; bj < 2; ++bj) { f32x4 z0, z1; unpack8(zz[bj][m], z0, z1); f32x4 o0, o1;
#pragma unroll
                    for (int j = 0; j < 4; ++j) { o0[j] = z0[j] * fast_sigmoid(acc[ai][bj][m][0][j] + bb[bj][0][j]); o1[j] = z1[j] * fast_sigmoid(acc[ai][bj][m][1][j] + bb[bj][1][j]); }
                    w[bj] = pack8(o0, o1); }
                store_pair_lines(Z2, 512, row, col0, fr, w[0], w[1]); }
            asm volatile("" ::: "memory");
        }
    }
};
#else
struct EpiGlu {
    static constexpr bool GA = false, CM = false; static constexpr int NVM = 0;
    const bf16_t* Z; const float* bias; bf16_t* Z2;
    __device__ __forceinline__ void operator()(EPI_ARGS) const {
        EPI_OPAQUE
        u32x4 zz[2][2][4];
#pragma unroll
        for (int bj = 0; bj < 2; ++bj) { const int col = u.pn * 256 + bj * 128 + wc * 32 + 8 * fq;
#pragma unroll
            ROWLOOP zz[bj][ai][m] = *(const u32x4*)(Z + (size_t)(u.pm * 256 + ai * 128 + wr * 64 + m * 16 + fr) * 512 + col); }
#pragma unroll
        for (int bj = 0; bj < 2; ++bj) { const int col = u.pn * 256 + bj * 128 + wc * 32 + 8 * fq;
            const f32x4 b0 = *(const f32x4*)(bias + col), b1 = *(const f32x4*)(bias + col + 4);
#pragma unroll
            ROWLOOP { const int row = u.pm * 256 + ai * 128 + wr * 64 + m * 16 + fr;
                f32x4 z0, z1; unpack8(zz[bj][ai][m], z0, z1);
                f32x4 o0, o1;
#pragma unroll
                for (int j = 0; j < 4; ++j) { o0[j] = z0[j] * fast_sigmoid(acc[ai][bj][m][0][j] + b0[j]); o1[j] = z1[j] * fast_sigmoid(acc[ai][bj][m][1][j] + b1[j]); }
                *(u32x4*)(Z2 + (size_t)row * 512 + col) = pack8(o0, o1); }
        }
    }
};
#endif
#ifdef MK_MIXPAIR
template <bool SECOND> struct EpiMix {
    static constexpr bool GA = false, CM = true; static constexpr int NVM = 0;
    const bf16_t* SG; bf16_t* T1;
    __device__ __forceinline__ void operator()(EPI_ARGS) const {
        EPI_OPAQUE
        const int col0 = u.pn * 256 + wc * 64 + 8 * fq;
#pragma unroll
        for (int ai = 0; ai < 2; ++ai) {
            u32x4 sg[2][4], tt[2][4];
#pragma unroll
            for (int m = 0; m < 4; ++m) { const int row = u.pm * 256 + ai * 128 + wr * 64 + m * 16 + fr;
#ifdef MK_GATESUB
                { _Pragma("unroll") for (int bj = 0; bj < 2; ++bj) sg[bj][m] = *(const u32x4*)(SG + ((size_t)(row >> 4) * 32 + (u.pn * 8 + wc * 2 + bj)) * 512 + (row & 15) * 32 + 8 * fq); }
#else
                load_pair_lines(SG, 1024, row, col0, fr, sg[0][m], sg[1][m]);
#endif
                if (SECOND) load_pair_lines(T1, 1024, row, col0, fr, tt[0][m], tt[1][m]); }
#pragma unroll
            for (int m = 0; m < 4; ++m) { const int row = u.pm * 256 + ai * 128 + wr * 64 + m * 16 + fr;
                u32x4 w[2];
#pragma unroll
                for (int bj = 0; bj < 2; ++bj) { f32x4 s0, s1; unpack8(sg[bj][m], s0, s1);
                    f32x4 r0 = s0 * acc[ai][bj][m][0], r1 = s1 * acc[ai][bj][m][1];
                    if (SECOND) { f32x4 t0, t1; unpack8(tt[bj][m], t0, t1); r0 += t0; r1 += t1; }
                    w[bj] = pack8(r0, r1); }
                store_pair_lines(T1, 1024, row, col0, fr, w[0], w[1]); }
            asm volatile("" ::: "memory");
        }
    }
};
#else
template <bool SECOND> struct EpiMix {
    static constexpr bool GA = false, CM = false; static constexpr int NVM = 0;
    const bf16_t* SG; bf16_t* T1;
    __device__ __forceinline__ void operator()(EPI_ARGS) const {
        EPI_OPAQUE
#pragma unroll
        for (int ai = 0; ai < 2; ++ai) {
            u32x4 sg[2][4], tt[2][4];
#pragma unroll
            for (int bj = 0; bj < 2; ++bj)
#pragma unroll
                for (int m = 0; m < 4; ++m) { const size_t o = (size_t)(u.pm * 256 + ai * 128 + wr * 64 + m * 16 + fr) * 1024 + u.pn * 256 + bj * 128 + wc * 32 + 8 * fq;
                    sg[bj][m] = *(const u32x4*)(SG + o); if (SECOND) tt[bj][m] = *(const u32x4*)(T1 + o); }
#pragma unroll
            for (int bj = 0; bj < 2; ++bj)
#pragma unroll
                for (int m = 0; m < 4; ++m) { const size_t o = (size_t)(u.pm * 256 + ai * 128 + wr * 64 + m * 16 + fr) * 1024 + u.pn * 256 + bj * 128 + wc * 32 + 8 * fq;
                    f32x4 s0, s1; unpack8(sg[bj][m], s0, s1);
                    f32x4 r0 = s0 * acc[ai][bj][m][0], r1 = s1 * acc[ai][bj][m][1];
                    if (SECOND) { f32x4 t0, t1; unpack8(tt[bj][m], t0, t1); r0 += t0; r1 += t1; }
                    *(u32x4*)(T1 + o) = pack8(r0, r1); }
            asm volatile("" ::: "memory");
        }
    }
};
#endif
#if defined(MK_MIXPAIR) && defined(MK_OUTPAIR)
struct EpiOut {
    static constexpr bool GA = false, CM = true; static constexpr int NVM = 0;
    const float* x; float* out; bf16_t* HB; float* ssq_h; int dry;
    __device__ __forceinline__ void operator()(EPI_ARGS) const {
        EPI_OPAQUE
        const int col0 = u.pn * 256 + wc * 64 + 8 * fq;
#ifdef MK_XPAIR
        constexpr int MB = 2;
#else
        constexpr int MB = 4;
#endif
#pragma unroll
        for (int ai = 0; ai < 2; ++ai)
#pragma unroll
          for (int m0 = 0; m0 < 4; m0 += MB) {
            f32x4 xv[MB][2][2];
#pragma unroll
            for (int mi = 0; mi < MB; ++mi)
#pragma unroll
                for (int bj = 0; bj < 2; ++bj) { const int row = u.pm * 256 + ai * 128 + wr * 64 + (m0 + mi) * 16 + fr;
#ifdef MK_XPAIR
                    const bool even = (fr & 1) == 0;
                    const float* px = x + (size_t)(row - (fr & 1)) * 1024 + col0 + bj * 32 + (even ? 0 : 4);
                    const f32x4 a = *(const f32x4*)px, b2 = *(const f32x4*)(px + 1024);
                    const f32x4 r = __builtin_bit_cast(f32x4, xor1(__builtin_bit_cast(u32x4, even ? b2 : a)));
                    xv[mi][bj][0] = even ? a : r; xv[mi][bj][1] = even ? r : b2;
#else
                    const size_t o = (size_t)row * 1024 + col0 + bj * 32;
                    xv[mi][bj][0] = *(const f32x4*)(x + o); xv[mi][bj][1] = *(const f32x4*)(x + o + 4);
#endif
                }
#pragma unroll
            for (int mi = 0; mi < MB; ++mi) { const int m = m0 + mi; const int row = u.pm * 256 + ai * 128 + wr * 64 + m * 16 + fr; float q = 0.f; u32x4 w[2];
#pragma unroll
                for (int bj = 0; bj < 2; ++bj) { const f32x4 h0 = xv[mi][bj][0] + acc[ai][bj][m][0], h1 = xv[mi][bj][1] + acc[ai][bj][m][1];
                    w[bj] = pack8(h0, h1); q += sq4(h0) + sq4(h1); }
#ifdef MK_HBSUB
#pragma unroll
                for (int bj = 0; bj < 2; ++bj) *(u32x4*)(HB + ((size_t)(row >> 4) * 32 + (u.pn * 8 + wc * 2 + bj)) * 512 + (row & 15) * 32 + 8 * fq) = w[bj];
#else
                store_pair_lines(HB, 1024, row, col0, fr, w[0], w[1]);
#endif
                q = fq_sum(q); if (fq == 0 && !dry) atomicAdd(ssq_h + row, q); }
            asm volatile("" ::: "memory");
          }
    }
};
#else
struct EpiOut {
    static constexpr bool GA = false, CM = false; static constexpr int NVM = 0;
    const float* x; float* out; bf16_t* HB; float* ssq_h; int dry;
    __device__ __forceinline__ void operator()(EPI_ARGS) const {
        EPI_OPAQUE
#pragma unroll
        for (int ai = 0; ai < 2; ++ai) {
            f32x4 xv[4][2][2];
#pragma unroll
            for (int m = 0; m < 4; ++m)
#pragma unroll
                for (int bj = 0; bj < 2; ++bj) { const size_t o = (size_t)(u.pm * 256 + ai * 128 + wr * 64 + m * 16 + fr) * 1024 + u.pn * 256 + bj * 128 + wc * 32 + 8 * fq;
                    xv[m][bj][0] = *(const f32x4*)(x + o); xv[m][bj][1] = *(const f32x4*)(x + o + 4); }
#pragma unroll
            for (int m = 0; m < 4; ++m) { const int row = u.pm * 256 + ai * 128 + wr * 64 + m * 16 + fr; float q = 0.f;
#pragma unroll
                for (int bj = 0; bj < 2; ++bj) { const size_t o = (size_t)row * 1024 + u.pn * 256 + bj * 128 + wc * 32 + 8 * fq;
                    const f32x4 h0 = xv[m][bj][0] + acc[ai][bj][m][0], h1 = xv[m][bj][1] + acc[ai][bj][m][1];
                    *(u32x4*)(HB + o) = pack8(h0, h1); q += sq4(h0) + sq4(h1); }
                q = fq_sum(q); if (fq == 0 && !dry) atomicAdd(ssq_h + row, q); }
            asm volatile("" ::: "memory");
        }
    }
};
#endif
__device__ __forceinline__ unsigned xor1(unsigned v) { return (unsigned)__builtin_amdgcn_mov_dpp((int)v, 0xB1, 0xF, 0xF, true); }
__device__ __forceinline__ u32x4 xor1(u32x4 v) { return (u32x4){xor1(v.x), xor1(v.y), xor1(v.z), xor1(v.w)}; }
__device__ __forceinline__ void store_pair_lines(bf16_t* base, size_t ld, int row, int col0, int fr, u32x4 w0, u32x4 w1) {
    const bool even = (fr & 1) == 0;
    const u32x4 r = xor1(even ? w1 : w0);
    bf16_t* p = base + (size_t)(row - (fr & 1)) * ld + col0 + (even ? 0 : 32);
    *(u32x4*)p = even ? w0 : r;
    *(u32x4*)(p + ld) = even ? r : w1;
}
#ifdef MK_MIXPAIR
__device__ __forceinline__ void load_pair_lines(const bf16_t* base, size_t ld, int row, int col0, int fr, u32x4& w0, u32x4& w1) {
    const bool even = (fr & 1) == 0;
    const bf16_t* p = base + (size_t)(row - (fr & 1)) * ld + col0 + (even ? 0 : 32);
    const u32x4 a = *(const u32x4*)p, b = *(const u32x4*)(p + ld);
    const u32x4 r = xor1(even ? b : a);
    w0 = even ? a : r; w1 = even ? r : b;
}
#endif
struct EpiUp {

#ifdef MK_HBSUB
    static constexpr int GA = 2; static constexpr bool CM = true;
#else
    static constexpr bool GA = false, CM = true;
#endif
    static constexpr int NVM = 0;
    bf16_t* HID;
    __device__ __forceinline__ void operator()(EPI_ARGS) const {
        EPI_OPAQUE
#pragma unroll
        ROWLOOP { const int row = u.pm * 256 + ai * 128 + wr * 64 + m * 16 + fr;
            u32x4 w[2];
#pragma unroll
            for (int bj = 0; bj < 2; ++bj) { f32x4 a, b;
#pragma unroll
                for (int j = 0; j < 4; ++j) { const float p = fmaxf(acc[ai][bj][m][0][j], 0.f), q = fmaxf(acc[ai][bj][m][1][j], 0.f); a[j] = p * p; b[j] = q * q; }
                w[bj] = pack8(a, b); }
#ifdef MK_HIDSUB
#pragma unroll
            for (int bj = 0; bj < 2; ++bj) *(u32x4*)(HID + ((size_t)(row >> 4) * 128 + (u.pn * 8 + wc * 2 + bj)) * 512 + (row & 15) * 32 + 8 * fq) = w[bj]; }
#else
            store_pair_lines(HID, 4096, row, u.pn * 256 + wc * 64 + 8 * fq, fr, w[0], w[1]); }
#endif
    }
};
#if defined(MK_MIXPAIR) && defined(MK_DOWNPAIR)
struct EpiDown {
#ifdef MK_HIDSUB
    static constexpr int GA = 2; static constexpr bool CM = true; static constexpr int NVM = 0;
#else
    static constexpr bool GA = false, CM = true; static constexpr int NVM = 0;
#endif
    const bf16_t* HB; const float* ssq_h; float* out;
    __device__ __forceinline__ void operator()(EPI_ARGS) const {
        EPI_OPAQUE
        const int col0 = u.pn * 256 + wc * 64 + 8 * fq;
        u32x4 hb[2][4][2]; float sq[2][4];
#pragma unroll
        ROWLOOP { const int row = u.pm * 256 + ai * 128 + wr * 64 + m * 16 + fr; sq[ai][m] = ssq_h[row];
#ifdef MK_HBSUB
#pragma unroll
            for (int bj = 0; bj < 2; ++bj) hb[ai][m][bj] = *(const u32x4*)(HB + ((size_t)(row >> 4) * 32 + (u.pn * 8 + wc * 2 + bj)) * 512 + (row & 15) * 32 + 8 * fq); }
#else
            load_pair_lines(HB, 1024, row, col0, fr, hb[ai][m][0], hb[ai][m][1]); }
#endif
#pragma unroll
        ROWLOOP { const int row = u.pm * 256 + ai * 128 + wr * 64 + m * 16 + fr; const float s2 = __builtin_amdgcn_rcpf(sq[ai][m] * (1.f / 1024.f) + 1e-6f);
#pragma unroll
            for (int bj = 0; bj < 2; ++bj) { const size_t o = (size_t)row * 1024 + col0 + bj * 32;
                f32x4 h0, h1; unpack8(hb[ai][m][bj], h0, h1);
                *(f32x4*)(out + o) = h0 + acc[ai][bj][m][0] * s2; *(f32x4*)(out + o + 4) = h1 + acc[ai][bj][m][1] * s2; } }
    }
};
#else
struct EpiDown {
    static constexpr bool GA = false, CM = false; static constexpr int NVM = 0;
    const bf16_t* HB; const float* ssq_h; float* out;
    __device__ __forceinline__ void operator()(EPI_ARGS) const {
        EPI_OPAQUE
        u32x4 hb[2][4][2]; float sq[2][4];
#pragma unroll
        ROWLOOP { const int row = u.pm * 256 + ai * 128 + wr * 64 + m * 16 + fr; sq[ai][m] = ssq_h[row];
#pragma unroll
            for (int bj = 0; bj < 2; ++bj) hb[ai][m][bj] = *(const u32x4*)(HB + (size_t)row * 1024 + u.pn * 256 + bj * 128 + wc * 32 + 8 * fq); }
#pragma unroll
        ROWLOOP { const int row = u.pm * 256 + ai * 128 + wr * 64 + m * 16 + fr; const float s2 = __builtin_amdgcn_rcpf(sq[ai][m] * (1.f / 1024.f) + 1e-6f);
#pragma unroll
            for (int bj = 0; bj < 2; ++bj) { const size_t o = (size_t)row * 1024 + u.pn * 256 + bj * 128 + wc * 32 + 8 * fq;
                f32x4 h0, h1; unpack8(hb[ai][m][bj], h0, h1);
                *(f32x4*)(out + o) = h0 + acc[ai][bj][m][0] * s2; *(f32x4*)(out + o + 4) = h1 + acc[ai][bj][m][1] * s2; } }
    }
};
#endif
#define XB_TMO      128
#define XB_XCNT(j)  (256  + 64 * (j))
#define XB_XSUB(j)  (1280 + 64 * (j))
#define XB_XGEN(j)  (2304 + 64 * (j))
#define XB_TOP      3328
#define XB_TOPGEN   3392
#define XCD_BAR_WORDS 3456
#define XB_SPIN_CAP (1u << 18)
__device__ __forceinline__ unsigned xb_ld(unsigned* p)              { return __hip_atomic_load(p, __ATOMIC_RELAXED, __HIP_MEMORY_SCOPE_AGENT); }
__device__ __forceinline__ unsigned xb_add(unsigned* p, unsigned v) { return __hip_atomic_fetch_add(p, v, __ATOMIC_RELAXED, __HIP_MEMORY_SCOPE_AGENT); }
__device__ __forceinline__ unsigned xb_xcc_id() { return (unsigned)__builtin_amdgcn_s_getreg((3 << 11) | 20) & 0xFu; }
#define XB_SPIN(cond, bar) do { unsigned _sp = 0; while (cond) { __builtin_amdgcn_s_sleep(1); \
    if ((++_sp & 255u) == 0u) { if (xb_ld(&(bar)[XB_TMO])) break; if (_sp > XB_SPIN_CAP) { atomicAdd(&(bar)[XB_TMO], 1u); break; } } } } while (0)
struct XcdBarrier { unsigned* bar; unsigned x; volatile LAS unsigned* st; };
__device__ __forceinline__ XcdBarrier xcd_barrier_post(unsigned* bar, volatile LAS unsigned* st) {
    XcdBarrier b; b.bar = bar; b.x = xb_xcc_id(); b.st = st;
    if (threadIdx.x == 0) (void)xb_add(&bar[XB_XCNT(b.x)], 1u);
    return b;
}
__device__ __forceinline__ void xcd_barrier_complete(unsigned* bar, unsigned x, unsigned& nloc, unsigned& nx) {
    const unsigned G = gridDim.x * gridDim.y * gridDim.z;
    unsigned sum, cnt, mine, sp = 0u;
    for (;;) {
        sum = 0u; cnt = 0u; mine = 0u;
#pragma unroll
        for (unsigned j = 0; j < 16; ++j) { const unsigned c = xb_ld(&bar[XB_XCNT(j)]); sum += c; cnt += (c > 0u) ? 1u : 0u; mine = (j == x) ? c : mine; }
        if (sum == G) break;
        __builtin_amdgcn_s_sleep(1);
        if ((++sp & 255u) == 0u) { if (xb_ld(&bar[XB_TMO])) break; if (sp > XB_SPIN_CAP) { atomicAdd(&bar[XB_TMO], 1u); break; } }
    }
    nloc = mine > 0u ? mine : 1u; nx = cnt > 0u ? cnt : 1u;
}
__device__ __forceinline__ void xcd_barrier(const XcdBarrier& b) {
    asm volatile("s_waitcnt vmcnt(0)" ::: "memory");
    __syncthreads();
    if (threadIdx.x == 0) {
        unsigned* bar = b.bar;
        __builtin_amdgcn_s_waitcnt(0);
        unsigned nloc = b.st[0], nx = b.st[1];
        if (nloc == 0u) { xcd_barrier_complete(bar, b.x, nloc, nx); b.st[0] = nloc; b.st[1] = nx; }
        const unsigned old = xb_add(&bar[XB_XSUB(b.x)], 1u);
        const unsigned gen = old / nloc;
        if (old + 1u == (gen + 1u) * nloc) {
            __builtin_amdgcn_fence(__ATOMIC_RELEASE, "agent");
            asm volatile("s_waitcnt vmcnt(0)" ::: "memory");
            const unsigned og = xb_add(&bar[XB_TOP], 1u);
            const unsigned tg = og / nx;
            if (og + 1u == (tg + 1u) * nx) xb_add(&bar[XB_TOPGEN], 1u);
            else XB_SPIN(xb_ld(&bar[XB_TOPGEN]) == tg, bar);
            __builtin_amdgcn_fence(__ATOMIC_ACQUIRE, "agent");
            xb_add(&bar[XB_XGEN(b.x)], 1u);
            asm volatile("s_waitcnt vmcnt(0)" ::: "memory");
        } else {
            XB_SPIN(xb_ld(&bar[XB_XGEN(b.x)]) == gen, bar);
            __builtin_amdgcn_fence(__ATOMIC_ACQUIRE, "agent");
            asm volatile("s_waitcnt vmcnt(0)" ::: "memory");
        }
    }
    __syncthreads();
}

__device__ __forceinline__ void ctr_barrier(unsigned* ctr, unsigned* tmo, unsigned& epoch) {
    __threadfence();
    __syncthreads();
    ++epoch;
    if (threadIdx.x == 0) {
        const unsigned target = epoch * gridDim.x;
        xb_add(ctr, 1u);
        unsigned sp = 0;
        while (xb_ld(ctr) < target) { __builtin_amdgcn_s_sleep(1); if ((++sp & 1023u) == 0u) { if (sp > (1u << 22)) { atomicAdd(tmo, 1u); break; } } }
    }
    __syncthreads();
    __threadfence();
}
#ifndef MK_ATT_EAGER
#define MK_ATT_LAZY 1
#endif
#ifdef MK_QFRAG
#define QF_ROW(r) ((r) * 16)
#define QF_D0 1024
#else
#define QF_ROW(r) ((r) * 192)
#define QF_D0 32
#endif
#ifdef MK_ROPEFRAG
#define ROPE_BASE(row, hi) ((size_t)((row) >> 5) * 1024 + (unsigned)(((row) & 31) * 4 + (hi) * 128))
#define ROPE_D0 256
#else
#define ROPE_BASE(row, hi) ((size_t)(row) * 32 + (unsigned)((hi) * 4))
#define ROPE_D0 8
#endif
namespace att {
constexpr int KSLOT = 24576, VSLOT = 16384, NSLOT = 3;
constexpr int LDS_K = 0, LDS_V = NSLOT * KSLOT, LDS_WS = LDS_V + NSLOT * VSLOT, LDS_END = LDS_WS + 8 * 256;
__device__ __forceinline__ int crow(int r, int hi) { return (r & 3) + 8 * (r >> 2) + 4 * hi; }
__device__ __forceinline__ s16x4 vtr(const LAS unsigned char* p) { typedef short v4i16_t __attribute__((ext_vector_type(4))); return __builtin_bit_cast(s16x4, __builtin_amdgcn_ds_read_tr16_b64_v4i16((LAS v4i16_t*)p)); }
#ifndef ATT_THR
#ifdef MK_ATT_LAZY
#define ATT_THR 24.0f
#else
#define ATT_THR 6.0f
#endif
#endif
#define ATT_WAIT_V(n) asm volatile("s_waitcnt vmcnt(" #n ")" ::: "memory")
#define ATT_WAIT_VK() asm volatile("s_waitcnt vmcnt(%0)" :: "n"(ATT_KPIECES) : "memory")
__device__ __forceinline__ void glds_run4(const void* sbase, unsigned voff, unsigned lds_dst) { unsigned keep;
    asm volatile("s_mov_b32 %0, m0\n\ts_mov_b32 m0, %3\n\ts_nop 0\n\tglobal_load_lds_dwordx4 %1, %2\n\tglobal_load_lds_dwordx4 %1, %2 offset:1024\n\tglobal_load_lds_dwordx4 %1, %2 offset:2048\n\tglobal_load_lds_dwordx4 %1, %2 offset:3072\n\ts_mov_b32 m0, %0"
                 : "=&s"(keep) : "v"(voff), "s"(sbase), "s"(lds_dst) : "memory"); }
__device__ __forceinline__ void glds_run4c(int cond, const void* sbase, unsigned voff, unsigned lds_dst) { unsigned keep;
    asm volatile("s_cmp_eq_u32 %4, 0\n\ts_cbranch_scc1 1f\n\ts_mov_b32 %0, m0\n\ts_mov_b32 m0, %3\n\ts_nop 0\n\tglobal_load_lds_dwordx4 %1, %2\n\tglobal_load_lds_dwordx4 %1, %2 offset:1024\n\tglobal_load_lds_dwordx4 %1, %2 offset:2048\n\tglobal_load_lds_dwordx4 %1, %2 offset:3072\n\ts_mov_b32 m0, %0\n1:"
                 : "=&s"(keep) : "v"(voff), "s"(sbase), "s"(lds_dst), "s"(cond) : "memory", "scc"); }
__device__ __forceinline__ void glds_run2c(int cond, const void* sbase, unsigned voff, unsigned lds_dst) { unsigned keep;
    asm volatile("s_cmp_eq_u32 %4, 0\n\ts_cbranch_scc1 1f\n\ts_mov_b32 %0, m0\n\ts_mov_b32 m0, %3\n\ts_nop 0\n\tglobal_load_lds_dwordx4 %1, %2\n\tglobal_load_lds_dwordx4 %1, %2 offset:1024\n\ts_mov_b32 m0, %0\n1:"
                 : "=&s"(keep) : "v"(voff), "s"(sbase), "s"(lds_dst), "s"(cond) : "memory", "scc"); }
__device__ __forceinline__ void glds_run1(const void* sbase, unsigned voff, unsigned lds_dst) { unsigned keep;
    asm volatile("s_mov_b32 %0, m0\n\ts_mov_b32 m0, %3\n\ts_nop 0\n\tglobal_load_lds_dwordx4 %1, %2\n\ts_mov_b32 m0, %0" : "=&s"(keep) : "v"(voff), "s"(sbase), "s"(lds_dst) : "memory"); }
__device__ __forceinline__ void glds_run2(const void* sbase, unsigned voff, unsigned lds_dst) { unsigned keep;
    asm volatile("s_mov_b32 %0, m0\n\ts_mov_b32 m0, %3\n\ts_nop 0\n\tglobal_load_lds_dwordx4 %1, %2\n\tglobal_load_lds_dwordx4 %1, %2 offset:1024\n\ts_mov_b32 m0, %0"
                 : "=&s"(keep) : "v"(voff), "s"(sbase), "s"(lds_dst) : "memory"); }

#ifdef MK_ATT_NEXT
__device__ __forceinline__ void attn_unit(int bh, int qb, const bf16_t* Qg, const bf16_t* Kg, const bf16_t* Vg, bf16_t* Og, const float* rcos, const float* rsin, LAS unsigned char* lds, float* tprobe,
                                          bf16x8 (&qf)[12], int nbh, int nqb, bool hnx) {
#else
__device__ __forceinline__ void attn_unit(int bh, int qb, const bf16_t* Qg, const bf16_t* Kg, const bf16_t* Vg, bf16_t* Og, const float* rcos, const float* rsin, LAS unsigned char* lds, float* tprobe) {
#endif
    int tid = threadIdx.x; asm volatile("" : "+v"(tid));
    const int lane = tid & 63, r32 = lane & 31, hi = lane >> 5; const int wid = __builtin_amdgcn_readfirstlane(tid >> 6);
    const int b = bh >> 3, h = bh & 7;
    const int NT = 4 * (qb + 1);
    const char* kbase = (const char*)Kg + (size_t)bh * 64 * KSLOT;
    const char* vbase = (const char*)Vg + (size_t)bh * 64 * VSLOT;
    const unsigned loff = (unsigned)lane * 16u;
    LAS float* wsf = (LAS float*)(lds + LDS_WS) + wid * 64;
    const unsigned lds0 = (unsigned)(uintptr_t)lds;
#ifdef MK_ATT_DMA4
#define ATT_ISSUE_K(t, slot) do { const int _w = wid & 3; const char* _g = kbase + (size_t)(t) * KSLOT + _w * 6144; const unsigned _l = (unsigned)__builtin_amdgcn_readfirstlane(lds0 + LDS_K + (slot) * KSLOT + _w * 6144); \
        glds_run4c(__builtin_amdgcn_readfirstlane((int)(wid < 4)), _g, loff, _l); glds_run2c(__builtin_amdgcn_readfirstlane((int)(wid < 4)), _g + 4096, loff, _l + 4096); } while (0)
#define ATT_ISSUE_V(t, slot) do { const int _w = wid & 3; glds_run4c(__builtin_amdgcn_readfirstlane((int)(wid < 4)), vbase + (size_t)(t) * VSLOT + _w * 4096, loff, (unsigned)__builtin_amdgcn_readfirstlane(lds0 + LDS_V + (slot) * VSLOT + _w * 4096)); } while (0)
#define ATT_KPIECES 6
#else
#define ATT_ISSUE_K(t, slot) do { const char* _g = kbase + (size_t)(t) * KSLOT + wid * 3072; const unsigned _l = (unsigned)__builtin_amdgcn_readfirstlane(lds0 + LDS_K + (slot) * KSLOT + wid * 3072); \
        glds_run2(_g, loff, _l); glds_run1(_g + 2048, loff, _l + 2048); } while (0)
#define ATT_ISSUE_V(t, slot) do { glds_run2(vbase + (size_t)(t) * VSLOT + wid * 2048, loff, (unsigned)__builtin_amdgcn_readfirstlane(lds0 + LDS_V + (slot) * VSLOT + wid * 2048)); } while (0)
#define ATT_KPIECES 3
#endif
#ifdef MK_ATT_NEXT
    const unsigned qoff = (unsigned)(QF_ROW(r32) + hi * 8) * 2u;
#define ATT_ISSUE_KB(base, t, slot) do { const char* _g = (base) + (size_t)(t) * KSLOT + wid * 3072; const unsigned _l = (unsigned)__builtin_amdgcn_readfirstlane(lds0 + LDS_K + (slot) * KSLOT + wid * 3072); \
        glds_run2(_g, loff, _l); glds_run1(_g + 2048, loff, _l + 2048); } while (0)
#define ATT_ISSUE_VB(base, t, slot) do { glds_run2((base) + (size_t)(t) * VSLOT + wid * 2048, loff, (unsigned)__builtin_amdgcn_readfirstlane(lds0 + LDS_V + (slot) * VSLOT + wid * 2048)); } while (0)
    ATT_ISSUE_K(1, 1);
#else
#ifdef MK_ATT_EARLY_DMA
    ATT_ISSUE_K(0, 0); ATT_ISSUE_V(0, 0); ATT_ISSUE_K(1, 1);
#endif
    const char* qbase = (const char*)(Qg + ((size_t)bh * TOK + qb * 256 + wid * 32) * 192);
    const unsigned qoff = (unsigned)(QF_ROW(r32) + hi * 8) * 2u;
    bf16x8 qf[12];
#pragma unroll
    for (int d0 = 0; d0 < 12; ++d0) qf[d0] = *(const bf16x8*)(qbase + qoff + d0 * QF_D0);
    { const size_t trow = (size_t)b * TOK + qb * 256 + wid * 32 + r32;
#pragma unroll
      for (int d0 = 8; d0 < 12; ++d0) { const int i0 = 4 * (2 * (d0 - 8) + hi);
          const f32x4 cs = *(const f32x4*)(rcos + (ROPE_BASE(trow, hi) + (d0 - 8) * ROPE_D0)), sn = *(const f32x4*)(rsin + (ROPE_BASE(trow, hi) + (d0 - 8) * ROPE_D0));
          f32x4 x1, x2; unpack8(__builtin_bit_cast(u32x4, qf[d0]), x1, x2);
          qf[d0] = __builtin_bit_cast(bf16x8, pack8(x1 * cs - x2 * sn, x2 * cs + x1 * sn)); } }
#ifndef MK_ATT_EARLY_DMA
    ATT_ISSUE_K(0, 0); ATT_ISSUE_V(0, 0); ATT_ISSUE_K(1, 1);
#endif
#endif
    float mrow = -1e30f, lsum = 0.f, alpha = 1.f;
#ifdef MK_ATT_LAZY
    bool zref = false; float rmf = 0.f;
#endif
    f32x16 o[4];
#pragma unroll
    for (int d = 0; d < 4; ++d) o[d] = (f32x16){0.f, 0.f, 0.f, 0.f, 0.f, 0.f, 0.f, 0.f, 0.f, 0.f, 0.f, 0.f, 0.f, 0.f, 0.f, 0.f};
    const int qrel = wid * 32 + r32;
    u32x4 pw[2] = {(u32x4){0u, 0u, 0u, 0u}, (u32x4){0u, 0u, 0u, 0u}};
    f32x16 pA = o[0], pB = o[0];
    bool need = false;
    const LAS unsigned char* vp0 = lds + LDS_V + ((lane >> 4) & 1) * 32 + (lane & 3) * 8 + (4 * hi + ((lane & 15) >> 2)) * 64;
#define SBAR() __builtin_amdgcn_sched_barrier(0)
#ifndef ATT_HEADG
#define ATT_HEADG 0
#endif
#define XBAR() __builtin_amdgcn_sched_barrier(0x406)
#define ATT_LDK(buf, g) do { _Pragma("unroll") for (int _i = 0; _i < 3; ++_i) kf[buf][_i] = *(const LAS bf16x8*)(kp + (3 * (g) + _i) * 2048); } while (0)
#define ATT_QK(P, ks, hh) do { const LAS unsigned char* kp = lds + LDS_K + (ks) * KSLOT + hi * 1024 + r32 * 16 + (hh) * 512; bf16x8 kf[2][3]; \
        P = (f32x16){0.f, 0.f, 0.f, 0.f, 0.f, 0.f, 0.f, 0.f, 0.f, 0.f, 0.f, 0.f, 0.f, 0.f, 0.f, 0.f}; \
        ATT_LDK(0, 0); \
        _Pragma("unroll") for (int g = 0; g < 4; ++g) { \
            if (g < 3) ATT_LDK((g + 1) & 1, g + 1); \
            XBAR(); \
            _Pragma("unroll") for (int _i = 0; _i < 3; ++_i) P = __builtin_amdgcn_mfma_f32_32x32x16_bf16(kf[g & 1][_i], qf[3 * g + _i], P, 0, 0, 0); \
            if (g < ATT_HEADG) SBAR(); else XBAR(); } } while (0)
#ifdef MK_ATT_LAZY
#define ATT_START(P, jbs) do { \
        if ((jbs) >= 0) { const int kb = 32 * (jbs) + 4 * hi; \
            _Pragma("unroll") for (int r = 0; r < 16; ++r) { const int kv = kb + (r & 3) + 8 * (r >> 2); if (kv > qrel) P[r] = -INFINITY; } } \
        float rm = fmaxf(fmaxf(P[0], P[1]), P[2]); \
        _Pragma("unroll") for (int r = 3; r < 15; r += 2) rm = fmaxf(fmaxf(rm, P[r]), P[r + 1]); \
        rm = fmaxf(rm, P[15]); \
        { auto rr = __builtin_amdgcn_permlane32_swap(__float_as_uint(rm), __float_as_uint(rm), false, false); rm = fmaxf(__uint_as_float(rr[0]), __uint_as_float(rr[1])); } \
        rmf = rm; need = __any(rm > mrow + ATT_THR); } while (0)
#define ATT_RESC(P) do { if (__builtin_expect(need || !zref, 0)) { \
          if (need) { const float mnew = fmaxf(mrow, rmf); alpha = __builtin_amdgcn_exp2f(mrow - mnew); mrow = mnew; \
            lsum *= alpha; if (hi == 0) wsf[r32] = alpha; asm volatile("s_waitcnt lgkmcnt(0)" ::: "memory"); \
            _Pragma("unroll") for (int r = 0; r < 16; ++r) { const float a_ = wsf[crow(r, hi)]; _Pragma("unroll") for (int d = 0; d < 4; ++d) o[d][r] *= a_; } need = false; zref = false; } \
          _Pragma("unroll") for (int r = 0; r < 16; ++r) P[r] -= mrow; } } while (0)
#else
#define ATT_START(P, jbs) do { \
        if ((jbs) >= 0) { const int kb = 32 * (jbs) + 4 * hi; \
            _Pragma("unroll") for (int r = 0; r < 16; ++r) { const int kv = kb + (r & 3) + 8 * (r >> 2); if (kv > qrel) P[r] = -INFINITY; } } \
        float rm = fmaxf(P[0], P[1]); \
        _Pragma("unroll") for (int r = 2; r < 16; ++r) rm = fmaxf(rm, P[r]); \
        { auto rr = __builtin_amdgcn_permlane32_swap(__float_as_uint(rm), __float_as_uint(rm), false, false); rm = fmaxf(__uint_as_float(rr[0]), __uint_as_float(rr[1])); } \
        need = __any(rm > mrow + ATT_THR);                       \
        const float mnew = need ? fmaxf(mrow, rm) : mrow; alpha = __builtin_amdgcn_exp2f(mrow - mnew); mrow = mnew; \
        _Pragma("unroll") for (int r = 0; r < 16; ++r) P[r] -= mnew; } while (0)
#define ATT_RESC(P) do { if (need) { lsum *= alpha; if (hi == 0) wsf[r32] = alpha; asm volatile("s_waitcnt lgkmcnt(0)" ::: "memory"); \
            _Pragma("unroll") for (int r = 0; r < 16; ++r) { const float a_ = wsf[crow(r, hi)]; _Pragma("unroll") for (int d = 0; d < 4; ++d) o[d][r] *= a_; } need = false; } } while (0)
#endif
#define ATT_FIN(P) do { float ps = 0.f; \
        _Pragma("unroll") for (int r = 0; r < 16; ++r) { P[r] = __builtin_amdgcn_exp2f(P[r]); ps += P[r]; } \
        lsum += ps; \
        _Pragma("unroll") for (int k = 0; k < 2; ++k) \
            pw[k] = (u32x4){cvt_pk_bf16(P[8 * k], P[8 * k + 1]), cvt_pk_bf16(P[8 * k + 2], P[8 * k + 3]), cvt_pk_bf16(P[8 * k + 4], P[8 * k + 5]), cvt_pk_bf16(P[8 * k + 6], P[8 * k + 7])}; } while (0)
#define ATT_LDV(buf, d, hh) do { _Pragma("unroll") for (int ks = 0; ks < 2; ++ks) { vlo[buf][ks] = vtr(vp + (d) * 4096 + (2 * (hh) + ks) * 1024); vhi[buf][ks] = vtr(vp + (d) * 4096 + (2 * (hh) + ks) * 1024 + 512); } } while (0)
#define ATT_PV(vslot, hh) do { const LAS unsigned char* vp = vp0 + (vslot) * VSLOT; s16x4 vlo[2][2], vhi[2][2]; \
        ATT_LDV(0, 0, hh); \
        _Pragma("unroll") for (int d = 0; d < 4; ++d) { \
            if (d < 3) ATT_LDV((d + 1) & 1, d + 1, hh); \
            XBAR(); \
            _Pragma("unroll") for (int ks = 0; ks < 2; ++ks) { const s16x4 lo = vlo[d & 1][ks], hv = vhi[d & 1][ks]; \
                const bf16x8 vf = (bf16x8){lo[0], lo[1], lo[2], lo[3], hv[0], hv[1], hv[2], hv[3]}; \
                o[d] = __builtin_amdgcn_mfma_f32_32x32x16_bf16(__builtin_bit_cast(bf16x8, pw[ks]), vf, o[d], 0, 0, 0); } \
            XBAR(); } } while (0)
    int s0 = 0, sm1 = 2;
#if defined(MK_ATT_PRIO) && MK_ATT_PRIO == 2
#define ATT_YOUNG_PRIO(v) do { if (wid >= 4) __builtin_amdgcn_s_setprio(v); } while (0)
#else
#define ATT_YOUNG_PRIO(v) do { } while (0)
#endif
#define ATT_STEP(t, hh, PC, PP, pvs, MASKED) do { \
        const int jbs = (MASKED) ? (2 * (t) + (hh) - 2 * (NT - 4)) : -1; \
        if (!(MASKED) || jbs <= wid) {                         \
            SBAR(); ATT_QK(PC, s0, hh); ATT_FIN(PP); SBAR(); \
            ATT_PV(pvs, 1 - (hh)); ATT_START(PC, jbs); SBAR(); \
            ATT_RESC(PC); \
        } else {                                               \
            ATT_FIN(PP); ATT_PV(pvs, 1 - (hh)); \
            _Pragma("unroll") for (int r = 0; r < 16; ++r) PC[r] = -INFINITY; \
        } } while (0)
#define ATT_SYNC(t) do { \
        if ((t) + 1 < NT) ATT_WAIT_VK(); else ATT_WAIT_V(0); \
        __builtin_amdgcn_s_barrier(); asm volatile("" ::: "memory"); \
        if ((t) + 1 < NT) ATT_ISSUE_V((t) + 1, (s0 == 2) ? 0 : s0 + 1); \
        if ((t) + 2 < NT) ATT_ISSUE_K((t) + 2, sm1); } while (0)
#define ATT_ROT() do { sm1 = s0; s0 = (s0 == 2) ? 0 : s0 + 1; } while (0)
#ifdef MK_ATT_NEXT
    asm volatile("s_waitcnt vmcnt(11)" ::: "memory");
    __builtin_amdgcn_s_barrier(); asm volatile("" ::: "memory");
    ATT_ISSUE_V(1, 1); ATT_ISSUE_K(2, 2);
#else
    ATT_SYNC(0);
#endif
    { const int jb0 = (NT == 4) ? 0 : -1;
      ATT_QK(pA, s0, 0);
#ifdef MK_ATT_LAZY
      { float r0 = fabsf(pA[0]);
#pragma unroll
        for (int r = 1; r < 16; ++r) r0 = fmaxf(r0, fabsf(pA[r]));
        zref = !__any(r0 > ATT_THR); mrow = zref ? 0.f : -1e30f; }
#endif
      ATT_START(pA, jb0); ATT_RESC(pA);
      if (NT == 4) ATT_STEP(0, 1, pB, pA, s0, true); else ATT_STEP(0, 1, pB, pA, s0, false); }
    ATT_ROT();
    int t = 1;
#ifdef MK_TPROBE
    const unsigned long long tp0 = __builtin_amdgcn_s_memtime(), tr0 = __builtin_amdgcn_s_memrealtime();
    unsigned long long tseg[6] = {0, 0, 0, 0, 0, 0}, tlast = tp0; int nint = 0;
#define TSEG(i) do { __builtin_amdgcn_sched_barrier(0); const unsigned long long _n = __builtin_amdgcn_s_memtime(); tseg[i] += _n - tlast; tlast = _n; __builtin_amdgcn_sched_barrier(0); } while (0)
#else
#define TSEG(i) do { } while (0)
#endif
    for (; t < NT - 4; ++t) {
        if ((t) + 1 < NT) ATT_WAIT_VK(); else ATT_WAIT_V(0);
        __builtin_amdgcn_s_barrier(); asm volatile("" ::: "memory");
        TSEG(0);
        if ((t) + 1 < NT) ATT_ISSUE_V((t) + 1, (s0 == 2) ? 0 : s0 + 1);
        if ((t) + 2 < NT) ATT_ISSUE_K((t) + 2, sm1);
        TSEG(1);
        ATT_YOUNG_PRIO(1);
        ATT_STEP(t, 0, pA, pB, sm1, false);
        ATT_YOUNG_PRIO(0);
        TSEG(2);
        ATT_STEP(t, 1, pB, pA, s0, false);
        TSEG(3);
        ATT_ROT();
#ifdef MK_TPROBE
        ++nint;
#endif
    }
#ifdef MK_TPROBE
    { const unsigned long long tp1 = __builtin_amdgcn_s_memtime(), tr1 = __builtin_amdgcn_s_memrealtime();
      if (bh == MK_TPROBE_BH && qb == 15 && tid == MK_TPROBE_TID) { tprobe[0] = (float)(tp1 - tp0) / (float)nint; tprobe[1] = (float)(tp1 - tp0) / (float)(tr1 - tr0) * 100.f;
        for (int i = 0; i < 6; ++i) tprobe[2 + i] = (float)tseg[i] / (float)nint; } }
#endif
    for (; t < NT; ++t) {
        ATT_SYNC(t);
        ATT_STEP(t, 0, pA, pB, sm1, true);
        ATT_STEP(t, 1, pB, pA, s0, true);
        ATT_ROT();
    }
    ATT_SYNC(NT);
#ifdef MK_ATT_NEXT
    if (hnx) ATT_ISSUE_KB((const char*)Kg + (size_t)nbh * 64 * KSLOT, 0, 0);
    ATT_FIN(pB); ATT_PV(sm1, 1);
    asm volatile("s_waitcnt lgkmcnt(0)" ::: "memory"); __builtin_amdgcn_s_barrier(); asm volatile("" ::: "memory");
    f32x4 ncs[4], nsn[4];
    if (hnx) ATT_ISSUE_VB((const char*)Vg + (size_t)nbh * 64 * VSLOT, 0, 0);
    {   const char* qb2 = (const char*)(Qg + ((size_t)nbh * TOK + nqb * 256 + wid * 32) * 192);
#pragma unroll
        for (int d0 = 0; d0 < 12; ++d0) qf[d0] = *(const bf16x8*)(qb2 + qoff + d0 * QF_D0);
    }
#else
    ATT_FIN(pB); ATT_PV(sm1, 1);
#endif
#undef ATT_SYNC
#undef ATT_ROT
#undef ATT_STEP
#undef ATT_QK
#undef ATT_START
#undef ATT_RESC
#undef ATT_FIN
    { auto rr = __builtin_amdgcn_permlane32_swap(__float_as_uint(lsum), __float_as_uint(lsum), false, false); lsum = __uint_as_float(rr[0]) + __uint_as_float(rr[1]); }
    if (hi == 0) wsf[32 + r32] = lsum;
    asm volatile("s_waitcnt lgkmcnt(0)" ::: "memory");
#ifdef MK_ATT_NEXT
    { LAS unsigned char* st = wid < 5 ? lds + LDS_K + KSLOT + wid * (32 * 272) : lds + LDS_V + VSLOT + (wid - 5) * (32 * 272);
#pragma unroll
      for (int r = 0; r < 16; ++r) { const int q = crow(r, hi); const float il = __builtin_amdgcn_rcpf(wsf[32 + q]);
#pragma unroll
          for (int d = 0; d < 4; ++d) { const unsigned w = cvt_pk_bf16(o[d][r] * il, 0.f); *(LAS unsigned short*)(st + q * 272 + (d * 32 + r32) * 2) = (unsigned short)(w & 0xffffu); } }
      asm volatile("s_waitcnt lgkmcnt(0)" ::: "memory");
      { const size_t trow2 = (size_t)(nbh >> 3) * TOK + nqb * 256 + wid * 32 + r32;
#pragma unroll
        for (int d0 = 8; d0 < 12; ++d0) { ncs[d0 - 8] = *(const f32x4*)(rcos + (ROPE_BASE(trow2, hi) + (d0 - 8) * ROPE_D0)); nsn[d0 - 8] = *(const f32x4*)(rsin + (ROPE_BASE(trow2, hi) + (d0 - 8) * ROPE_D0)); } }
      {
#pragma unroll
          for (int d0 = 8; d0 < 12; ++d0) { f32x4 x1, x2; unpack8(__builtin_bit_cast(u32x4, qf[d0]), x1, x2);
              qf[d0] = __builtin_bit_cast(bf16x8, pack8(x1 * ncs[d0 - 8] - x2 * nsn[d0 - 8], x2 * ncs[d0 - 8] + x1 * nsn[d0 - 8])); } }
      bf16_t* ob = Og + ((size_t)b * TOK + qb * 256 + wid * 32) * 1024 + h * 128 + (lane & 15) * 8;
#pragma unroll
      for (int j = 0; j < 8; ++j) *(u32x4*)(ob + (size_t)(4 * j + (lane >> 4)) * 1024) = *(const LAS u32x4*)(st + (4 * j + (lane >> 4)) * 272 + (lane & 15) * 16); }
#else
#ifdef MK_ATT_OSTAGE
    { LAS unsigned char* st = lds + LDS_K + wid * (32 * 272);
#pragma unroll
      for (int r = 0; r < 16; ++r) { const int q = crow(r, hi); const float il = __builtin_amdgcn_rcpf(wsf[32 + q]);
#pragma unroll
          for (int d = 0; d < 4; ++d) { const unsigned w = cvt_pk_bf16(o[d][r] * il, 0.f); *(LAS unsigned short*)(st + q * 272 + (d * 32 + r32) * 2) = (unsigned short)(w & 0xffffu); } }
      asm volatile("s_waitcnt lgkmcnt(0)" ::: "memory");
      bf16_t* ob = Og + ((size_t)b * TOK + qb * 256 + wid * 32) * 1024 + h * 128 + (lane & 15) * 8;
#pragma unroll
      for (int j = 0; j < 8; ++j) *(u32x4*)(ob + (size_t)(4 * j + (lane >> 4)) * 1024) = *(const LAS u32x4*)(st + (4 * j + (lane >> 4)) * 272 + (lane & 15) * 16); }
#else
    bf16_t* orow = Og + ((size_t)b * TOK + qb * 256 + wid * 32) * 1024 + h * 128 + r32;
#pragma unroll
    for (int r = 0; r < 16; ++r) { const int q = crow(r, hi); const float il = __builtin_amdgcn_rcpf(wsf[32 + q]);
#pragma unroll
        for (int d = 0; d < 4; ++d) { const unsigned w = cvt_pk_bf16(o[d][r] * il, 0.f); orow[(size_t)q * 1024 + d * 32] = (bf16_t)(w & 0xffffu); } }
#endif
#endif
    asm volatile("s_waitcnt lgkmcnt(0)" ::: "memory"); __builtin_amdgcn_s_barrier(); asm volatile("" ::: "memory");
#undef ATT_ISSUE_K
#undef ATT_ISSUE_V
#ifdef MK_ATT_NEXT
#undef ATT_ISSUE_KB
#undef ATT_ISSUE_VB
#endif
#undef ATT_PV
#undef ATT_LDV
#undef ATT_LDK
#undef XBAR
#undef SBAR
}

__device__ __forceinline__ void attn_phase(const Params& p, LAS unsigned char* lds, int vcu, int G) {
    const int nitems = p.NB * 8 * 8;
#if defined(MK_ATT_PRIO) && MK_ATT_PRIO == 1
    if (__builtin_amdgcn_readfirstlane(threadIdx.x) >= 256) __builtin_amdgcn_s_setprio(1);
#endif
#ifdef MK_ATT_NEXT
    bf16x8 qf[12];
    if (vcu < nitems) {
        int tid = threadIdx.x; asm volatile("" : "+v"(tid));
        const int lane = tid & 63, r32 = lane & 31, hi = lane >> 5; const int wid = __builtin_amdgcn_readfirstlane(tid >> 6);
        const int bh = vcu >> 3, qb = vcu & 7, b = bh >> 3;
        const unsigned loff = (unsigned)lane * 16u, lds0 = (unsigned)(uintptr_t)lds;
        { const char* _g = (const char*)p.K + (size_t)bh * 64 * KSLOT + wid * 3072; const unsigned _l = (unsigned)__builtin_amdgcn_readfirstlane(lds0 + LDS_K + wid * 3072); glds_run2(_g, loff, _l); glds_run1(_g + 2048, loff, _l + 2048); }
        glds_run2((const char*)p.V + (size_t)bh * 64 * VSLOT + wid * 2048, loff, (unsigned)__builtin_amdgcn_readfirstlane(lds0 + LDS_V + wid * 2048));
        const char* qbase = (const char*)(p.Q + ((size_t)bh * TOK + qb * 256 + wid * 32) * 192); const unsigned qoff = (unsigned)(QF_ROW(r32) + hi * 8) * 2u;
#pragma unroll
        for (int d0 = 0; d0 < 12; ++d0) qf[d0] = *(const bf16x8*)(qbase + qoff + d0 * QF_D0);
        const size_t trow = (size_t)b * TOK + qb * 256 + wid * 32 + r32;
#pragma unroll
        for (int d0 = 8; d0 < 12; ++d0) { const int i0 = 4 * (2 * (d0 - 8) + hi);
            const f32x4 cs = *(const f32x4*)(p.rcos + (ROPE_BASE(trow, hi) + (d0 - 8) * ROPE_D0)), sn = *(const f32x4*)(p.rsin + (ROPE_BASE(trow, hi) + (d0 - 8) * ROPE_D0));
            f32x4 x1, x2; unpack8(__builtin_bit_cast(u32x4, qf[d0]), x1, x2);
            qf[d0] = __builtin_bit_cast(bf16x8, pack8(x1 * cs - x2 * sn, x2 * cs + x1 * sn)); }
    }
    for (int it = vcu; it < nitems; it += G) {
        const int bh = it >> 3, s = it & 7; const int itn = it + G; const bool hn = itn < nitems;
        attn_unit(bh, s, p.Q, p.K, p.V, p.ATT, p.rcos, p.rsin, lds, (float*)(p.ctl + 2048), qf, bh, 15 - s, true);
        attn_unit(bh, 15 - s, p.Q, p.K, p.V, p.ATT, p.rcos, p.rsin, lds, (float*)(p.ctl + 2048), qf, hn ? (itn >> 3) : bh, hn ? (itn & 7) : 15 - s, hn);
    }
#else
    for (int it = vcu; it < nitems; it += G) {
        const int bh = it >> 3, s = it & 7;
        attn_unit(bh, s, p.Q, p.K, p.V, p.ATT, p.rcos, p.rsin, lds, (float*)(p.ctl + 2048));
        attn_unit(bh, 15 - s, p.Q, p.K, p.V, p.ATT, p.rcos, p.rsin, lds, (float*)(p.ctl + 2048));
    }
#endif
#if defined(MK_ATT_PRIO) && MK_ATT_PRIO == 1
    __builtin_amdgcn_s_setprio(0);
#endif
}
}
namespace ssm {
constexpr int CH = 256, NCH = TOK / CH, XROW = 272;
struct Cplx { float r, i; };
__device__ __forceinline__ Cplx cmul(Cplx a, Cplx b) { return {a.r * b.r - a.i * b.i, a.r * b.i + a.i * b.r}; }

template <bool OUT>
__device__ __forceinline__ void ssm_item(const Params& p, int item, LAS unsigned char* xt  ) {
    int lane = threadIdx.x & 63; asm volatile("" : "+v"(lane));
    const int j = lane & 31, hi = lane >> 5;
    const int cp = item & 7, g = (item >> 3) & 31, b = item >> 8;
    const int chunk = 2 * cp + hi;
    const float* a_re = p.in[11]; const float* a_im = p.in[12]; const float* log_dt = p.in[13];
    const float* b_re = p.in[14]; const float* b_im = p.in[15]; const float* c_re = p.in[16]; const float* c_im = p.in[17]; const float* dsk = p.in[18];
    const float dt = expf(log_dt[g]);
    Cplx lam[2], fac[2];
#pragma unroll
    for (int k = 0; k < 2; ++k) { const int pp = g * 64 + 32 * k + j; const float ar = a_re[pp], ai = a_im[pp];
        const float mag = expf(ar * dt); lam[k] = {mag * cosf(ai * dt), mag * sinf(ai * dt)};
        const float nr = lam[k].r - 1.f, ni = lam[k].i, den = ar * ar + ai * ai; fac[k] = {(nr * ar + ni * ai) / den, (ni * ar - nr * ai) / den}; }
    bf16x8 bfr[4];
#pragma unroll
    for (int k = 0; k < 2; ++k) { const int pp = g * 64 + 32 * k + j; float br[8], bi[8];
        const f32x4 r0 = *(const f32x4*)(b_re + pp * 16 + 8 * hi), r1 = *(const f32x4*)(b_re + pp * 16 + 8 * hi + 4);
        const f32x4 i0 = *(const f32x4*)(b_im + pp * 16 + 8 * hi), i1 = *(const f32x4*)(b_im + pp * 16 + 8 * hi + 4);
#pragma unroll
        for (int q = 0; q < 4; ++q) { br[q] = r0[q]; br[4 + q] = r1[q]; bi[q] = i0[q]; bi[4 + q] = i1[q]; }
        u32x4 wr_, wi_;
#pragma unroll
        for (int q = 0; q < 4; ++q) { const float ar0 = fac[k].r * br[2 * q] - fac[k].i * bi[2 * q], ar1 = fac[k].r * br[2 * q + 1] - fac[k].i * bi[2 * q + 1];
            const float ai0 = fac[k].r * bi[2 * q] + fac[k].i * br[2 * q], ai1 = fac[k].r * bi[2 * q + 1] + fac[k].i * br[2 * q + 1];
            wr_[q] = cvt_pk_bf16(ar0, ar1); wi_[q] = cvt_pk_bf16(ai0, ai1); }
        bfr[2 * k] = __builtin_bit_cast(bf16x8, wr_); bfr[2 * k + 1] = __builtin_bit_cast(bf16x8, wi_); }
    const int hA = (j >> 2) & 1, rA = (j & 3) + 4 * (j >> 3);
    const size_t rowA0 = (size_t)b * TOK + (size_t)(2 * cp + hA) * CH + rA;
#ifdef MK_UFRAG
#define U_TSTRIDE 16
    const bf16_t* ua = p.U + ((size_t)(b * 32 + g) * TOK + (size_t)(2 * cp + hA) * CH + rA) * 16 + 8 * hi;
#else
#define U_TSTRIDE 512
    const bf16_t* ua = p.U + rowA0 * 512 + g * 16 + 8 * hi;
#endif
    Cplx x[2] = {{0.f, 0.f}, {0.f, 0.f}};
    bf16x8 cfr[8]; float dv[8];
    if (OUT) {
        Cplx l256[2];
#pragma unroll
        for (int k = 0; k < 2; ++k) { Cplx t = lam[k];
#pragma unroll
            for (int s = 0; s < 8; ++s) t = cmul(t, t);
            l256[k] = t; }
        const float* sl = p.sloc + ((size_t)(b * 32 + g) * NCH) * 128;
        float2 sv[NCH - 1][2];
#pragma unroll
        for (int c = 0; c < NCH - 1; ++c)
#pragma unroll
            for (int k = 0; k < 2; ++k) sv[c][k] = (c < chunk) ? *(const float2*)(sl + (size_t)c * 128 + (32 * k + j) * 2) : make_float2(0.f, 0.f);
#pragma unroll
        for (int c = 0; c < NCH - 1; ++c) { if (c < chunk) {
#pragma unroll
            for (int k = 0; k < 2; ++k) { const Cplx t = cmul(l256[k], x[k]); x[k] = {t.r + sv[c][k].x, t.i + sv[c][k].y}; } } }
#pragma unroll
        for (int ks = 0; ks < 8; ++ks) { u32x4 w = (u32x4){0u, 0u, 0u, 0u};
            if (j < 16) { const f32x4 cr = *(const f32x4*)(c_re + (g * 16 + j) * 64 + 8 * ks + 4 * hi), ci = *(const f32x4*)(c_im + (g * 16 + j) * 64 + 8 * ks + 4 * hi);
#pragma unroll
                for (int q = 0; q < 4; ++q) w[q] = cvt_pk_bf16(cr[q], -ci[q]); }
            cfr[ks] = __builtin_bit_cast(bf16x8, w); }
#pragma unroll
        for (int q = 0; q < 8; ++q) dv[q] = dsk[g * 16 + 4 * hi + (q & 3) + 8 * (q >> 2)];
    }
    const int hn = j >> 4, rn = j & 15;
    const size_t rowO0 = (size_t)b * TOK + (size_t)(2 * cp + hn) * CH + rn;
#ifdef MK_UFRAG
    const bf16_t* uo = p.U + ((size_t)(b * 32 + g) * TOK + (size_t)(2 * cp + hn) * CH + rn) * 16 + 4 * hi;
#else
    const bf16_t* uo = p.U + rowO0 * 512 + g * 16 + 4 * hi;
#endif
    bf16x8 af_n = *(const bf16x8*)ua;
    u32x2 uw_n[2] = {(u32x2){0u, 0u}, (u32x2){0u, 0u}};
    if (OUT) { uw_n[0] = *(const u32x2*)uo; uw_n[1] = *(const u32x2*)(uo + 8); }
    for (int tile = 0; tile < CH / 16; ++tile) {
        const bf16x8 af = af_n; const u32x2 uw0 = uw_n[0], uw1 = uw_n[1];
        if (tile + 1 < CH / 16) { af_n = *(const bf16x8*)(ua + (size_t)(tile + 1) * 16 * U_TSTRIDE);
            if (OUT) { uw_n[0] = *(const u32x2*)(uo + (size_t)(tile + 1) * 16 * U_TSTRIDE); uw_n[1] = *(const u32x2*)(uo + (size_t)(tile + 1) * 16 * U_TSTRIDE + 8); } }
        f32x16 bu[4];
#pragma unroll
        for (int q = 0; q < 4; ++q) bu[q] = __builtin_amdgcn_mfma_f32_32x32x16_bf16(af, bfr[q], (f32x16){0.f, 0.f, 0.f, 0.f, 0.f, 0.f, 0.f, 0.f, 0.f, 0.f, 0.f, 0.f, 0.f, 0.f, 0.f, 0.f}, 0, 0, 0);
#pragma unroll
        for (int r = 0; r < 16; ++r) {
#pragma unroll
            for (int k = 0; k < 2; ++k) { const float nr = fmaf(lam[k].r, x[k].r, fmaf(-lam[k].i, x[k].i, bu[2 * k][r])), ni = fmaf(lam[k].r, x[k].i, fmaf(lam[k].i, x[k].r, bu[2 * k + 1][r]));
                x[k] = {nr, ni}; if (OUT) { bu[2 * k][r] = nr; bu[2 * k + 1][r] = ni; } }
        }
        if (OUT) {
#pragma unroll
            for (int r = 0; r < 16; ++r) { LAS unsigned* rowp = (LAS unsigned*)(xt + (16 * hi + r) * XROW);
                rowp[j] = cvt_pk_bf16(bu[0][r], bu[1][r]); rowp[32 + j] = cvt_pk_bf16(bu[2][r], bu[3][r]); }
            asm volatile("s_waitcnt lgkmcnt(0)" ::: "memory");
            f32x16 y = (f32x16){0.f, 0.f, 0.f, 0.f, 0.f, 0.f, 0.f, 0.f, 0.f, 0.f, 0.f, 0.f, 0.f, 0.f, 0.f, 0.f};
#pragma unroll
            for (int ks = 0; ks < 8; ++ks) { const bf16x8 xf = *(const LAS bf16x8*)(xt + j * XROW + (16 * ks + 8 * hi) * 2);
                y = __builtin_amdgcn_mfma_f32_32x32x16_bf16(cfr[ks], xf, y, 0, 0, 0); }
            const size_t row = rowO0 + tile * 16;
#pragma unroll
            for (int q2 = 0; q2 < 2; ++q2) { const int c0 = 4 * hi + 8 * q2;
                const u32x2 uw = q2 ? uw1 : uw0;
                const float u0 = bf_lo(uw.x), u1 = bf_hi(uw.x), u2 = bf_lo(uw.y), u3 = bf_hi(uw.y);
                const float z0 = gelu_t(y[4 * q2 + 0] + dv[4 * q2 + 0] * u0), z1 = gelu_t(y[4 * q2 + 1] + dv[4 * q2 + 1] * u1);
                const float z2 = gelu_t(y[4 * q2 + 2] + dv[4 * q2 + 2] * u2), z3 = gelu_t(y[4 * q2 + 3] + dv[4 * q2 + 3] * u3);
#ifdef MK_ZFRAG
                *(u32x2*)(p.Z + ((size_t)(b * 32 + g) * TOK + (row - (size_t)b * TOK)) * 16 + c0) = (u32x2){cvt_pk_bf16(z0, z1), cvt_pk_bf16(z2, z3)}; }
#else
                *(u32x2*)(p.Z + row * 512 + g * 16 + c0) = (u32x2){cvt_pk_bf16(z0, z1), cvt_pk_bf16(z2, z3)}; }
#endif
            asm volatile("s_waitcnt lgkmcnt(0)" ::: "memory");
        }
    }
    if (!OUT) {
        float* sl = p.sloc + (((size_t)(b * 32 + g) * NCH + chunk) * 64) * 2;
#pragma unroll
        for (int k = 0; k < 2; ++k) *(float2*)(sl + (32 * k + j) * 2) = make_float2(x[k].r, x[k].i);
    }
}
template <bool OUT>
__device__ __forceinline__ void ssm_phase(const Params& p, LAS unsigned char* lds, int vcu, int G) {
    const int wid = __builtin_amdgcn_readfirstlane(threadIdx.x >> 6);
    const int nitems = p.NB * 32 * 8;
    for (int it = vcu * 8 + wid; it < nitems; it += G * 8) ssm_item<OUT>(p, it, lds + wid * (32 * XROW));
}
}
__device__ __forceinline__ int src_col(int mode, int n) {
    if (mode == 0) return n;
    if (mode == 1) { if (n < 1152) return n; if (n < 1216) return 1152 + dperm(n - 1152); if (n < 1280) return -1; if (n < 2304) return 1216 + (n - 1280); return 2240 + (n - 2304); }
    const int h = n >> 8, c = n & 255; if (c < 128) return 192 * h + c; if (c < 192) return 192 * h + 128 + dperm(c - 128); return -1;
}
__device__ __forceinline__ unsigned f2bf(float f) { unsigned u = __builtin_bit_cast(unsigned, f); return (u + 0x7fffu + ((u >> 16) & 1u)) >> 16; }
__device__ __forceinline__ unsigned pk2(float lo, float hi) { return f2bf(lo) | (f2bf(hi) << 16); }
__device__ __forceinline__ void p0_item(const float* W, int K, int Nsrc, const float* gain, bf16_t* WT, int nblk, int mode, LAS float* scr, int item, int lane) {
    const int kb = item / nblk, nb = item % nblk, k0 = 64 * kb, n0 = 32 * nb;
    const int sc = src_col(mode, n0 + (lane & 31));
    float v[32], gn[32];
    const int scc = sc >= 0 ? sc : 0;
#pragma unroll
    for (int i = 0; i < 32; ++i) { const int kk = 2 * i + (lane >> 5); v[i] = W[(size_t)(k0 + kk) * Nsrc + scc]; gn[i] = gain ? gain[k0 + kk] : 1.f; }
#pragma unroll
    for (int i = 0; i < 32; ++i) { const int kk = 2 * i + (lane >> 5); scr[kk * 33 + (lane & 31)] = sc >= 0 ? v[i] * gn[i] : 0.f; }
    asm volatile("s_waitcnt lgkmcnt(0)" ::: "memory");
    const int c = lane & 7;
#pragma unroll
    for (int jj = 0; jj < 4; ++jj) { const int n = (lane >> 3) + 8 * jj; const LAS float* s = scr + (8 * c) * 33 + n;
        u32x4 o; o.x = pk2(s[0 * 33], s[1 * 33]); o.y = pk2(s[2 * 33], s[3 * 33]); o.z = pk2(s[4 * 33], s[5 * 33]); o.w = pk2(s[6 * 33], s[7 * 33]);
        *(u32x4*)(WT + (size_t)(n0 + n) * K + k0 + 8 * c) = o; }
    asm volatile("s_waitcnt lgkmcnt(0)" ::: "memory");
}
__device__ __forceinline__ void rope_sincos(float a, float& s, float& c) {
#if !defined(MK_FAST_ROPE) && !defined(MK_P0_FAST)
    s = sinf(a); c = cosf(a);
#else
    const float n = rintf(a * 0.15915494309189535f);
    float r = fmaf(-n, 6.2831854820251465f, a);
    r = fmaf(n, 1.7484555e-7f, r);
    const float t = r * 0.15915494309189535f;
    s = __builtin_amdgcn_sinf(t); c = __builtin_amdgcn_cosf(t);
#endif
}
#ifdef MK_P0_FAST
__device__ __forceinline__ float wave_sum(float v) {
#define WS_DPP(ctrl) v += __builtin_bit_cast(float, __builtin_amdgcn_mov_dpp(__builtin_bit_cast(int, v), ctrl, 0xF, 0xF, true))
    WS_DPP(0xB1); WS_DPP(0x4E); WS_DPP(0x141); WS_DPP(0x140);
#undef WS_DPP
    { auto a = __builtin_amdgcn_permlane16_swap(__float_as_uint(v), __float_as_uint(v), false, false); v = __uint_as_float(a[0]) + __uint_as_float(a[1]); }
    { auto b = __builtin_amdgcn_permlane32_swap(__float_as_uint(v), __float_as_uint(v), false, false); v = __uint_as_float(b[0]) + __uint_as_float(b[1]); }
    return v;
}
#else
__device__ __forceinline__ float wave_sum(float v) {
#pragma unroll
    for (int o = 1; o < 64; o <<= 1) v += __shfl_xor(v, o);
    return v;
}
#endif
__device__ __forceinline__ void p0_prologue(const Params& p, LAS unsigned char* lds, int vcu, int G) {
    const int lane = threadIdx.x & 63, wid = __builtin_amdgcn_readfirstlane(threadIdx.x >> 6);
    LAS float* scr = (LAS float*)(lds + wid * 16384);
    const int gw = vcu * 8 + wid, NGW = G * 8;
    constexpr int I1 = 16 * 104, IQ = 6 * 64, IKV = 4 * 64;
    constexpr int NITEMS = I1 + IQ + IKV;
    for (int it = gw; it < NITEMS; it += NGW) {
        int r = it;
        if (r < I1) { p0_item(p.in[3], 1024, 3264, p.in[2], p.W1t, 104, 1, scr, r, lane); continue; } r -= I1;
        if (r < IQ) { p0_item(p.in[6], 384, 1536, p.in[4], p.Wqt, 64, 2, scr, r, lane); continue; } r -= IQ;
        p0_item(p.in[7], 256, 2048, p.in[5], p.Wkvt, 64, 0, scr, r, lane);
    }
    const int M = p.NB * TOK;
#ifdef MK_P0_FAST
#define XLOAD(V, mbase) do { _Pragma("unroll") for (int r = 0; r < 4; ++r) { const f32x4* xr = (const f32x4*)(p.x + (size_t)((mbase) + r) * 1024) + lane; \
            _Pragma("unroll") for (int jj = 0; jj < 4; ++jj) V[r][jj] = xr[64 * jj]; } } while (0)
#define XPROC(v, m0) do { float s[4]; \
        _Pragma("unroll") for (int r = 0; r < 4; ++r) { s[r] = 0.f; \
            _Pragma("unroll") for (int jj = 0; jj < 4; ++jj) s[r] += sq4(v[r][jj]); \
            s[r] = wave_sum(s[r]); \
            const float iv = rsqrtf(s[r] * (1.f / 1024.f) + 1e-6f); \
            u32x2* o8 = (u32x2*)(p.XB + (size_t)((m0) + r) * 1024) + lane; \
            _Pragma("unroll") for (int jj = 0; jj < 4; ++jj) o8[64 * jj] = (u32x2){cvt_pk_bf16(v[r][jj][0] * iv, v[r][jj][1] * iv), cvt_pk_bf16(v[r][jj][2] * iv, v[r][jj][3] * iv)}; } \
        if (lane < 4) { const int mm = (m0) + lane; const float sv = lane == 0 ? s[0] : lane == 1 ? s[1] : lane == 2 ? s[2] : s[3]; \
            p.inv_x[mm] = rsqrtf(sv * (1.f / 1024.f) + 1e-6f); p.ssq_q[mm] = 0.f; p.ssq_kv[mm] = 0.f; p.ssq_kpe[mm] = 0.f; p.ssq_h[mm] = 0.f; } \
        { const int mm = (m0) + (lane >> 5) * 2, i = lane & 31; \
          _Pragma("unroll") for (int r = 0; r < 2; ++r) { const float ang = (float)p.pos[mm + r] * p.inv_freq[i]; float cs_, sn_; rope_sincos(ang, sn_, cs_); p.rcos[ROPE_IDX(mm + r, i)] = cs_; p.rsin[ROPE_IDX(mm + r, i)] = sn_; } } } while (0)
    { int m0 = gw * 4; const int step = NGW * 4;
      if (m0 < M) { f32x4 va[4][4], vb[4][4]; XLOAD(va, m0);
        for (;;) { const int m1 = m0 + step; if (m1 < M) XLOAD(vb, m1); XPROC(va, m0); if (m1 >= M) break;
                   const int m2 = m1 + step; if (m2 < M) XLOAD(va, m2); XPROC(vb, m1); if (m2 >= M) break; m0 = m2; } } }
#undef XLOAD
#undef XPROC
#else
    for (int m0 = gw * 4; m0 < M; m0 += NGW * 4) {
        f32x4 v[4][4]; float s[4];
#pragma unroll
        for (int r = 0; r < 4; ++r) { const f32x4* xr = (const f32x4*)(p.x + (size_t)(m0 + r) * 1024) + lane;
#pragma unroll
            for (int jj = 0; jj < 4; ++jj) v[r][jj] = xr[64 * jj]; }
#pragma unroll
        for (int r = 0; r < 4; ++r) { s[r] = 0.f;
#pragma unroll
            for (int jj = 0; jj < 4; ++jj) s[r] += sq4(v[r][jj]);
            s[r] = wave_sum(s[r]);
            const float iv = rsqrtf(s[r] * (1.f / 1024.f) + 1e-6f);
            u32x2* o8 = (u32x2*)(p.XB + (size_t)(m0 + r) * 1024) + lane;
#pragma unroll
            for (int jj = 0; jj < 4; ++jj) o8[64 * jj] = (u32x2){cvt_pk_bf16(v[r][jj][0] * iv, v[r][jj][1] * iv), cvt_pk_bf16(v[r][jj][2] * iv, v[r][jj][3] * iv)}; }
        if (lane < 4) { const int mm = m0 + lane; const float sv = lane == 0 ? s[0] : lane == 1 ? s[1] : lane == 2 ? s[2] : s[3];
            p.inv_x[mm] = rsqrtf(sv * (1.f / 1024.f) + 1e-6f); p.ssq_q[mm] = 0.f; p.ssq_kv[mm] = 0.f; p.ssq_kpe[mm] = 0.f; p.ssq_h[mm] = 0.f; }
        { const int mm = m0 + (lane >> 5) * 2, i = lane & 31;
#pragma unroll
          for (int r = 0; r < 2; ++r) { const float ang = (float)p.pos[mm + r] * p.inv_freq[i]; float cs_, sn_; rope_sincos(ang, sn_, cs_); p.rcos[ROPE_IDX(mm + r, i)] = cs_; p.rsin[ROPE_IDX(mm + r, i)] = sn_; } }
    }
#endif
}

__device__ __forceinline__ void late_weights(const Params& p, LAS unsigned char* lds, int gw, int NGW) {
    const int lane = threadIdx.x & 63, wid = __builtin_amdgcn_readfirstlane(threadIdx.x >> 6);
    LAS float* scr = (LAS float*)(lds + wid * 16384);
    constexpr int IGL = 8 * 16, IOS = 8 * 32, IOM = 16 * 32, IOU = 16 * 32, IUP = 16 * 128, IDN = 64 * 32;
    constexpr int NITEMS = IGL + IOS + IOM + IOU + IUP + IDN;
    for (int it = gw; it < NITEMS; it += NGW) {
        int r = it;
        if (r < IGL) { p0_item(p.in[19], 512, 512, nullptr, p.Wglut, 16, 0, scr, r, lane); continue; } r -= IGL;
        if (r < IOS) { p0_item(p.in[21], 512, 1024, nullptr, p.Wost, 32, 0, scr, r, lane); continue; } r -= IOS;
        if (r < IOM) { p0_item(p.in[10], 1024, 1024, nullptr, p.Womt, 32, 0, scr, r, lane); continue; } r -= IOM;
        if (r < IOU) { p0_item(p.in[22], 1024, 1024, nullptr, p.Woutt, 32, 0, scr, r, lane); continue; } r -= IOU;
        if (r < IUP) { p0_item(p.in[24], 1024, 4096, p.in[23], p.Wupt, 128, 0, scr, r, lane); continue; } r -= IUP;
        p0_item(p.in[25], 4096, 1024, nullptr, p.Wdnt, 32, 0, scr, r, lane);
    }
}
constexpr int LDS_RING = 131072, LDS_AUX = LDS_RING, LDS_BYTES = LDS_RING + 4096 + 256;
#ifndef MK_MODE
#define MK_MODE 0
#endif
namespace cg = cooperative_groups;
template <int K>
__device__ __forceinline__ void run_phase(const Params& p, LAS unsigned char* lds, LAS unsigned char* aux, int vcu, int G, int bx, int dry) {
    const int M = p.NB * TOK;
#ifdef MK_STAGGER_T
    if ((MK_STAGGER_MASK >> K) & 1) { const int g_ = vcu & (MK_STAGGER_G - 1);
        if (g_) { const unsigned long long t0 = __builtin_amdgcn_s_memrealtime(); while (__builtin_amdgcn_s_memrealtime() - t0 < (unsigned long long)(g_ * MK_STAGGER_T)) __builtin_amdgcn_s_sleep(2); } }
#endif
#ifdef MK_IDLE_T
    if (K == 7) { const unsigned long long t0 = __builtin_amdgcn_s_memrealtime(); while (__builtin_amdgcn_s_memrealtime() - t0 < (unsigned long long)(MK_IDLE_T)) __builtin_amdgcn_s_sleep(8); }
#endif
    if (K == 0) { p0_prologue(p, lds, vcu, G); __syncthreads(); }
    if (K == 1) {
        pg8::Gemm g{p.XB, 1024, p.W1t, 1024, M, 3328, 1024}; pg8::StaticOrder S; S.init(M, 3328, G, bx);
        EpiG1 E{p.U, p.QL, p.CKV, p.kpe, p.SGS, p.SGM, p.ssq_q, p.ssq_kv, p.ssq_kpe, p.rcos, p.rsin, p.in[9], dry};
        pg8::gemm_phase(lds, aux, g, S, E, p.ctl + 2048);
        { const int nunits = (M / 256) * 13, rem = nunits % G;
          if (rem == 0) late_weights(p, lds, bx * 8 + __builtin_amdgcn_readfirstlane(threadIdx.x >> 6), G * 8);
          else if (bx >= rem) late_weights(p, lds, (bx - rem) * 8 + __builtin_amdgcn_readfirstlane(threadIdx.x >> 6), (G - rem) * 8);
          __syncthreads(); }
    }
#ifndef MK_DUPSUB
#define MK_DUPSUB 7
#endif
#ifndef MK_P2SUB
#define MK_P2SUB 7
#endif
#define SUBON(b) ((!dry || (MK_DUPSUB & (b))) && (MK_P2SUB & (b)))
    if (K == 2) {
        if (SUBON(4) && (vcu & 1)) { ssm::ssm_phase<false>(p, lds, vcu, G); __syncthreads(); }
        if (SUBON(1)) { pg8::Gemm g{p.QL, 384, p.Wqt, 384, M, 2048, 384}; pg8::StaticOrder S; S.init(M, 2048, G, bx);
          EpiQ E{p.ssq_q, p.rcos, p.rsin, p.in[8], p.Q}; pg8::gemm_phase(lds, aux, g, S, E, p.ctl + 2048); }
        if (SUBON(2)) { pg8::Gemm g{p.CKV, 256, p.Wkvt, 256, M, 2048, 256}; pg8::StaticOrder S; S.init(M, 2048, G, bx);
          EpiKV E{p.ssq_kv, p.ssq_kpe, p.in[9], p.kpe, p.K, p.V}; pg8::gemm_phase(lds, aux, g, S, E, p.ctl + 2048); }
        if (SUBON(4) && !(vcu & 1)) ssm::ssm_phase<false>(p, lds, vcu, G);
        __syncthreads();
    }
    if (K == 3) {
#ifdef MK_P3_MIX
        if (SUBON(2) && (vcu & 1)) { ssm::ssm_phase<true>(p, lds, vcu, G); __syncthreads(); }
        if (SUBON(1)) att::attn_phase(p, lds, vcu, G);
        if (SUBON(2) && !(vcu & 1)) { __syncthreads(); ssm::ssm_phase<true>(p, lds, vcu, G); }
#else
        if (SUBON(1)) att::attn_phase(p, lds, vcu, G);
        if (SUBON(2)) ssm::ssm_phase<true>(p, lds, vcu, G);
#endif
        __syncthreads();
    }
    if (K == 4) {
        pg8::Gemm g{p.Z, 512, p.Wglut, 512, M, 512, 512}; pg8::StaticOrder S; S.init(M, 512, G, bx);
        EpiGlu E{p.Z, p.in[20], p.Z2}; pg8::gemm_phase(lds, aux, g, S, E, p.ctl + 2048);
    }
    if (K == 5) {
        { pg8::Gemm g{p.Z2, 512, p.Wost, 512, M, 1024, 512}; pg8::StaticOrder S; S.init(M, 1024, G, bx);
          EpiMix<false> E{p.SGS, p.T1}; pg8::gemm_phase(lds, aux, g, S, E, p.ctl + 2048); }
        { pg8::Gemm g{p.ATT, 1024, p.Womt, 1024, M, 1024, 1024}; pg8::StaticOrder S; S.init(M, 1024, G, bx);
          EpiMix<true> E{p.SGM, p.T1}; pg8::gemm_phase(lds, aux, g, S, E, p.ctl + 2048); }
    }
    if (K == 6) {
        pg8::Gemm g{p.T1, 1024, p.Woutt, 1024, M, 1024, 1024}; pg8::StaticOrder S; S.init(M, 1024, G, bx);
        EpiOut E{p.x, p.out, p.HB, p.ssq_h, dry}; pg8::gemm_phase(lds, aux, g, S, E, p.ctl + 2048);
    }
    if (K == 7) {
#ifdef MK_STAGGER_US
        if (vcu & 1) { const unsigned long long t0 = __builtin_amdgcn_s_memrealtime(); while (__builtin_amdgcn_s_memrealtime() - t0 < (unsigned long long)(MK_STAGGER_US * 100)) __builtin_amdgcn_s_sleep(8); }
#endif
        pg8::Gemm g{p.HB, 1024, p.Wupt, 1024, M, 4096, 1024}; pg8::StaticOrder S; S.init(M, 4096, G, bx);
        EpiUp E{p.HID}; pg8::gemm_phase(lds, aux, g, S, E, p.ctl + 2048);
    }
    if (K == 8) {
        pg8::Gemm g{p.HID, 4096, p.Wdnt, 4096, M, 1024, 4096}; pg8::StaticOrder S; S.init(M, 1024, G, bx);
        EpiDown E{p.HB, p.ssq_h, p.out}; pg8::gemm_phase(lds, aux, g, S, E, p.ctl + 2048);
    }
}
__global__ void __launch_bounds__(512, 2) mk_kernel(Params p) {
    extern __shared__ __attribute__((aligned(16))) unsigned char lds_raw[];
    LAS unsigned char* lds = (LAS unsigned char*)lds_raw;
    LAS unsigned char* aux = lds + LDS_AUX;
    const int G = gridDim.x, bx = blockIdx.x;
    const int vcu = (G % 8 == 0) ? (bx % 8) * (G / 8) + bx / 8 : bx;
#ifndef MK_PHMASK
#define MK_PHMASK 0x1ff
#endif
#define IN(k) (((MK_PHMASK >> (k)) & 1) && p.ph_lo <= (k) && (k) < p.ph_hi)
#if MK_MODE == 0
#ifndef MK_CGSYNC
#define MK_CGSYNC 0
#endif
    volatile LAS unsigned* bst = (volatile LAS unsigned*)(lds + LDS_AUX + 4096);
    if (threadIdx.x < 2) bst[threadIdx.x] = 0u;
    __syncthreads();
    XcdBarrier xbar = xcd_barrier_post(p.ctl + 4096, bst);
#ifndef MK_PLAIN_LAUNCH
    if (p.NB < 0) cg::this_grid().sync();
#endif
#ifndef MK_BAR
#define MK_BAR 2
#endif
    unsigned bar_epoch = 0;
#define SEAMX() do { if (MK_CGSYNC) cg::this_grid().sync(); else if (MK_BAR == 1) ctr_barrier(p.ctl + 1024, p.ctl + 1088, bar_epoch); else xcd_barrier(xbar); } while (0)
#define SEAM(k) do { if (IN(k) && IN((k) + 1)) SEAMX(); } while (0)
#else
#define SEAMX() do { } while (0)
#define SEAM(k) do { } while (0)
#endif
#ifndef MK_DUP
#define MK_DUP -1
#endif
#ifdef MK_PHPROBE
#define PHSTAMP(k) do { if (blockIdx.x == 0 && threadIdx.x == 0) { const unsigned long long n_ = __builtin_amdgcn_s_memrealtime(); ((float*)(p.ctl + 2048))[16 + (k)] = (float)(n_ - ph_t0) * 0.01f; ph_t0 = n_; } } while (0)
    unsigned long long ph_t0 = __builtin_amdgcn_s_memrealtime();
#else
#define PHSTAMP(k) do { } while (0)
#endif
#define PHASE(k) do { if (IN(k)) { run_phase<k>(p, lds, aux, vcu, G, bx, 0); if (MK_DUP == (k)) { SEAMX(); run_phase<k>(p, lds, aux, vcu, G, bx, 1); } } SEAM(k); PHSTAMP(k); } while (0)
    PHASE(0); PHASE(1); PHASE(2); PHASE(3); PHASE(4); PHASE(5); PHASE(6); PHASE(7); PHASE(8);
#ifdef MK_TPROBE
    SEAMX();
    if (blockIdx.x == 0 && threadIdx.x == 0) p.out[0] += 12.f * logf(((const float*)(p.ctl + 2048))[MK_TPROBE] * MK_TPROBE_SCALE);
#endif
#undef IN
#undef SEAM
}
constexpr int N_PHASES = 9;

static size_t al(size_t v) { return (v + 255) & ~(size_t)255; }
static Params make_params(void* const* d_in, float* out, unsigned char* ws, int NB, int b0, bool alias, unsigned char* gates) {
    Params p{};
    for (int i = 0; i < 26; ++i) p.in[i] = (const float*)d_in[i];
    p.out = out; p.NB = NB; p.ph_lo = 0; p.ph_hi = N_PHASES; p.pad = 0;
    p.x = (const float*)d_in[0] + (size_t)b0 * TOK * 1024; p.pos = (const int*)d_in[1] + (size_t)b0 * TOK;
    for (int i = 0; i < 32; ++i) p.inv_freq[i] = powf(10000.0f, -(float)i / 32.0f);
    const size_t M = (size_t)NB * TOK; size_t off = 0;
    auto take = [&](size_t bytes) { unsigned char* q = ws + off; off += al(bytes); return q; };
    p.ctl = (unsigned*)take(1 << 20);
    p.ssq_q = (float*)take(M * 4); p.ssq_kv = (float*)take(M * 4); p.ssq_kpe = (float*)take(M * 4); p.ssq_h = (float*)take(M * 4); p.inv_x = (float*)take(M * 4);
    p.sloc = (float*)take((size_t)NB * 32 * 16 * 128 * 4);
    p.rcos = (float*)take(M * 32 * 4); p.rsin = (float*)take(M * 32 * 4);
    p.kpe = (bf16_t*)take(M * 64 * 2);
    p.W1t = (bf16_t*)take((size_t)3328 * 1024 * 2); p.Wqt = (bf16_t*)take((size_t)2048 * 384 * 2); p.Wkvt = (bf16_t*)take((size_t)2048 * 256 * 2);
    p.Wglut = (bf16_t*)take((size_t)512 * 512 * 2); p.Wost = (bf16_t*)take((size_t)1024 * 512 * 2); p.Womt = (bf16_t*)take((size_t)1024 * 1024 * 2);
    p.Woutt = (bf16_t*)take((size_t)1024 * 1024 * 2); p.Wupt = (bf16_t*)take((size_t)4096 * 1024 * 2); p.Wdnt = (bf16_t*)take((size_t)1024 * 4096 * 2);
    if (alias) {
        unsigned char* rXB = take(M * 2048); unsigned char* rU = take(M * 1024); unsigned char* rQL = take(M * 1280); unsigned char* rQKV = take(M * 8192); unsigned char* rT1 = take(M * 2048);
        p.XB = (bf16_t*)rXB; p.ATT = (bf16_t*)rXB; p.HB = (bf16_t*)rXB;
        p.U = (bf16_t*)rU; p.Z2 = (bf16_t*)rU;
        p.QL = (bf16_t*)rQL; p.CKV = (bf16_t*)(rQL + M * 768); p.Z = (bf16_t*)rQL;
        p.Q = (bf16_t*)rQKV; p.K = (bf16_t*)(rQKV + M * 3072); p.V = (bf16_t*)(rQKV + M * 6144); p.HID = (bf16_t*)rQKV;
        p.T1 = (bf16_t*)rT1;
        p.SGS = (bf16_t*)out; p.SGM = (bf16_t*)((unsigned char*)out + M * 2048);
    } else {
        p.XB = (bf16_t*)take(M * 2048); p.ATT = (bf16_t*)take(M * 2048); p.HB = (bf16_t*)take(M * 2048);
        p.U = (bf16_t*)take(M * 1024); p.Z2 = (bf16_t*)take(M * 1024); p.Z = (bf16_t*)take(M * 1024);
        p.QL = (bf16_t*)take(M * 768); p.CKV = (bf16_t*)take(M * 512);
        p.Q = (bf16_t*)take(M * 3072); p.K = (bf16_t*)take(M * 3072); p.V = (bf16_t*)take(M * 2048); p.HID = (bf16_t*)take(M * 8192);
        p.T1 = (bf16_t*)take(M * 2048);
        p.SGS = (bf16_t*)gates; p.SGM = (bf16_t*)(gates + M * 2048);
    }
    return p;
}
static int g_grid = 0;
static int mk_grid() {
    if (g_grid == 0) {
        int dev = 0, cus = 0, per_cu = 0;
        hipGetDevice(&dev); hipDeviceGetAttribute(&cus, hipDeviceAttributeMultiprocessorCount, dev);
        hipFuncSetAttribute((const void*)mk_kernel, hipFuncAttributeMaxDynamicSharedMemorySize, LDS_BYTES);
        hipOccupancyMaxActiveBlocksPerMultiprocessor(&per_cu, (const void*)mk_kernel, 512, LDS_BYTES);
        (void)hipGetLastError();
        g_grid = (per_cu >= 1) ? cus : -1;
        if (g_grid < 0) fprintf(stderr, "mk: occupancy query reports %d blocks per CU\n", per_cu);
    }
    return g_grid;
}
static void mk_launch_phases(Params p, int lo, int hi, bool coop, hipStream_t stream) {
    const int grid = mk_grid(); if (grid <= 0) return;
    p.ph_lo = lo; p.ph_hi = hi;
    if (coop) { void* args[] = {&p}; hipError_t e = hipLaunchCooperativeKernel((const void*)mk_kernel, dim3(grid), dim3(512), args, LDS_BYTES, stream);
        if (e != hipSuccess) fprintf(stderr, "mk: cooperative launch failed: %s\n", hipGetErrorString(e)); }
    else hipLaunchKernelGGL(mk_kernel, dim3(grid), dim3(512), LDS_BYTES, stream, p);
}
extern "C" void kernel_launch(void* const* d_in, const int* in_sizes, int n_in, void* d_out, int out_size, void* d_ws, size_t ws_size, hipStream_t stream) {
    Params p = make_params(d_in, (float*)d_out, (unsigned char*)d_ws, 8, 0, true, nullptr);
    hipMemsetAsync(d_ws, 0, 65536, stream);
#if MK_MODE == 0
#ifndef MK_PLAIN_LAUNCH
    mk_launch_phases(p, 0, N_PHASES, true, stream);
#else
    mk_launch_phases(p, 0, N_PHASES, false, stream);
#endif
#else
    for (int ph = 0; ph < N_PHASES; ++ph) mk_launch_phases(p, ph, ph + 1, false, stream);
#endif
}
```
